# Optimizing an MI355X kernel written in HIP

```python
import math
import jax, jax.numpy as jnp
from jax import lax
import numpy as np

D_MODEL = 4096
BATCH = 1
SEQ = 16384
DEPTH = 1
DEC_BATCH = 16
DEC_SEQ = 32
PAST_LEN = 2048

CHUNK = 64
HEAD_DIM = 128
D_SB = D_MODEL // 2
N_HEADS_SB = D_SB // HEAD_DIM
D_LRU = D_MODEL // 2
N_BLOCKS_LRU = 16
LRU_BLOCK = D_LRU // N_BLOCKS_LRU
D_MIX = D_SB + D_LRU
D_IN = 3 * D_SB + 2 * D_LRU
CONV_W_LRU = 4
LRU_C = 8.0
D_FF = 11008
CONV_W_FFN = 3
Q_BLOCK = 128
N_MOD = 6
EPS = 1e-6

kernel_name = 'hybrid_stickbreak_rglru_streaming_step'


def rms_norm(x, g):
    xf = x.astype(jnp.float32)
    y = xf * lax.rsqrt(jnp.mean(xf * xf, axis=-1, keepdims=True) + EPS) * g.astype(jnp.float32)
    return y.astype(x.dtype)


def causal_dwconv(x, prev, w, b):
    W = w.shape[0]
    T = x.shape[1]
    xp = jnp.concatenate([prev.astype(x.dtype), x], axis=1)
    y = b
    for j in range(W):
        y = y + xp[:, j:j + T] * w[j]
    return y, xp[:, T:]


def stick_breaking(q, k, v, q_pos, k_pos):
    z = jnp.einsum('bqhd,bkhd->bhqk', q.astype(jnp.float32), k.astype(jnp.float32)) * (HEAD_DIM ** -0.5)
    visible = k_pos[None, :] < q_pos[:, None]
    log_beta = jax.nn.log_sigmoid(z)
    log_keep = jnp.where(visible, jax.nn.log_sigmoid(-z), 0.0)
    shifted = jnp.pad(log_keep[..., 1:], ((0, 0), (0, 0), (0, 0), (0, 1)))
    log_pass = lax.cumsum(shifted, axis=3, reverse=True)
    weights = jnp.where(visible, jnp.exp(log_beta + log_pass), 0.0)
    return jnp.einsum('bhqk,bkhd->bqhd', weights, v.astype(jnp.float32))


def sb_prompt(q, k, v):
    B, S, H, Dh = q.shape
    nb = S // Q_BLOCK
    q_blocks = q.reshape(B, nb, Q_BLOCK, H, Dh).swapaxes(0, 1)
    starts = jnp.arange(nb, dtype=jnp.int32) * Q_BLOCK
    k_pos = jnp.arange(S, dtype=jnp.int32)

    def one(args):
        qb, s0 = args
        return stick_breaking(qb, k, v, s0 + jnp.arange(Q_BLOCK, dtype=jnp.int32), k_pos)

    o = lax.map(one, (q_blocks, starts))
    return o.swapaxes(0, 1).reshape(B, S, H, Dh)


def block_diag(x, w, b):
    xb = x.reshape(x.shape[0], x.shape[1], N_BLOCKS_LRU, LRU_BLOCK)
    y = jnp.einsum('btnc,ncd->btnd', xb, w.astype(jnp.float32))
    return y.reshape(x.shape) + b.astype(jnp.float32)


def rg_lru(x, h0, w_a, b_a, w_x, b_x, lam):
    xf = x.astype(jnp.float32)
    r = jax.nn.sigmoid(block_diag(xf, w_a, b_a))
    i = jax.nn.sigmoid(block_diag(xf, w_x, b_x))
    log_a = -LRU_C * r * jax.nn.softplus(-lam.astype(jnp.float32))
    a = jnp.exp(log_a)
    u = jnp.sqrt(-jnp.expm1(2.0 * log_a)) * (i * xf)

    def step(h, au):
        a_t, u_t = au
        h = a_t * h + u_t
        return h, h

    h_last, hs = lax.scan(step, h0.astype(jnp.float32), (a.swapaxes(0, 1), u.swapaxes(0, 1)))
    return hs.swapaxes(0, 1), h_last


def layer(x, c, p, past):
    k_past, v_past, conv_lru_prev, h_prev, conv_ffn_prev = past
    B, T, _ = x.shape
    mod = jax.nn.silu(c) @ p['w_ada'] + p['b_ada']
    sh_m, sc_m, g_m, sh_f, sc_f, g_f = jnp.split(mod[:, None, :], N_MOD, axis=-1)

    h = rms_norm(x, p['g_pre_mix']) * (1 + sc_m) + sh_m
    proj = h @ p['w_in']
    q, k, v, xl, gl = jnp.split(proj, [D_SB, 2 * D_SB, 3 * D_SB, 3 * D_SB + D_LRU], axis=-1)
    q = q.reshape(B, T, N_HEADS_SB, HEAD_DIM)
    k = k.reshape(B, T, N_HEADS_SB, HEAD_DIM)
    v = v.reshape(B, T, N_HEADS_SB, HEAD_DIM)
    if k_past is None:
        o_sb = sb_prompt(q, k, v)
    else:
        P = k_past.shape[1]
        k_all = jnp.concatenate([k_past.astype(k.dtype), k], axis=1)
        v_all = jnp.concatenate([v_past.astype(v.dtype), v], axis=1)
        o_sb = stick_breaking(q, k_all, v_all, P + jnp.arange(T, dtype=jnp.int32),
                              jnp.arange(P + T, dtype=jnp.int32))
    o_sb = o_sb.reshape(B, T, D_SB).astype(x.dtype)

    xc, conv_lru_new = causal_dwconv(xl, conv_lru_prev, p['w_conv_lru'], p['b_conv_lru'])
    hs, h_last = rg_lru(xc, h_prev, p['w_gate_a'], p['b_gate_a'], p['w_gate_x'], p['b_gate_x'], p['lru_lambda'])
    o_lru = hs.astype(x.dtype) * jax.nn.gelu(gl, approximate=True)

    mixed = jnp.concatenate([rms_norm(o_sb, p['g_grp_attn']), rms_norm(o_lru, p['g_grp_lru'])], axis=-1) @ p['w_out']
    x = x + g_m * rms_norm(mixed, p['g_post_mix'])

    h = rms_norm(x, p['g_pre_ffn']) * (1 + sc_f) + sh_f
    up, conv_ffn_new = causal_dwconv(h @ p['w_up'], conv_ffn_prev, p['w_conv_ffn'], p['b_conv_ffn'])
    gate, val = jnp.split(up, 2, axis=-1)
    y = (jax.nn.gelu(gate, approximate=True) * val) @ p['w_down']
    x = x + g_f * rms_norm(y, p['g_post_ffn'])
    return x, (k, v, conv_lru_new, h_last.astype(x.dtype), conv_ffn_new)


def setup_inputs(seed: int = 0) -> dict:
    key = jax.random.key(seed)
    ks = jax.random.split(key, 40)
    f32 = jnp.float32

    def nrm(i, shape, s):
        return jax.random.normal(ks[i], shape, f32) * s

    def gain(i, n):
        return 1.0 + 0.01 * jax.random.normal(ks[i], (DEPTH, n), f32)

    L = DEPTH
    u = jax.random.uniform(ks[39], (L, D_LRU), f32, minval=0.9, maxval=0.999)
    s = u ** (1.0 / LRU_C)
    lam = jnp.log(s) - jnp.log1p(-s)
    return {
        'x_prompt': nrm(0, (BATCH, SEQ, D_MODEL), 1.0),
        'x_sample': nrm(1, (DEC_BATCH, DEC_SEQ, D_MODEL), 1.0),
        'c_prompt': nrm(2, (BATCH, D_MODEL), 1.0),
        'c_sample': nrm(3, (DEC_BATCH, D_MODEL), 1.0),
        'cache_k': nrm(4, (L, DEC_BATCH, PAST_LEN, N_HEADS_SB, HEAD_DIM), 1.0),
        'cache_v': nrm(5, (L, DEC_BATCH, PAST_LEN, N_HEADS_SB, HEAD_DIM), 1.0),
        'state_conv_lru': nrm(6, (L, DEC_BATCH, CONV_W_LRU - 1, D_LRU), 1.0),
        'state_lru': nrm(7, (L, DEC_BATCH, D_LRU), 0.5),
        'state_conv_ffn': nrm(8, (L, DEC_BATCH, CONV_W_FFN - 1, 2 * D_FF), 1.0),
        'w_ada': nrm(9, (L, D_MODEL, N_MOD * D_MODEL), 0.5 * D_MODEL ** -0.5),
        'b_ada': nrm(10, (L, N_MOD * D_MODEL), 0.01),
        'g_pre_mix': gain(11, D_MODEL),
        'w_in': nrm(12, (L, D_MODEL, D_IN), D_MODEL ** -0.5),
        'w_conv_lru': nrm(13, (L, CONV_W_LRU, D_LRU), CONV_W_LRU ** -0.5),
        'b_conv_lru': nrm(14, (L, D_LRU), 0.01),
        'w_gate_a': nrm(15, (L, N_BLOCKS_LRU, LRU_BLOCK, LRU_BLOCK), LRU_BLOCK ** -0.5),
        'b_gate_a': nrm(16, (L, D_LRU), 0.01),
        'w_gate_x': nrm(17, (L, N_BLOCKS_LRU, LRU_BLOCK, LRU_BLOCK), LRU_BLOCK ** -0.5),
        'b_gate_x': nrm(18, (L, D_LRU), 0.01),
        'lru_lambda': lam,
        'g_grp_attn': gain(19, D_SB),
        'g_grp_lru': gain(20, D_LRU),
        'w_out': nrm(21, (L, D_MIX, D_MODEL), D_MIX ** -0.5),
        'g_post_mix': gain(22, D_MODEL),
        'g_pre_ffn': gain(23, D_MODEL),
        'w_up': nrm(24, (L, D_MODEL, 2 * D_FF), D_MODEL ** -0.5),
        'w_conv_ffn': nrm(25, (L, CONV_W_FFN, 2 * D_FF), CONV_W_FFN ** -0.5),
        'b_conv_ffn': nrm(26, (L, 2 * D_FF), 0.01),
        'w_down': nrm(27, (L, D_FF, D_MODEL), D_FF ** -0.5),
        'g_post_ffn': gain(28, D_MODEL),
    }


def reference(x_prompt, x_sample, c_prompt, c_sample, cache_k, cache_v, state_conv_lru, state_lru,
              state_conv_ffn, w_ada, b_ada, g_pre_mix, w_in, w_conv_lru, b_conv_lru, w_gate_a, b_gate_a,
              w_gate_x, b_gate_x, lru_lambda, g_grp_attn, g_grp_lru, w_out, g_post_mix, g_pre_ffn, w_up,
              w_conv_ffn, b_conv_ffn, w_down, g_post_ffn):
    xp, xs = x_prompt, x_sample
    Bp = xp.shape[0]
    st_p = [[], [], [], [], []]
    st_s = [[], [], [], [], []]
    for l in range(DEPTH):
        p = {
            'w_ada': w_ada[l], 'b_ada': b_ada[l], 'g_pre_mix': g_pre_mix[l], 'w_in': w_in[l],
            'w_conv_lru': w_conv_lru[l], 'b_conv_lru': b_conv_lru[l],
            'w_gate_a': w_gate_a[l], 'b_gate_a': b_gate_a[l], 'w_gate_x': w_gate_x[l], 'b_gate_x': b_gate_x[l],
            'lru_lambda': lru_lambda[l], 'g_grp_attn': g_grp_attn[l], 'g_grp_lru': g_grp_lru[l],
            'w_out': w_out[l], 'g_post_mix': g_post_mix[l], 'g_pre_ffn': g_pre_ffn[l], 'w_up': w_up[l],
            'w_conv_ffn': w_conv_ffn[l], 'b_conv_ffn': b_conv_ffn[l], 'w_down': w_down[l],
            'g_post_ffn': g_post_ffn[l],
        }
        prompt_past = (None, None,
                       jnp.zeros((Bp, CONV_W_LRU - 1, D_LRU), xp.dtype),
                       jnp.zeros((Bp, D_LRU), xp.dtype),
                       jnp.zeros((Bp, CONV_W_FFN - 1, 2 * D_FF), xp.dtype))
        xp, new_p = layer(xp, c_prompt, p, prompt_past)
        sample_past = (cache_k[l], cache_v[l], state_conv_lru[l], state_lru[l], state_conv_ffn[l])
        xs, new_s = layer(xs, c_sample, p, sample_past)
        for j in range(5):
            st_p[j].append(new_p[j])
            st_s[j].append(new_s[j])
    k_p, v_p, cl_p, h_p, cf_p = [jnp.stack(a, axis=0) for a in st_p]
    k_s, v_s, cl_s, h_s, cf_s = [jnp.stack(a, axis=0) for a in st_s]
    return (xp, xs, k_p, v_p, cl_p, h_p, cf_p, k_s, v_s, cl_s, h_s, cf_s)
```

```cpp
#include <hip/hip_runtime.h>
#include <cstdio>
#include <cstdint>
namespace pg8 {
#define PG8_LAS __attribute__((address_space(3)))
typedef unsigned short bf16_t;
typedef short bf16x8 __attribute__((ext_vector_type(8)));
typedef float f32x4 __attribute__((ext_vector_type(4)));
typedef unsigned u32x4 __attribute__((ext_vector_type(4)));
constexpr int BM = 256, BK = 64, HALF = 128, HTB = HALF * BK * 2  , STAGE_BYTES = 8 * HTB, NXCD = 8, WGM = 8;

__host__ __device__ __forceinline__ int lds_byte(int r, int c) { const int st = (r >> 4) * 2 + (c >> 5), rr = r & 15, cc = c & 31, ob = rr * 64 + cc * 2; return st * 1024 + (ob ^ (((ob >> 9) & 1) << 5)); }
__host__ __device__ __forceinline__ void stage_rc(int b, int& R, int& C) { const int st = b / 1024, sb = b % 1024, swz = sb ^ (((sb >> 9) & 1) << 5); R = (st >> 1) * 16 + swz / 64; C = (st & 1) * 32 + (swz % 64) / 2; }
__host__ __device__ __forceinline__ int perm32(int rho) { const int n = rho >> 4, i = rho & 15; return 8 * (i >> 2) + 4 * n + (i & 3); }

struct Unit { int pm, pn; };
struct Gemm { const bf16_t* A; const bf16_t* Bt; int M, N, K; };

struct StaticOrder {
    int nM, nN, nwg, G, c;
    __host__ __device__ void init(int M, int N, int G_, int c_) { nM = M / BM; nN = N / BM; nwg = nM * nN; G = G_; c = c_; }
    __host__ __device__ __forceinline__ bool next(int i, Unit& u) const {
        const long L = (long)i * G + c; if (L >= nwg) return false;
        int wgid = (int)L; { const int q = nwg / NXCD, r = nwg % NXCD, xcd = wgid % NXCD, off = wgid / NXCD; wgid = (xcd < r ? xcd * (q + 1) : r * (q + 1) + (xcd - r) * q) + off; }
        const int nig = WGM * nN, gid = wgid / nig, fm = gid * WGM, gsz = (nM - fm) < WGM ? (nM - fm) : WGM;
        u.pm = fm + ((wgid % nig) % gsz); u.pn = (wgid % nig) / gsz; return true;
    }
    __device__ __forceinline__ void a_ready(const Unit&) const {}
    __device__ __forceinline__ void done(const Unit&) const {}
    __device__ __forceinline__ void kslice(const Unit&, int ntf, int& kt0, int& nt) const { kt0 = 0; nt = ntf; }
};
struct SplitOrder {
    StaticOrder main; int pm0, npan, nN, nks, nt_hi, n_hi, G, c, nmine;
    __host__ __device__ void init(int Mmain, int Msplit, int N, int nks_, int nt_hi_, int n_hi_, int G_, int c_) {
        main.init(Mmain, N, G_, c_); pm0 = Mmain / BM; npan = Msplit / BM; nN = N / BM; nks = nks_; nt_hi = nt_hi_; n_hi = n_hi_; G = G_; c = c_;
        nmine = (main.nwg > c_) ? (main.nwg - c_ + G_ - 1) / G_ : 0; }
    __host__ __device__ __forceinline__ bool next(int i, Unit& u) const {
        const bool is_main = i < nmine; Unit m; m.pm = 0; m.pn = 0; const bool okm = main.next(is_main ? i : 0, m);
        const int j = (i - nmine) * G + c, ks = j % nks, rest = j / nks;
        u.pm = is_main ? m.pm : pm0 + rest / nN; u.pn = is_main ? m.pn : ((rest % nN) | ((ks + 1) << 8));
        return is_main ? okm : (j < npan * nN * nks);
    }
    __device__ __forceinline__ void a_ready(const Unit&) const {}
    __device__ __forceinline__ void done(const Unit&) const {}
    __device__ __forceinline__ void kslice(const Unit& u, int ntf, int& kt0, int& nt) const { const int ksp = u.pn >> 8, ks = ksp - 1;
        nt = ksp == 0 ? ntf : (ks < n_hi ? nt_hi : nt_hi - 2); kt0 = ksp == 0 ? 0 : (ks < n_hi ? ks * nt_hi : n_hi * nt_hi + (ks - n_hi) * (nt_hi - 2)); }
};
__device__ __forceinline__ unsigned cvt_pk_bf16(float lo, float hi) { unsigned r; asm volatile("v_cvt_pk_bf16_f32 %0, %1, %2" : "=v"(r) : "v"(lo), "v"(hi)); return r; }
typedef float f32x2 __attribute__((ext_vector_type(2)));
struct EpiF32 {
    static constexpr bool PERM = false, AFTER_DRAIN = false;
    float* C; int ldc; const float* bias;
    __device__ __forceinline__ void operator()(const f32x4 (&acc)[2][2][4][2], const Unit& u, int wr, int wc, int fr, int fq) const {
        const int row0 = u.pm * BM + wr * 64 + fr, col0 = u.pn * BM + wc * 32 + 4 * fq;
        f32x4 bv[2][2];
#pragma unroll
        for (int bj = 0; bj < 2; ++bj)
#pragma unroll
            for (int n = 0; n < 2; ++n) bv[bj][n] = bias ? *(const f32x4*)(bias + col0 + bj * HALF + n * 16) : (f32x4){0.f, 0.f, 0.f, 0.f};
#pragma unroll
        for (int ai = 0; ai < 2; ++ai)
#pragma unroll
            for (int m = 0; m < 4; ++m) { float* rowp = C + (size_t)(row0 + ai * HALF + m * 16) * ldc + col0;
#pragma unroll
                for (int bj = 0; bj < 2; ++bj)
#pragma unroll
                    for (int n = 0; n < 2; ++n) *(f32x4*)(rowp + bj * HALF + n * 16) = acc[ai][bj][m][n] + bv[bj][n]; }
    }
};
struct EpiInProj {
    static constexpr bool PERM = true, AFTER_DRAIN = false;
    bf16_t* P; float* kp; float* vp; float* ks; float* vs; float* clp; float* cls;
    __device__ __forceinline__ void operator()(const f32x4 (&acc)[2][2][4][2], const Unit& u, int wr, int wc, int fr, int fq) const {
        const int row0 = u.pm * BM + wr * 64 + fr, col0 = u.pn * BM + wc * 32 + 8 * fq;
        const int seg = u.pn >> 3;
#pragma unroll
        for (int ai = 0; ai < 2; ++ai)
#pragma unroll
            for (int m = 0; m < 4; ++m) { const int row = row0 + ai * HALF + m * 16; bf16_t* rowp = P + (size_t)row * 10240 + col0;
#pragma unroll
                for (int bj = 0; bj < 2; ++bj) { const f32x4 v0 = acc[ai][bj][m][0], v1 = acc[ai][bj][m][1];
                    u32x4 w; w.x = cvt_pk_bf16(v0[0], v0[1]); w.y = cvt_pk_bf16(v0[2], v0[3]); w.z = cvt_pk_bf16(v1[0], v1[1]); w.w = cvt_pk_bf16(v1[2], v1[3]);
                    *(u32x4*)(rowp + bj * HALF) = w; }
                if (seg == 1 || seg == 2) {
                    const int c = col0 - seg * 2048;
                    float* o = (row < 16384) ? ((seg == 1 ? kp : vp) + (size_t)row * 2048 + c) : ((seg == 1 ? ks : vs) + (size_t)(row - 16384) * 2048 + c);
#pragma unroll
                    for (int bj = 0; bj < 2; ++bj) { *(f32x4*)(o + bj * HALF) = acc[ai][bj][m][0]; *(f32x4*)(o + bj * HALF + 4) = acc[ai][bj][m][1]; }
                }
                if (seg == 3 && u.pm >= 63) {
                    const int c = col0 - 6144; float* o = nullptr;
                    if (row < 16384) { if (row >= 16381) o = clp + (size_t)(row - 16381) * 2048 + c; }
                    else { const int rs = row - 16384, j = (rs & 31) - 29; if (j >= 0) o = cls + (size_t)((rs >> 5) * 3 + j) * 2048 + c; }
                    if (o) {
#pragma unroll
                        for (int bj = 0; bj < 2; ++bj) { *(f32x4*)(o + bj * HALF) = acc[ai][bj][m][0]; *(f32x4*)(o + bj * HALF + 4) = acc[ai][bj][m][1]; } }
                }
            }
    }
};
struct EpiUp {
    static constexpr bool PERM = true, AFTER_DRAIN = false;
    bf16_t* U; float* cfp; float* cfs;
    __device__ __forceinline__ void operator()(const f32x4 (&acc)[2][2][4][2], const Unit& u, int wr, int wc, int fr, int fq) const {
        const int row0 = u.pm * BM + wr * 64 + fr, col0 = u.pn * BM + wc * 32 + 8 * fq;
#pragma unroll
        for (int ai = 0; ai < 2; ++ai)
#pragma unroll
            for (int m = 0; m < 4; ++m) { const int row = row0 + ai * HALF + m * 16; bf16_t* rowp = U + (size_t)row * 22016 + col0;
#pragma unroll
                for (int bj = 0; bj < 2; ++bj) { const f32x4 v0 = acc[ai][bj][m][0], v1 = acc[ai][bj][m][1];
                    u32x4 w; w.x = cvt_pk_bf16(v0[0], v0[1]); w.y = cvt_pk_bf16(v0[2], v0[3]); w.z = cvt_pk_bf16(v1[0], v1[1]); w.w = cvt_pk_bf16(v1[2], v1[3]);
                    *(u32x4*)(rowp + bj * HALF) = w; }
                if (u.pm >= 63) {
                    float* o = nullptr;
                    if (row < 16384) { if (row >= 16382) o = cfp + (size_t)(row - 16382) * 22016 + col0; }
                    else { const int rs = row - 16384, j = (rs & 31) - 30; if (j >= 0) o = cfs + (size_t)((rs >> 5) * 2 + j) * 22016 + col0; }
                    if (o) {
#pragma unroll
                        for (int bj = 0; bj < 2; ++bj) { *(f32x4*)(o + bj * HALF) = acc[ai][bj][m][0]; *(f32x4*)(o + bj * HALF + 4) = acc[ai][bj][m][1]; } }
                }
            }
    }
};
struct EpiMixS {
    static constexpr bool PERM = true, AFTER_DRAIN = false;
    bf16_t* C; int ldc; float* part; int row_split0, rows_split;
    __device__ __forceinline__ void operator()(const f32x4 (&acc)[2][2][4][2], const Unit& u, int wr, int wc, int fr, int fq) const {
        const int ksp = u.pn >> 8, row0 = u.pm * BM + wr * 64 + fr, col0 = (u.pn & 255) * BM + wc * 32 + 8 * fq;
        if (ksp == 0) {
#pragma unroll
            for (int ai = 0; ai < 2; ++ai)
#pragma unroll
                for (int m = 0; m < 4; ++m) { bf16_t* rowp = C + (size_t)(row0 + ai * HALF + m * 16) * ldc + col0;
#pragma unroll
                    for (int bj = 0; bj < 2; ++bj) { const f32x4 v0 = acc[ai][bj][m][0], v1 = acc[ai][bj][m][1];
                        u32x4 w; w.x = cvt_pk_bf16(v0[0], v0[1]); w.y = cvt_pk_bf16(v0[2], v0[3]); w.z = cvt_pk_bf16(v1[0], v1[1]); w.w = cvt_pk_bf16(v1[2], v1[3]);
                        *(u32x4*)(rowp + bj * HALF) = w; } }
        } else {
            float* base = part + ((size_t)(ksp - 1) * rows_split - (size_t)row_split0) * ldc;
#pragma unroll
            for (int ai = 0; ai < 2; ++ai)
#pragma unroll
                for (int m = 0; m < 4; ++m) { float* rowp = base + (size_t)(row0 + ai * HALF + m * 16) * ldc + col0;
#pragma unroll
                    for (int bj = 0; bj < 2; ++bj) { *(f32x4*)(rowp + bj * HALF) = acc[ai][bj][m][0]; *(f32x4*)(rowp + bj * HALF + 4) = acc[ai][bj][m][1]; } }
        }
    }
};
__device__ __forceinline__ float dpp_ror1(float v) { return __builtin_bit_cast(float, __builtin_amdgcn_mov_dpp(__builtin_bit_cast(int, v), 0x121, 0xf, 0xf, false)); }
__device__ __forceinline__ float dpp_shr1(float old, float v) { return __builtin_bit_cast(float, __builtin_amdgcn_update_dpp(__builtin_bit_cast(int, old), __builtin_bit_cast(int, v), 0x111, 0xf, 0xf, false)); }
__device__ __forceinline__ float dpp_ror2(float v) { return __builtin_bit_cast(float, __builtin_amdgcn_mov_dpp(__builtin_bit_cast(int, v), 0x122, 0xf, 0xf, false)); }
__device__ __forceinline__ float dpp_shr2(float old, float v) { return __builtin_bit_cast(float, __builtin_amdgcn_update_dpp(__builtin_bit_cast(int, old), __builtin_bit_cast(int, v), 0x112, 0xf, 0xf, false)); }
struct EpiUpAct {
    static constexpr bool PERM = true, AFTER_DRAIN = false;
    bf16_t* ACT; const float* wcv; const float* bcv; float* rawp; float* raws; float* cfp; float* cfs; PG8_LAS float* X;
    __device__ __forceinline__ void operator()(const f32x4 (&acc)[2][2][4][2], const Unit& u, int wr, int wc, int fr, int fq) const {
        const int x0 = wc * 32 + 8 * fq, gcol = u.pn * 128 + x0;
        if (fr >= 14) {
#pragma unroll
            for (int ai = 0; ai < 2; ++ai)
#pragma unroll
                for (int bj = 0; bj < 2; ++bj)
#pragma unroll
                    for (int n = 0; n < 2; ++n) *(PG8_LAS f32x4*)(X + (((2 * ai + wr) * 2 + (fr - 14)) * 256 + bj * 128 + x0 + 4 * n)) = acc[ai][bj][3][n];
        }
        asm volatile("s_waitcnt lgkmcnt(0)" ::: "memory"); __builtin_amdgcn_s_barrier(); asm volatile("" ::: "memory");
#pragma unroll
        for (int n = 0; n < 2; ++n) {
            f32x4 w0[2], w1[2], w2[2], bb[2];
#pragma unroll
            for (int bj = 0; bj < 2; ++bj) { const float* p = wcv + bj * 11008 + gcol + 4 * n; w0[bj] = *(const f32x4*)p; w1[bj] = *(const f32x4*)(p + 22016); w2[bj] = *(const f32x4*)(p + 44032);
                bb[bj] = *(const f32x4*)(bcv + bj * 11008 + gcol + 4 * n); }
#pragma unroll
            for (int ai = 0; ai < 2; ++ai) {
                const int ps = (2 * ai + wr + 3) & 3;
                f32x4 P14[2], P15[2];
#pragma unroll
                for (int bj = 0; bj < 2; ++bj) { P14[bj] = *(const PG8_LAS f32x4*)(X + ((ps * 2 + 0) * 256 + bj * 128 + x0 + 4 * n)); P15[bj] = *(const PG8_LAS f32x4*)(X + ((ps * 2 + 1) * 256 + bj * 128 + x0 + 4 * n)); }
                float outv[4][4];
#pragma unroll
                for (int e = 0; e < 4; ++e) {
                    float cv[2][4];
#pragma unroll
                    for (int bj = 0; bj < 2; ++bj) {
                        float pr1 = P15[bj][e], pr2 = (fr == 0) ? P14[bj][e] : P15[bj][e];
#pragma unroll
                        for (int m = 0; m < 4; ++m) { const float c = acc[ai][bj][m][n][e];
                            const float u1 = dpp_shr1(pr1, c), u2 = dpp_shr2(pr2, c);
                            cv[bj][m] = bb[bj][e] + w0[bj][e] * u2 + w1[bj][e] * u1 + w2[bj][e] * c;
                            if (m < 3) { pr1 = dpp_ror1(c); pr2 = dpp_ror2(c); } }
                    }
#pragma unroll
                    for (int m = 0; m < 4; ++m) { const float g = cv[0][m]; outv[m][e] = g * __builtin_amdgcn_rcpf(1.0f + __builtin_amdgcn_exp2f(g * (-2.3022082f - 0.10294324f * g * g))) * cv[1][m]; }
                }
#pragma unroll
                for (int m = 0; m < 4; ++m) { const int row = u.pm * BM + ai * HALF + wr * 64 + m * 16 + fr;
                    unsigned lo = cvt_pk_bf16(outv[m][0], outv[m][1]), hi = cvt_pk_bf16(outv[m][2], outv[m][3]);
                    *(unsigned long long*)(ACT + (size_t)row * 11008 + gcol + 4 * n) = (unsigned long long)lo | ((unsigned long long)hi << 32); }
            }
        }
        if (u.pm < 64) {
            if (wr == 0 && fr < 2) { float* d = rawp + (size_t)(u.pm * 4 + 2 + fr) * 22016 + gcol;
#pragma unroll
                for (int bj = 0; bj < 2; ++bj) { *(f32x4*)(d + bj * 11008) = acc[0][bj][0][0]; *(f32x4*)(d + bj * 11008 + 4) = acc[0][bj][0][1]; } }
            if (wr == 1 && fr >= 14) { float* d = (u.pm < 63 ? rawp + (size_t)((u.pm + 1) * 4 + (fr - 14)) * 22016 : cfp + (size_t)(fr - 14) * 22016) + gcol;
#pragma unroll
                for (int bj = 0; bj < 2; ++bj) { *(f32x4*)(d + bj * 11008) = acc[1][bj][3][0]; *(f32x4*)(d + bj * 11008 + 4) = acc[1][bj][3][1]; } }
        } else {
#pragma unroll
            for (int ai = 0; ai < 2; ++ai)
#pragma unroll
                for (int m = 0; m < 4; ++m) { const int rt = ai * HALF + wr * 64 + m * 16 + fr, q = rt & 31, s = ((u.pm - 64) * BM + rt) >> 5; float* d = nullptr;
                    if (q < 2) d = raws + (size_t)(s * 2 + q) * 22016 + gcol; else if (q >= 30) d = cfs + (size_t)(s * 2 + q - 30) * 22016 + gcol;
                    if (d) {
#pragma unroll
                        for (int bj = 0; bj < 2; ++bj) { *(f32x4*)(d + bj * 11008) = acc[ai][bj][m][0]; *(f32x4*)(d + bj * 11008 + 4) = acc[ai][bj][m][1]; } } }
        }
    }
};
template <class Epi, class Sched, bool ALIGN_EPI = false, bool SP2 = false>
__device__ __forceinline__ void gemm_phase(PG8_LAS unsigned char* lds, const Gemm g, const Sched& S, const Epi& E) {
    const int tid = threadIdx.x, wid = __builtin_amdgcn_readfirstlane(tid >> 6), lane = tid & 63, wr = wid >> 2, wc = wid & 3, fr = lane & 15, fq = lane >> 4;
    const int K = g.K, ntf = K / BK;
    unsigned voffA[2], voffB[2];
#pragma unroll
    for (int i = 0; i < 2; ++i) { int R, C; stage_rc(tid * 16 + i * 8192, R, C); const int Rb = Epi::PERM ? ((R & ~31) + perm32(R & 31)) : R;
        voffA[i] = (unsigned)(R * K + C) * 2u; voffB[i] = (unsigned)(Rb * K + C) * 2u; }
    const size_t kstep = (size_t)(BK * 2);
    const size_t hstep = (size_t)HALF * K * 2;
    const size_t tstep = 2 * hstep;
    const unsigned ldsw = (unsigned)wid * 1024u;
    const int aoff = lds_byte(wr * 64 + fr, fq * 8), boff = lds_byte(wc * 32 + fr, fq * 8);
#define PG8_SA(b, h) (((b) * 2 + (h)) * HTB)
#define PG8_SB(b, h) ((4 + (b) * 2 + (h)) * HTB)
#define PG8_STAGE(bufoff, gbase, voff) do { _Pragma("unroll") for (int _i = 0; _i < 2; ++_i) \
        __builtin_amdgcn_global_load_lds((const unsigned*)((const char*)(gbase) + (voff)[_i]), (PG8_LAS unsigned*)(lds + (bufoff) + ldsw + _i * 8192), 16, 0, 0); } while (0)
#define PG8_LDA(dst, b, h) do { _Pragma("unroll") for (int m = 0; m < 4; ++m) _Pragma("unroll") for (int k = 0; k < 2; ++k) dst[m][k] = *(const PG8_LAS bf16x8*)(lds + PG8_SA(b, h) + aoff + m * 2048 + k * 1024); } while (0)
#define PG8_LDB(dst, b, h) do { _Pragma("unroll") for (int n = 0; n < 2; ++n) _Pragma("unroll") for (int k = 0; k < 2; ++k) dst[n][k] = *(const PG8_LAS bf16x8*)(lds + PG8_SB(b, h) + boff + n * 2048 + k * 1024); } while (0)
#define PG8_MMA(ai, bj, At, Bt) do { __builtin_amdgcn_s_setprio(1); _Pragma("unroll") for (int m = 0; m < 4; ++m) _Pragma("unroll") for (int n = 0; n < 2; ++n) _Pragma("unroll") for (int k = 0; k < 2; ++k) \
        acc[ai][bj][m][n] = __builtin_amdgcn_mfma_f32_16x16x32_bf16(Bt[n][k], At[m][k], acc[ai][bj][m][n], 0, 0, 0); __builtin_amdgcn_s_setprio(0); } while (0)
#define PG8_WAIT_V(n) asm volatile("s_waitcnt vmcnt(" #n ")" ::: "memory")
#define PG8_WAIT_L(n) asm volatile("s_waitcnt lgkmcnt(" #n ")" ::: "memory")
#define PG8_BAR __builtin_amdgcn_s_barrier()
#define PG8_SCHED __builtin_amdgcn_sched_barrier(0)
    Unit cur, nxt; int ui = 0;
    if (!S.next(0, cur)) return;
    f32x4 acc[2][2][4][2];
#pragma unroll
    for (int a = 0; a < 2; ++a)
#pragma unroll
        for (int b = 0; b < 2; ++b)
#pragma unroll
            for (int m = 0; m < 4; ++m)
#pragma unroll
                for (int n = 0; n < 2; ++n) acc[a][b][m][n] = (f32x4){0.f, 0.f, 0.f, 0.f};
    bf16x8 At[4][2], B0[2][2], B1[2][2];
    int kt0, nt; S.kslice(cur, ntf, kt0, nt);
    const char* cA = (const char*)g.A + (size_t)cur.pm * tstep + (size_t)kt0 * kstep; const char* cB = (const char*)g.Bt + (size_t)(cur.pn & 255) * tstep + (size_t)kt0 * kstep;
    S.a_ready(cur);
    if constexpr (SP2) {
        PG8_STAGE(PG8_SB(0, 0), cB, voffB); PG8_STAGE(PG8_SB(0, 1), cB + hstep, voffB); PG8_STAGE(PG8_SA(0, 0), cA, voffA); PG8_STAGE(PG8_SA(0, 1), cA + hstep, voffA);
        if (wr == 1) PG8_BAR;
        PG8_WAIT_V(2); PG8_BAR;
        PG8_STAGE(PG8_SB(1, 0), cB + kstep, voffB); PG8_STAGE(PG8_SA(1, 0), cA + kstep, voffA); PG8_STAGE(PG8_SB(1, 1), cB + hstep + kstep, voffB);
        PG8_WAIT_V(6); PG8_BAR;
    } else {
        PG8_STAGE(PG8_SB(0, 0), cB, voffB); PG8_STAGE(PG8_SA(0, 0), cA, voffA); PG8_STAGE(PG8_SB(0, 1), cB + hstep, voffB); PG8_STAGE(PG8_SA(0, 1), cA + hstep, voffA);
        if (wr == 1) PG8_BAR;
        PG8_WAIT_V(4); PG8_BAR;
        PG8_STAGE(PG8_SB(1, 0), cB + kstep, voffB); PG8_STAGE(PG8_SA(1, 0), cA + kstep, voffA); PG8_STAGE(PG8_SB(1, 1), cB + hstep + kstep, voffB);
        PG8_WAIT_V(6); PG8_BAR;
    }
    for (;;) {
        const bool has_next = S.next(ui + 1, nxt);
        int nkt0 = 0, nnt = ntf; if (has_next) S.kslice(nxt, ntf, nkt0, nnt);
        const char* nA = has_next ? (const char*)g.A + (size_t)nxt.pm * tstep + (size_t)nkt0 * kstep : cA; const char* nB = has_next ? (const char*)g.Bt + (size_t)(nxt.pn & 255) * tstep + (size_t)nkt0 * kstep : cB;
        for (int t = 0; t < nt; t += 2) {
            const bool last = (t == nt - 2);
            const char* a1 = cA + (size_t)(t + 1) * kstep;
            const char* a2 = last ? nA : cA + (size_t)(t + 2) * kstep; const char* b2 = last ? nB : cB + (size_t)(t + 2) * kstep;
            const char* a3 = a2 + kstep; const char* b3 = b2 + kstep;
            if (last && has_next) S.a_ready(nxt);
            if constexpr (SP2) {
            PG8_LDB(B0, 0, 0); PG8_LDB(B1, 0, 1); PG8_SCHED; PG8_LDA(At, 0, 0); PG8_STAGE(PG8_SA(1, 1), a1 + hstep, voffA);
            PG8_WAIT_V(8); PG8_WAIT_L(0); PG8_BAR; PG8_MMA(0, 0, At, B0); PG8_MMA(0, 1, At, B1); PG8_BAR; PG8_SCHED;
            PG8_LDA(At, 0, 1); PG8_STAGE(PG8_SB(0, 0), b2, voffB); PG8_STAGE(PG8_SB(0, 1), b2 + hstep, voffB); PG8_STAGE(PG8_SA(0, 0), a2, voffA);
            PG8_WAIT_V(8); PG8_WAIT_L(0); PG8_BAR; PG8_MMA(1, 0, At, B0); PG8_MMA(1, 1, At, B1); PG8_BAR; PG8_SCHED;
            PG8_LDB(B0, 1, 0); PG8_LDB(B1, 1, 1); PG8_SCHED; PG8_LDA(At, 1, 0); PG8_STAGE(PG8_SA(0, 1), a2 + hstep, voffA);
            PG8_WAIT_V(8); PG8_WAIT_L(0); PG8_BAR; PG8_MMA(0, 0, At, B0); PG8_MMA(0, 1, At, B1); PG8_BAR; PG8_SCHED;
            PG8_LDA(At, 1, 1); PG8_STAGE(PG8_SB(1, 0), b3, voffB); PG8_STAGE(PG8_SB(1, 1), b3 + hstep, voffB); PG8_STAGE(PG8_SA(1, 0), a3, voffA);
            PG8_WAIT_V(8); PG8_WAIT_L(0); PG8_BAR; PG8_MMA(1, 0, At, B0); PG8_MMA(1, 1, At, B1); PG8_BAR; PG8_SCHED;
            } else {
            PG8_LDB(B0, 0, 0); PG8_SCHED; PG8_LDA(At, 0, 0); PG8_STAGE(PG8_SA(1, 1), a1 + hstep, voffA);
            PG8_WAIT_L(8); PG8_BAR; PG8_WAIT_L(0); PG8_MMA(0, 0, At, B0); PG8_BAR; PG8_SCHED;
            PG8_LDB(B1, 0, 1); PG8_STAGE(PG8_SB(0, 0), b2, voffB);
            PG8_BAR; PG8_WAIT_L(0); PG8_MMA(0, 1, At, B1); PG8_BAR;
            PG8_LDA(At, 0, 1); PG8_STAGE(PG8_SA(0, 0), a2, voffA);
            PG8_BAR; PG8_WAIT_L(0); PG8_MMA(1, 0, At, B0); PG8_BAR; PG8_SCHED;
            PG8_STAGE(PG8_SB(0, 1), b2 + hstep, voffB);
            PG8_WAIT_V(6); PG8_BAR; PG8_MMA(1, 1, At, B1); PG8_BAR;
            PG8_LDB(B0, 1, 0); PG8_SCHED; PG8_LDA(At, 1, 0); PG8_STAGE(PG8_SA(0, 1), a2 + hstep, voffA);
            PG8_WAIT_L(8); PG8_BAR; PG8_WAIT_L(0); PG8_MMA(0, 0, At, B0); PG8_BAR; PG8_SCHED;
            PG8_LDB(B1, 1, 1); PG8_STAGE(PG8_SB(1, 0), b3, voffB);
            PG8_BAR; PG8_WAIT_L(0); PG8_MMA(0, 1, At, B1); PG8_BAR;
            PG8_LDA(At, 1, 1); PG8_STAGE(PG8_SA(1, 0), a3, voffA);
            PG8_BAR; PG8_WAIT_L(0); PG8_MMA(1, 0, At, B0); PG8_BAR; PG8_SCHED;
            PG8_STAGE(PG8_SB(1, 1), b3 + hstep, voffB);
            PG8_WAIT_V(6); PG8_BAR; PG8_MMA(1, 1, At, B1); PG8_BAR;
            }
        }
        if constexpr (ALIGN_EPI) { if (wr == 0) PG8_BAR; }
        if constexpr (!Epi::AFTER_DRAIN) { E(acc, cur, wr, wc, fr, fq); S.done(cur); }
        if (!has_next) break;
#pragma unroll
        for (int a = 0; a < 2; ++a)
#pragma unroll
            for (int b = 0; b < 2; ++b)
#pragma unroll
                for (int m = 0; m < 4; ++m)
#pragma unroll
                    for (int n = 0; n < 2; ++n) acc[a][b][m][n] = (f32x4){0.f, 0.f, 0.f, 0.f};
        cur = nxt; cA = nA; cB = nB; nt = nnt; ++ui;
        if constexpr (ALIGN_EPI) { if (wr == 1) PG8_BAR; }
    }
    PG8_WAIT_V(0);
    if constexpr (!ALIGN_EPI) { if (wr == 0) PG8_BAR; }
    PG8_BAR;
    if constexpr (Epi::AFTER_DRAIN) { E.fused(acc, cur, wr, wc, fr, fq, lds, wid, lane); S.done(cur); }
#undef PG8_SA
#undef PG8_SB
#undef PG8_STAGE
#undef PG8_LDA
#undef PG8_LDB
#undef PG8_MMA
#undef PG8_WAIT_V
#undef PG8_WAIT_L
#undef PG8_BAR
#undef PG8_SCHED
}
}

constexpr int DM = 4096, SEQ = 16384, NDEC = 16, DSEQ = 32, PAST = 2048, HD = 128, DSB = 2048, NH = 16, DLRU = 2048, NBLK = 16, LBLK = 128;
constexpr int DIN = 10240, DFF = 11008, DFF2 = 22016, NMODC = 6 * DM, NB = 1 + NDEC;
constexpr int M = SEQ + NDEC * DSEQ;
constexpr int NCHUNK = M / 32;
constexpr float EPS = 1e-6f;
constexpr int NWAVES = 8;
constexpr int NPH = 12;

constexpr size_t OUT_Y = 0, OUT_KP = (size_t)M * DM, OUT_VP = OUT_KP + (size_t)SEQ * DSB, OUT_CLP = OUT_VP + (size_t)SEQ * DSB, OUT_LP = OUT_CLP + 3 * DLRU, OUT_CFP = OUT_LP + DLRU,
                 OUT_KS = OUT_CFP + 2 * DFF2, OUT_VS = OUT_KS + (size_t)512 * DSB, OUT_CLS = OUT_VS + (size_t)512 * DSB, OUT_LS = OUT_CLS + NDEC * 3 * DLRU, OUT_CFS = OUT_LS + NDEC * DLRU,
                 OUT_END = OUT_CFS + (size_t)NDEC * 2 * DFF2;
static_assert(OUT_END == 139299840ull, "output size");

constexpr size_t MiB = 1u << 20;
constexpr size_t WS_CTL = 0, CTL_ZERO_BYTES = 1 * MiB;
constexpr size_t WS_GATET = 1 * MiB;
constexpr size_t WS_MOD = 2 * MiB;
constexpr size_t WS_AGGA = 4 * MiB, WS_AGGH = 9 * MiB, WS_CARRY = 14 * MiB;
constexpr size_t WS_WDOWN = 20 * MiB;
constexpr size_t WS_WUP = 106 * MiB;
constexpr size_t WS_WOUT = 278 * MiB;
constexpr size_t WS_ACT = 310 * MiB;
constexpr size_t WS_MIX = 442 * MiB;
constexpr size_t WS_X1 = 574 * MiB;
constexpr size_t WS_R = 706 * MiB;
constexpr size_t WS_WIN = WS_R;
constexpr size_t WS_PROJ = WS_R + 80 * MiB;
constexpr size_t WS_OSB = WS_PROJ + 330 * MiB;
constexpr size_t WS_HP = WS_OSB + 66 * MiB;
constexpr size_t WS_PART = WS_R;
constexpr int KS_OUT = 8, KS_DOWN = 4;
constexpr size_t WS_RAWP = WS_R + 64 * MiB;
constexpr size_t WS_RAWS = WS_R + 88 * MiB;
constexpr size_t WS_ACTF = WS_R + 710 * MiB;
constexpr size_t WS_END = WS_ACTF + 355 * MiB;
static_assert(WS_HP + 132 * MiB <= WS_END && (size_t)M * DFF * 2 <= 355 * MiB && (size_t)M * DIN * 2 <= 330 * MiB, "ws map");
constexpr int CW_BAR = 4096;

constexpr int RING_BYTES = 131072;
constexpr int LDSCTL_OFF = RING_BYTES, MISC_OFF = LDSCTL_OFF + 320;
constexpr int LDS_BYTES = 147456;
constexpr int EXCH_OFF = LDSCTL_OFF + 2048;
static_assert(EXCH_OFF + 8192 <= LDS_BYTES, "lds map");
constexpr int WAVE_LDS = 9216;
constexpr int VROW = 288;
constexpr int XROW = 272;

#define GAS __attribute__((address_space(1)))
#define LAS __attribute__((address_space(3)))
typedef unsigned short bf16;
typedef unsigned v4u __attribute__((ext_vector_type(4)));
typedef unsigned v2u __attribute__((ext_vector_type(2)));
typedef float f32x4 __attribute__((ext_vector_type(4)));
typedef float f32x16 __attribute__((ext_vector_type(16)));
typedef short bf16x8 __attribute__((ext_vector_type(8)));
typedef short s16x4 __attribute__((ext_vector_type(4)));
typedef GAS unsigned gu32;
#define RLX_AGENT __ATOMIC_RELAXED, __HIP_MEMORY_SCOPE_AGENT
#define LDS_WAIT() asm volatile("s_waitcnt lgkmcnt(0)" ::: "memory")
__device__ __forceinline__ unsigned f2bf(float f) { unsigned u = __builtin_bit_cast(unsigned, f); return (u + 0x7fffu + ((u >> 16) & 1u)) >> 16; }
__device__ __forceinline__ unsigned pk2(float lo, float hi) { typedef float f2_t __attribute__((ext_vector_type(2))); typedef __bf16 b2_t __attribute__((ext_vector_type(2))); f2_t v = {lo, hi}; b2_t b = __builtin_convertvector(v, b2_t); return __builtin_bit_cast(unsigned, b); }
__device__ __forceinline__ float bf_lo(unsigned w) { return __builtin_bit_cast(float, w << 16); }
__device__ __forceinline__ float bf_hi(unsigned w) { return __builtin_bit_cast(float, w & 0xffff0000u); }
__device__ __forceinline__ float fexp2(float x) { return __builtin_amdgcn_exp2f(x); }
__device__ __forceinline__ float flog2(float x) { return __builtin_amdgcn_logf(x); }
__device__ __forceinline__ float frcp(float x) { return __builtin_amdgcn_rcpf(x); }
__device__ __forceinline__ float fsqrt(float x) { return __builtin_amdgcn_sqrtf(x); }
__device__ __forceinline__ float sigmoidf_(float x) { return frcp(1.0f + fexp2(-1.4426950408889634f * x)); }
__device__ __forceinline__ float gelu_tanh(float x) { return x * frcp(1.0f + fexp2(x * (-2.3022082f - 0.10294324f * x * x))); }
__device__ __forceinline__ float wave_sum(float v) {
#pragma unroll
    for (int o = 1; o < 64; o <<= 1) v += __shfl_xor(v, o);
    return v;
}
#define XB_TMO      128
#define XB_XCNT(j)  (256  + 64 * (j))
#define XB_XSUB(j)  (1280 + 64 * (j))
#define XB_XGEN(j)  (2304 + 64 * (j))
#define XB_TOP      3328
#define XB_TOPGEN   3392
#define XCD_BAR_WORDS 3456
#define XB_SPIN_CAP (1u << 18)

__device__ __forceinline__ unsigned xb_ld(unsigned* p)              { return __hip_atomic_load(p, __ATOMIC_RELAXED, __HIP_MEMORY_SCOPE_AGENT); }
__device__ __forceinline__ unsigned xb_add(unsigned* p, unsigned v) { return __hip_atomic_fetch_add(p, v, __ATOMIC_RELAXED, __HIP_MEMORY_SCOPE_AGENT); }
__device__ __forceinline__ unsigned xb_xcc_id() { return (unsigned)__builtin_amdgcn_s_getreg((3 << 11) | 20) & 0xFu; }
#define XB_SPIN(cond, bar) do { unsigned _sp = 0; while (cond) { __builtin_amdgcn_s_sleep(1); \
    if ((++_sp & 255u) == 0u) { if (xb_ld(&(bar)[XB_TMO])) break; if (_sp > XB_SPIN_CAP) { atomicAdd(&(bar)[XB_TMO], 1u); break; } } } } while (0)

struct XcdBarrier {
    unsigned* bar; unsigned x;
    volatile LAS unsigned* st;
};

__device__ __forceinline__ XcdBarrier xcd_barrier_post(unsigned* bar, volatile LAS unsigned* st) {
    XcdBarrier b; b.bar = bar; b.x = xb_xcc_id(); b.st = st;
    if (threadIdx.x == 0) (void)xb_add(&bar[XB_XCNT(b.x)], 1u);
    return b;
}
__device__ __forceinline__ void xcd_barrier_complete(unsigned* bar, unsigned x, unsigned& nloc, unsigned& nx) {
    const unsigned G = gridDim.x * gridDim.y * gridDim.z;
    unsigned sum, cnt, mine, sp = 0u;
    for (;;) {
        sum = 0u; cnt = 0u; mine = 0u;
#pragma unroll
        for (unsigned j = 0; j < 16; ++j) { const unsigned c = xb_ld(&bar[XB_XCNT(j)]); sum += c; cnt += (c > 0u) ? 1u : 0u; mine = (j == x) ? c : mine; }
        if (sum == G) break;
        __builtin_amdgcn_s_sleep(1);
        if ((++sp & 255u) == 0u) { if (xb_ld(&bar[XB_TMO])) break; if (sp > XB_SPIN_CAP) { atomicAdd(&bar[XB_TMO], 1u); break; } }
    }
    nloc = mine > 0u ? mine : 1u; nx = cnt > 0u ? cnt : 1u;
}

__device__ __forceinline__ void xcd_barrier(const XcdBarrier& b) {
    asm volatile("s_waitcnt vmcnt(0)" ::: "memory");
    __syncthreads();
    if (threadIdx.x == 0) {
        unsigned* bar = b.bar;
        __builtin_amdgcn_s_waitcnt(0);
        unsigned nloc = b.st[0], nx = b.st[1];
        if (nloc == 0u) { xcd_barrier_complete(bar, b.x, nloc, nx); b.st[0] = nloc; b.st[1] = nx; }
        const unsigned old = xb_add(&bar[XB_XSUB(b.x)], 1u);
        const unsigned gen = old / nloc;
        if (old + 1u == (gen + 1u) * nloc) {
            __builtin_amdgcn_fence(__ATOMIC_RELEASE, "agent");
            asm volatile("s_waitcnt vmcnt(0)" ::: "memory");
            const unsigned og = xb_add(&bar[XB_TOP], 1u);
            const unsigned tg = og / nx;
            if (og + 1u == (tg + 1u) * nx) xb_add(&bar[XB_TOPGEN], 1u);
            else XB_SPIN(xb_ld(&bar[XB_TOPGEN]) == tg, bar);
            __builtin_amdgcn_fence(__ATOMIC_ACQUIRE, "agent");
            xb_add(&bar[XB_XGEN(b.x)], 1u);
            asm volatile("s_waitcnt vmcnt(0)" ::: "memory");
        } else {
            XB_SPIN(xb_ld(&bar[XB_XGEN(b.x)]) == gen, bar);
            __builtin_amdgcn_fence(__ATOMIC_ACQUIRE, "agent");
            asm volatile("s_waitcnt vmcnt(0)" ::: "memory");
        }
    }
    __syncthreads();
}

enum InIdx { I_XP = 0, I_XS, I_CP, I_CS, I_CK, I_CV, I_SCL, I_SL, I_SCF, I_WADA, I_BADA, I_GPM, I_WIN, I_WCL, I_BCL, I_WGA, I_BGA, I_WGX, I_BGX, I_LAM, I_GGA, I_GGL,
             I_WOUT, I_GPOM, I_GPF, I_WUP, I_WCF, I_BCF, I_WDOWN, I_GPOF, N_IN };
struct Args { const float* in[N_IN]; float* out; unsigned char* ws; int ph_lo, ph_hi, li, pad; };
typedef const __attribute__((address_space(4))) Args KArgs;
struct Frame {
    LAS unsigned char* lds;
    volatile LAS unsigned* MISC;
    gu32* ctl;
    int tid, lane, wave, vcu, G;
};
__device__ __forceinline__ const float* xrow_of(KArgs& A, int m) { return m < SEQ ? A.in[I_XP] + (size_t)m * DM : A.in[I_XS] + (size_t)(m - SEQ) * DM; }
__device__ __forceinline__ int modrow_of(int m) { return m < SEQ ? 0 : 1 + ((m - SEQ) >> 5); }

template <bool UPMAP = false>
__device__ __forceinline__ void p0_transpose_item(const float* W, int K, int N, bf16* WT, LAS float* scr, int item, int lane) {
    const int nblk = N / 32, kb = item / nblk, nb = item % nblk, k0 = 64 * kb, n0 = 32 * nb;
    const int d0 = UPMAP ? (n0 < DFF ? (n0 >> 7) * 256 + (n0 & 127) : ((n0 - DFF) >> 7) * 256 + 128 + ((n0 - DFF) & 127)) : n0;
    float t[32];
    const float* wp = W + (size_t)(k0 + (lane >> 5)) * N + n0 + (lane & 31);
#pragma unroll
    for (int i = 0; i < 32; ++i) t[i] = wp[(size_t)(2 * i) * N];
#pragma unroll
    for (int i = 0; i < 32; ++i) scr[(2 * i + (lane >> 5)) * 33 + (lane & 31)] = t[i];
    LDS_WAIT(); asm volatile("" ::: "memory");
    const int c = lane & 7;
#pragma unroll
    for (int j = 0; j < 4; ++j) { const int n = (lane >> 3) + 8 * j; const LAS float* s = scr + (8 * c) * 33 + n;
        v4u o; o.x = pk2(s[0 * 33], s[1 * 33]); o.y = pk2(s[2 * 33], s[3 * 33]); o.z = pk2(s[4 * 33], s[5 * 33]); o.w = pk2(s[6 * 33], s[7 * 33]);
        *(GAS v4u*)(WT + (size_t)(d0 + n) * K + k0 + 8 * c) = o; }
    LDS_WAIT(); asm volatile("" ::: "memory");
}
constexpr int IT_UP = (DM / 64) * (DFF2 / 32), IT_DOWN = (DFF / 64) * (DM / 32);
constexpr int IT_DOWN_TAIL = 22016;
constexpr int IT_UP_TAIL = 44032;
template <bool UPMAP>
__device__ __forceinline__ void tail_convert(Frame& F, const float* W, int K, int N, bf16* WT, int nitems, int nunits) {
    const int G = F.G, c = (int)blockIdx.x, rounds = (nunits + G - 1) / G, nlast = nunits - (rounds - 1) * G;
    const bool all = (nlast == G); if (!all && c < nlast) return;
    const int nidle = all ? G : G - nlast, ii = (all ? c : c - nlast) * NWAVES + F.wave;
    LAS float* scr = (LAS float*)(F.lds + F.wave * 16384);
    for (int it = ii; it < nitems; it += nidle * NWAVES) p0_transpose_item<UPMAP>(W, K, N, WT, scr, it, F.lane);
}
__device__ __forceinline__ void p0_prologue(Frame& F, KArgs& A) {
    unsigned char* ws = A.ws;
    LAS float* scr = (LAS float*)(F.lds + F.wave * 16384);
    const int gw = F.vcu * NWAVES + F.wave, NGW = F.G * NWAVES;
    constexpr int IT_IN = (DM / 64) * (DIN / 32), IT_OUT = (DM / 64) * (DM / 32), IT_G = 2 * NBLK * 8;
    constexpr int NITEMS = IT_IN + IT_OUT + IT_G + (IT_UP - IT_UP_TAIL) + (IT_DOWN - IT_DOWN_TAIL);
    for (int it = gw; it < NITEMS; it += NGW) {
        int r = it;
        if (r < IT_IN) { p0_transpose_item(A.in[I_WIN], DM, DIN, (bf16*)(ws + WS_WIN), scr, r, F.lane); continue; } r -= IT_IN;
        if (r < IT_OUT) { p0_transpose_item(A.in[I_WOUT], DM, DM, (bf16*)(ws + WS_WOUT), scr, r, F.lane); continue; } r -= IT_OUT;
        if (r < IT_G) { const int gb = r >> 3, sub = r & 7;
          const float* Wg = (gb < NBLK ? A.in[I_WGA] : A.in[I_WGX]) + (size_t)(gb & 15) * LBLK * LBLK;
          p0_transpose_item(Wg, LBLK, LBLK, (bf16*)(ws + WS_GATET) + (size_t)gb * LBLK * LBLK, scr, sub, F.lane); continue; } r -= IT_G;
        if (r < IT_UP - IT_UP_TAIL) { p0_transpose_item<true>(A.in[I_WUP], DM, DFF2, (bf16*)(ws + WS_WUP), scr, IT_UP_TAIL + r, F.lane); continue; } r -= IT_UP - IT_UP_TAIL;
        p0_transpose_item(A.in[I_WDOWN], DFF, DM, (bf16*)(ws + WS_WDOWN), scr, IT_DOWN_TAIL + r, F.lane);
    }
    __syncthreads();
    float* MOD = (float*)(ws + WS_MOD);
    LAS float* RED = (LAS float*)F.lds;
    const int jj = F.lane & 15, kh = F.lane >> 4;
    typedef float f32x2v __attribute__((ext_vector_type(2)));
    for (int strip = F.vcu; strip < NMODC / 96; strip += F.G) {
        const int col0 = strip * 96;
        const float* wp = A.in[I_WADA] + (size_t)(512 * F.wave + kh) * NMODC + col0 + 6 * jj;
        const float* cs = A.in[I_CS] + (size_t)jj * DM + 512 * F.wave + kh;
        const float* cp = A.in[I_CP] + 512 * F.wave + kh;
        f32x4 acc[6]; float a0[6];
#pragma unroll
        for (int g = 0; g < 6; ++g) { acc[g] = (f32x4){0.f, 0.f, 0.f, 0.f}; a0[g] = 0.f; }
#pragma unroll 4
        for (int st = 0; st < 128; ++st) {
            const float* wr = wp + (size_t)(4 * st) * NMODC;
            const f32x2v w01 = *(const f32x2v*)wr, w23 = *(const f32x2v*)(wr + 2), wb = *(const f32x2v*)(wr + 4); const f32x4 wa = (f32x4){w01.x, w01.y, w23.x, w23.y};
            const float cv = cs[4 * st], c0 = cp[4 * st];
            const float sv = cv * sigmoidf_(cv), s0 = c0 * sigmoidf_(c0);
            acc[0] = __builtin_amdgcn_mfma_f32_16x16x4f32(sv, wa.x, acc[0], 0, 0, 0); acc[1] = __builtin_amdgcn_mfma_f32_16x16x4f32(sv, wa.y, acc[1], 0, 0, 0);
            acc[2] = __builtin_amdgcn_mfma_f32_16x16x4f32(sv, wa.z, acc[2], 0, 0, 0); acc[3] = __builtin_amdgcn_mfma_f32_16x16x4f32(sv, wa.w, acc[3], 0, 0, 0);
            acc[4] = __builtin_amdgcn_mfma_f32_16x16x4f32(sv, wb.x, acc[4], 0, 0, 0); acc[5] = __builtin_amdgcn_mfma_f32_16x16x4f32(sv, wb.y, acc[5], 0, 0, 0);
            a0[0] += s0 * wa.x; a0[1] += s0 * wa.y; a0[2] += s0 * wa.z; a0[3] += s0 * wa.w; a0[4] += s0 * wb.x; a0[5] += s0 * wb.y;
        }
#pragma unroll
        for (int g = 0; g < 6; ++g) { a0[g] += __shfl_xor(a0[g], 16); a0[g] += __shfl_xor(a0[g], 32); }
        LAS float* rw = RED + (size_t)F.wave * NB * 96;
#pragma unroll
        for (int g = 0; g < 6; ++g) {
#pragma unroll
            for (int rg = 0; rg < 4; ++rg) rw[(1 + 4 * kh + rg) * 96 + 6 * jj + g] = acc[g][rg];
            if (kh == 0) rw[6 * jj + g] = a0[g]; }
        __syncthreads();
        for (int idx = F.tid; idx < NB * 96; idx += 512) { float t = 0.f;
#pragma unroll
            for (int w = 0; w < NWAVES; ++w) t += RED[w * NB * 96 + idx];
            const int bb = idx / 96, c = idx % 96; MOD[(size_t)bb * NMODC + col0 + c] = t + A.in[I_BADA][col0 + c]; }
        __syncthreads();
    }
}

template <bool PROMPT>
__device__ __forceinline__ void p1_row(Frame& F, KArgs& A, int m, const LAS f32x4* LA, const LAS f32x4* LC) {
    const float* MOD = (const float*)(A.ws + WS_MOD); bf16* H = (bf16*)(A.ws + WS_ACT);
    const f32x4* xr = (const f32x4*)xrow_of(A, m) + F.lane;
    f32x4 v[16]; float ss = 0.f;
#pragma unroll
    for (int j = 0; j < 16; ++j) { v[j] = __builtin_nontemporal_load(xr + 64 * j); ss += (v[j].x * v[j].x + v[j].y * v[j].y) + (v[j].z * v[j].z + v[j].w * v[j].w); }
    const float rstd = 1.0f / sqrtf(wave_sum(ss) * (1.0f / DM) + EPS);
    v2u* o = (v2u*)(H + (size_t)m * DM) + F.lane;
    if (PROMPT) {
#pragma unroll
        for (int j = 0; j < 16; ++j) { const f32x4 y = v[j] * rstd * LA[F.lane + 64 * j] + LC[F.lane + 64 * j]; v2u w; w.x = pk2(y.x, y.y); w.y = pk2(y.z, y.w); __builtin_nontemporal_store(w, o + 64 * j); if ((j & 3) == 3) asm volatile("" ::: "memory"); }
    } else {
        const f32x4* g4 = (const f32x4*)A.in[I_GPM] + F.lane;
        const float* mr = MOD + (size_t)modrow_of(m) * NMODC; const f32x4* sh4 = (const f32x4*)mr + F.lane; const f32x4* sc4 = (const f32x4*)(mr + DM) + F.lane;
#pragma unroll
        for (int j = 0; j < 16; ++j) { const f32x4 g = g4[64 * j], sc = sc4[64 * j], sh = sh4[64 * j];
            const f32x4 y = v[j] * rstd * g * (1.0f + sc) + sh; v2u w; w.x = pk2(y.x, y.y); w.y = pk2(y.z, y.w); __builtin_nontemporal_store(w, o + 64 * j); }
    }
}
__device__ __forceinline__ void p1_load(KArgs& A, int m, int lane, f32x4 (&v)[16]) {
    const f32x4* xr = (const f32x4*)xrow_of(A, m) + lane;
#pragma unroll
    for (int j = 0; j < 16; ++j) v[j] = __builtin_nontemporal_load(xr + 64 * j);
}
__device__ __forceinline__ void p1_proc(Frame& F, KArgs& A, int m, const f32x4 (&v)[16], const LAS f32x4* LA, const LAS f32x4* LC) {
    float ss = 0.f;
#pragma unroll
    for (int j = 0; j < 16; ++j) ss += (v[j].x * v[j].x + v[j].y * v[j].y) + (v[j].z * v[j].z + v[j].w * v[j].w);
    const float rstd = 1.0f / sqrtf(wave_sum(ss) * (1.0f / DM) + EPS);
    v2u* o = (v2u*)((bf16*)(A.ws + WS_ACT) + (size_t)m * DM) + F.lane;
#pragma unroll
    for (int j = 0; j < 16; ++j) { const f32x4 y = v[j] * rstd * LA[F.lane + 64 * j] + LC[F.lane + 64 * j]; v2u w; w.x = pk2(y.x, y.y); w.y = pk2(y.z, y.w); __builtin_nontemporal_store(w, o + 64 * j); if ((j & 3) == 3) asm volatile("" ::: "memory"); }
}
__device__ __forceinline__ void wg_sum2(Frame& F, float a, float b, LAS float* red, float& ta, float& tb) {
    a = wave_sum(a); b = wave_sum(b);
    if (F.lane == 0) { red[F.wave] = a; red[8 + F.wave] = b; }
    __syncthreads();
    ta = 0.f; tb = 0.f;
#pragma unroll
    for (int w = 0; w < NWAVES; ++w) { ta += red[w]; tb += red[8 + w]; }
}
__device__ __forceinline__ void p1_samples(Frame& F, KArgs& A) {
    LAS float* red = (LAS float*)(F.lds + 65536);
    const float* MOD = (const float*)(A.ws + WS_MOD);
    const int cb = 128 * F.wave + F.lane;
#pragma unroll 1
    for (int j = 0; F.vcu + j * F.G < M - SEQ; j += 2) {
        const int sra = F.vcu + j * F.G, srb_ = sra + F.G; const bool hasb = srb_ < M - SEQ; const int srb = hasb ? srb_ : sra;
        const int sr[2] = {sra, srb};
        f32x4 v[2][2]; float s0 = 0.f, s1 = 0.f;
#pragma unroll
        for (int r = 0; r < 2; ++r)
#pragma unroll
            for (int q = 0; q < 2; ++q) { v[r][q] = ((const f32x4*)(A.in[I_XS] + (size_t)sr[r] * DM))[cb + 64 * q];
                const float e = (v[r][q].x * v[r][q].x + v[r][q].y * v[r][q].y) + (v[r][q].z * v[r][q].z + v[r][q].w * v[r][q].w); if (r == 0) s0 += e; else s1 += e; }
        float t0, t1; wg_sum2(F, s0, s1, red, t0, t1);
        const float rstd[2] = {1.0f / sqrtf(t0 * (1.0f / DM) + EPS), 1.0f / sqrtf(t1 * (1.0f / DM) + EPS)};
#pragma unroll
        for (int r = 0; r < 2; ++r) { const float* mo = MOD + (size_t)(1 + (sr[r] >> 5)) * NMODC;
#pragma unroll
            for (int q = 0; q < 2; ++q) { const int ci = cb + 64 * q;
                const f32x4 y = v[r][q] * rstd[r] * ((const f32x4*)A.in[I_GPM])[ci] * (1.0f + ((const f32x4*)(mo + DM))[ci]) + ((const f32x4*)mo)[ci];
                if (r == 0 || hasb) { v2u w; w.x = pk2(y.x, y.y); w.y = pk2(y.z, y.w); ((v2u*)((bf16*)(A.ws + WS_ACT) + (size_t)(SEQ + sr[r]) * DM))[ci] = w; } } }
        __syncthreads();
    }
}
__device__ __forceinline__ void p1_h1(Frame& F, KArgs& A) {
    const int gw = F.vcu * NWAVES + F.wave, NGW = F.G * NWAVES;
    const float* MOD = (const float*)(A.ws + WS_MOD);
    LAS f32x4* LA = (LAS f32x4*)F.lds; LAS f32x4* LC = LA + DM / 4;
    for (int i = F.tid; i < DM / 4; i += NWAVES * 64) { const f32x4 g = ((const f32x4*)A.in[I_GPM])[i], sh = ((const f32x4*)MOD)[i], sc = ((const f32x4*)(MOD + DM))[i]; LA[i] = g * (1.0f + sc); LC[i] = sh; }
    __syncthreads();
    { f32x4 va[16], vb[16]; int m = gw;
      if (m < SEQ) p1_load(A, m, F.lane, va);
#pragma unroll 1
      for (; m < SEQ; m += 2 * NGW) {
          if (m + NGW < SEQ) p1_load(A, m + NGW, F.lane, vb);
          p1_proc(F, A, m, va, LA, LC);
          if (m + NGW < SEQ) { if (m + 2 * NGW < SEQ) p1_load(A, m + 2 * NGW, F.lane, va); p1_proc(F, A, m + NGW, vb, LA, LC); }
      } }
    p1_samples(F, A);
}

__device__ __forceinline__ void lru_unit(Frame& F, KArgs& A, int blk, int c, LAS unsigned char* wl, const LAS unsigned char* gw_lds) {
    int lane_ = F.lane; asm volatile("" : "+v"(lane_));
    const int lane = lane_, r = lane & 31, h = lane >> 5;
    const int row0 = 32 * c;
    const bf16* PROJ = (const bf16*)(A.ws + WS_PROJ);
    {
        const int cg = lane & 31, th = lane >> 5, chg = blk * LBLK + 4 * cg;
        const bf16* xp = PROJ + (size_t)row0 * DIN + 6144 + chg;
        const int t0 = 16 * th;
        v2u cur[16];
#pragma unroll
        for (int i = 0; i < 16; ++i) cur[i] = *(const v2u*)(xp + (size_t)(t0 + i) * DIN);
        f32x4 x3, x2, x1;
        if (th == 1 || (c > 0 && c < 512)) {
            const v2u a = *(const v2u*)(xp + (ptrdiff_t)(t0 - 3) * DIN), b = *(const v2u*)(xp + (ptrdiff_t)(t0 - 2) * DIN), d = *(const v2u*)(xp + (ptrdiff_t)(t0 - 1) * DIN);
            x3 = (f32x4){bf_lo(a.x), bf_hi(a.x), bf_lo(a.y), bf_hi(a.y)}; x2 = (f32x4){bf_lo(b.x), bf_hi(b.x), bf_lo(b.y), bf_hi(b.y)}; x1 = (f32x4){bf_lo(d.x), bf_hi(d.x), bf_lo(d.y), bf_hi(d.y)};
        } else if (c == 0) { x3 = x2 = x1 = (f32x4){0.f, 0.f, 0.f, 0.f}; }
        else { const float* st = A.in[I_SCL] + (size_t)(c - 512) * 3 * DLRU + chg;
            x3 = *(const f32x4*)(st); x2 = *(const f32x4*)(st + DLRU); x1 = *(const f32x4*)(st + 2 * DLRU); }
        const f32x4 w0 = *(const f32x4*)(A.in[I_WCL] + 0 * DLRU + chg), w1 = *(const f32x4*)(A.in[I_WCL] + 1 * DLRU + chg), w2 = *(const f32x4*)(A.in[I_WCL] + 2 * DLRU + chg),
                    w3 = *(const f32x4*)(A.in[I_WCL] + 3 * DLRU + chg), bb = *(const f32x4*)(A.in[I_BCL] + chg);
#pragma unroll
        for (int i = 0; i < 16; ++i) { const int t = t0 + i; const v2u a = cur[i];
            const f32x4 x0 = (f32x4){bf_lo(a.x), bf_hi(a.x), bf_lo(a.y), bf_hi(a.y)};
            const f32x4 y = bb + w3 * x0 + w2 * x1 + w1 * x2 + w0 * x3;
            v2u o; o.x = pk2(y.x, y.y); o.y = pk2(y.z, y.w); *(LAS v2u*)(wl + t * XROW + 8 * cg) = o;
            x3 = x2; x2 = x1; x1 = x0; }
    }
    LDS_WAIT(); asm volatile("" ::: "memory");
    bf16x8 af[8];
#pragma unroll
    for (int kk = 0; kk < 8; ++kk) af[kk] = *(const LAS bf16x8*)(wl + r * XROW + (16 * kk + 8 * h) * 2);
    unsigned* HP = (unsigned*)(A.ws + WS_HP);
#pragma unroll 1
    for (int nt = 0; nt < 4; ++nt) {
        const int dl = 32 * nt + r, ch = blk * LBLK + dl;
        const float bga = A.in[I_BGA][ch], bgx = A.in[I_BGX][ch], lam = A.in[I_LAM][ch];
        f32x16 ga, gx;
#pragma unroll
        for (int i = 0; i < 16; ++i) { ga[i] = 0.f; gx[i] = 0.f; }
#pragma unroll
        for (int kk = 0; kk < 8; ++kk) { const int off = dl * 256 + (((2 * kk + h) ^ (dl & 15)) << 4);
            const bf16x8 fa = *(const LAS bf16x8*)(gw_lds + off), fx = *(const LAS bf16x8*)(gw_lds + 32768 + off);
            ga = __builtin_amdgcn_mfma_f32_32x32x16_bf16(af[kk], fa, ga, 0, 0, 0); gx = __builtin_amdgcn_mfma_f32_32x32x16_bf16(af[kk], fx, gx, 0, 0, 0); }
        const float spl8 = 8.0f * (fmaxf(-lam, 0.f) + 0.6931471805599453f * flog2(1.0f + fexp2(-1.4426950408889634f * fabsf(lam))));
#pragma unroll
        for (int i = 0; i < 16; ++i) { const int t = (i & 3) + 8 * (i >> 2) + 4 * h;
            const float xc = __builtin_bit_cast(float, (unsigned)(*(const LAS unsigned short*)(wl + t * XROW + 2 * dl)) << 16);
            const float rg = sigmoidf_(ga[i] + bga), ig = sigmoidf_(gx[i] + bgx);
            const float la = -rg * spl8, x2 = 2.0f * la, av = fexp2(1.4426950408889634f * la);
            const float om = (x2 > -0.125f) ? -x2 * (1.0f + x2 * (0.5f + x2 * (0.16666667f + x2 * (0.041666668f + x2 * 0.0083333338f)))) : 1.0f - av * av;
            ga[i] = av; gx[i] = fsqrt(om) * (ig * xc); }
        float TH[4], TP[4], OH[4], OP[4];
#pragma unroll
        for (int a = 0; a < 4; ++a) { float hl = 0.f, pl = 1.f;
#pragma unroll
            for (int e = 0; e < 4; ++e) { hl = ga[4 * a + e] * hl + gx[4 * a + e]; pl = pl * ga[4 * a + e]; gx[4 * a + e] = hl; ga[4 * a + e] = pl; }
            TH[a] = hl; TP[a] = pl; }
#pragma unroll
        for (int a = 0; a < 4; ++a) { OH[a] = __shfl_xor(TH[a], 32); OP[a] = __shfl_xor(TP[a], 32); }
        float hs = 0.f, pc = 1.f, cH[4], cP[4];
#pragma unroll
        for (int a = 0; a < 4; ++a) {
            const float eH = h ? OH[a] : TH[a], eP = h ? OP[a] : TP[a], oH = h ? TH[a] : OH[a], oP = h ? TP[a] : OP[a];
            const float h1 = eP * hs + eH, p1 = pc * eP;
            cH[a] = h ? h1 : hs; cP[a] = h ? p1 : pc;
            hs = oP * h1 + oH; pc = p1 * oP; }
#pragma unroll
        for (int a = 0; a < 4; ++a)
#pragma unroll
            for (int e = 0; e < 4; ++e) { gx[4 * a + e] = gx[4 * a + e] + ga[4 * a + e] * cH[a]; ga[4 * a + e] = ga[4 * a + e] * cP[a]; }
#pragma unroll
        for (int i = 0; i < 16; ++i) { const int t = (i & 3) + 8 * (i >> 2) + 4 * h; HP[(size_t)(row0 + t) * DLRU + ch] = pk2(gx[i], ga[i]); }
        if (h == 0) { ((float*)(A.ws + WS_AGGH))[(size_t)c * DLRU + ch] = hs; ((float*)(A.ws + WS_AGGA))[(size_t)c * DLRU + ch] = pc; }
    }
    LDS_WAIT(); asm volatile("" ::: "memory");
}

__device__ __forceinline__ s16x4 vtr(const LAS unsigned char* p) { typedef short v4i16_t __attribute__((ext_vector_type(4))); return __builtin_bit_cast(s16x4, __builtin_amdgcn_ds_read_tr16_b64_v4i16((LAS v4i16_t*)p)); }
__device__ __forceinline__ unsigned cvtpk(float lo, float hi) { return pk2(lo, hi); }
__device__ __forceinline__ f32x16 sb_qk(const bf16x8 (&kf)[8], const bf16x8 (&qf)[8]) {
    f32x16 s;
#pragma unroll
    for (int i = 0; i < 16; ++i) s[i] = 0.f;
#pragma unroll
    for (int kk = 0; kk < 8; ++kk) s = __builtin_amdgcn_mfma_f32_32x32x16_bf16(kf[kk], qf[kk], s, 0, 0, 0);
    return s;
}
template <bool DIAG>
__device__ __forceinline__ void sb_weights(const f32x16& s, float& R, int lane, bf16x8 (&wa)[2]) {
    const int r = lane & 31, h = lane >> 5;
    float lb[16], lk[16];
#pragma unroll
    for (int i = 0; i < 16; ++i) { const float z = s[i] * 0.12751743082459868f;
        const float sp = fmaxf(-z, 0.f) + flog2(1.0f + fexp2(-fabsf(z)));
        lb[i] = -sp; lk[i] = -sp - z;
        if (DIAG) { const int key = (i & 3) + 8 * (i >> 2) + 4 * h; if (!(key < r)) lk[i] = 0.f; } }
    float p[16], tot[4], oth[4];
#pragma unroll
    for (int a = 0; a < 4; ++a) { p[4 * a + 3] = 0.f; p[4 * a + 2] = lk[4 * a + 3]; p[4 * a + 1] = p[4 * a + 2] + lk[4 * a + 2]; p[4 * a] = p[4 * a + 1] + lk[4 * a + 1]; tot[a] = p[4 * a] + lk[4 * a]; }
#pragma unroll
    for (int a = 0; a < 4; ++a) oth[a] = __shfl_xor(tot[a], 32);
    float E[4], Od[4];
#pragma unroll
    for (int a = 0; a < 4; ++a) { E[a] = h ? oth[a] : tot[a]; Od[a] = h ? tot[a] : oth[a]; }
    float suf[8]; suf[7] = 0.f; suf[6] = Od[3]; suf[5] = suf[6] + E[3]; suf[4] = suf[5] + Od[2]; suf[3] = suf[4] + E[2]; suf[2] = suf[3] + Od[1]; suf[1] = suf[2] + E[1]; suf[0] = suf[1] + Od[0];
    const float total = suf[0] + E[0];
    float w[16];
#pragma unroll
    for (int a = 0; a < 4; ++a) { const float off = R + (h ? suf[2 * a + 1] : suf[2 * a]);
#pragma unroll
        for (int e = 0; e < 4; ++e) { const int i = 4 * a + e; float x = fexp2(lb[i] + off + p[i]);
            if (DIAG) { const int key = e + 8 * a + 4 * h; if (!(key < r)) x = 0.f; }
            w[i] = x; } }
    R += total;
#pragma unroll
    for (int st = 0; st < 2; ++st) {
        v4u pa; pa.x = cvtpk(w[8 * st], w[8 * st + 1]); pa.y = cvtpk(w[8 * st + 2], w[8 * st + 3]); pa.z = cvtpk(w[8 * st + 4], w[8 * st + 5]); pa.w = cvtpk(w[8 * st + 6], w[8 * st + 7]);
        wa[st] = __builtin_bit_cast(bf16x8, pa); }
}
__device__ __forceinline__ void sb_pv(const bf16x8 (&wa)[2], f32x16 (&o)[4], const LAS unsigned char* vl, int lane) {
    const int h = lane >> 5, i16 = lane & 15, q = i16 >> 2, pp = i16 & 3, rb = (lane >> 4) & 1;
#pragma unroll
    for (int st = 0; st < 2; ++st) {
        const LAS unsigned char* vb = vl + (16 * st + 4 * h + q) * VROW + (16 * rb + 4 * pp) * 2;
        s16x4 vlo[4], vhi[4];
#pragma unroll
        for (int dt = 0; dt < 4; ++dt) { vlo[dt] = vtr(vb + 64 * dt); vhi[dt] = vtr(vb + 8 * VROW + 64 * dt); }
        __builtin_amdgcn_sched_barrier(0);
#pragma unroll
        for (int dt = 0; dt < 4; ++dt) { const bf16x8 f = __builtin_shufflevector(vlo[dt], vhi[dt], 0, 1, 2, 3, 4, 5, 6, 7);
            o[dt] = __builtin_amdgcn_mfma_f32_32x32x16_bf16(wa[st], f, o[dt], 0, 0, 0); }
    }
}
__device__ __forceinline__ void attn_load_kv(KArgs& A, const bf16* PROJ, int sb, int head, int qrow0, int j, int lane, v4u (&kr)[8], v4u (&vv)[8]) {
    const int vrow = lane >> 4, vch = lane & 15;
    if (sb < 0 || j == 0) {
        const int krow0 = qrow0 - 32 * j;
        const bf16* kp = PROJ + (size_t)(krow0 + vrow) * DIN + DSB + head * HD + 8 * vch;
#pragma unroll
        for (int i = 0; i < 8; ++i) kr[i] = *(const v4u*)(kp + (size_t)(4 * i) * DIN);
        const bf16* vp = kp + DSB;
#pragma unroll
        for (int i = 0; i < 8; ++i) vv[i] = *(const v4u*)(vp + (size_t)(4 * i) * DIN);
    } else {
        const int pos0 = PAST - 32 * j;
        const size_t off = (((size_t)sb * PAST + pos0 + vrow) * NH + head) * HD + 8 * vch;
        const float* kp = A.in[I_CK] + off;
#pragma unroll
        for (int i = 0; i < 8; ++i) { const float* k = kp + (size_t)(4 * i) * NH * HD; const f32x4 a = *(const f32x4*)k, b = *(const f32x4*)(k + 4);
            v4u t; t.x = pk2(a.x, a.y); t.y = pk2(a.z, a.w); t.z = pk2(b.x, b.y); t.w = pk2(b.z, b.w); kr[i] = t; }
        const float* vp = A.in[I_CV] + off;
#pragma unroll
        for (int i = 0; i < 8; ++i) { const float* v = vp + (size_t)(4 * i) * NH * HD; const f32x4 a = *(const f32x4*)v, b = *(const f32x4*)(v + 4);
            v4u t; t.x = pk2(a.x, a.y); t.y = pk2(a.z, a.w); t.z = pk2(b.x, b.y); t.w = pk2(b.z, b.w); vv[i] = t; }
    }
}
constexpr int KROW = 272;
__device__ __forceinline__ f32x16 attn_stage_qk(LAS unsigned char* wl, int lane, const v4u (&kr)[8], const v4u (&vn)[8], const bf16x8 (&qf)[8]) {
    const int r = lane & 31, h = lane >> 5, vrow = lane >> 4, vch = lane & 15;
#pragma unroll
    for (int i = 0; i < 8; ++i) *(LAS v4u*)(wl + (4 * i + vrow) * KROW + 16 * vch) = kr[i];
    LDS_WAIT(); asm volatile("" ::: "memory");
    f32x16 s;
#pragma unroll
    for (int i = 0; i < 16; ++i) s[i] = 0.f;
    const LAS unsigned char* kb = wl + r * KROW + 16 * h;
#pragma unroll
    for (int hf = 0; hf < 2; ++hf) {
        bf16x8 kf[4];
#pragma unroll
        for (int kk = 0; kk < 4; ++kk) kf[kk] = *(const LAS bf16x8*)(kb + 32 * (4 * hf + kk));
        LDS_WAIT(); asm volatile("" ::: "memory");
#pragma unroll
        for (int kk = 0; kk < 4; ++kk) s = __builtin_amdgcn_mfma_f32_32x32x16_bf16(kf[kk], qf[4 * hf + kk], s, 0, 0, 0);
    }
#pragma unroll
    for (int i = 0; i < 8; ++i) *(LAS v4u*)(wl + (4 * i + vrow) * VROW + 16 * vch) = vn[i];
    return s;
}
__device__ __forceinline__ void attn_unit(Frame& F, KArgs& A, int unit, LAS unsigned char* wl) {
    int lane_ = F.lane; asm volatile("" : "+v"(lane_));
    const int lane = lane_, r = lane & 31, h = lane >> 5;
    const bf16* PROJ = (const bf16*)(A.ws + WS_PROJ);
    int head, qrow0, npast, sb = -1;
    if (unit < 512 * NH) { head = unit >> 9; const int qb = unit & 511; qrow0 = 32 * qb; npast = qb; }
    else { const int us = unit - 512 * NH; sb = us >> 4; head = us & 15; qrow0 = SEQ + 32 * sb; npast = PAST / 32; }
    bf16x8 qf[8]; v4u kr[8], vn[8];
    attn_load_kv(A, PROJ, sb, head, qrow0, 0, lane, kr, vn);
    { const bf16* qp = PROJ + (size_t)(qrow0 + r) * DIN + head * HD + 8 * h;
#pragma unroll
      for (int kk = 0; kk < 8; ++kk) qf[kk] = *(const bf16x8*)(qp + 16 * kk); }
    f32x16 o[4];
#pragma unroll
    for (int dt = 0; dt < 4; ++dt)
#pragma unroll
        for (int i = 0; i < 16; ++i) o[dt][i] = 0.f;
    float R = 0.f;
    { const f32x16 s = attn_stage_qk(wl, lane, kr, vn, qf); bf16x8 wa[2];
      sb_weights<true>(s, R, lane, wa);
      __builtin_amdgcn_sched_barrier(0);
      if (npast > 0) attn_load_kv(A, PROJ, sb, head, qrow0, 1, lane, kr, vn);
      LDS_WAIT(); asm volatile("" ::: "memory");
      sb_pv(wa, o, wl, lane); }
#pragma unroll 1
    for (int j = 1; j <= npast; ++j) {
        if (__all(R < -152.0f)) break;
        LDS_WAIT(); asm volatile("" ::: "memory");
        const f32x16 s = attn_stage_qk(wl, lane, kr, vn, qf); bf16x8 wa[2];
        sb_weights<false>(s, R, lane, wa);
        __builtin_amdgcn_sched_barrier(0);
        if (j < npast) attn_load_kv(A, PROJ, sb, head, qrow0, j + 1, lane, kr, vn);
        LDS_WAIT(); asm volatile("" ::: "memory");
        sb_pv(wa, o, wl, lane);
    }
    LDS_WAIT(); asm volatile("" ::: "memory");
    bf16* OSB = (bf16*)(A.ws + WS_OSB);
#pragma unroll
    for (int dt = 0; dt < 4; ++dt)
#pragma unroll
        for (int i = 0; i < 16; ++i) { const int qq = (i & 3) + 8 * (i >> 2) + 4 * h; OSB[(size_t)(qrow0 + qq) * DSB + head * HD + 32 * dt + r] = (bf16)f2bf(o[dt][i]); }
}
__device__ __forceinline__ void lru_load_weights(LAS unsigned char* lds, const bf16* GT, int blk, int tid) {
    for (int idx = tid; idx < 2 * LBLK * 16; idx += NWAVES * 64) { const int gate = idx >> 11, row = (idx >> 4) & 127, ch = idx & 15;
        const v4u w = *(const v4u*)(GT + ((size_t)(gate * NBLK + blk) * LBLK + row) * LBLK + 8 * ch);
        *(LAS v4u*)(lds + gate * 32768 + row * 256 + ((ch ^ (row & 15)) << 4)) = w; }
}
__device__ __forceinline__ void p3_mixers(Frame& F, KArgs& A) {
    const int gw = F.vcu * NWAVES + F.wave, NGW = F.G * NWAVES;
    LAS unsigned char* wl = F.wave < 7 ? F.lds + 65536 + F.wave * WAVE_LDS : F.lds + EXCH_OFF;
    static_assert(65536 + 7 * WAVE_LDS <= RING_BYTES && EXCH_OFF + WAVE_LDS <= LDS_BYTES, "P3 LDS map");
    bool first = true;
#pragma unroll 1
    for (int p = F.vcu; first || p < NBLK * 16; p += F.G) {
        const bool has_pair = p < NBLK * 16; const int blk = has_pair ? p >> 4 : 0, slot = p & 15;
        if (!first) __syncthreads();
        lru_load_weights(F.lds, (const bf16*)(A.ws + WS_GATET), blk, F.tid);
        __syncthreads();
#pragma unroll 1
        for (int pass = 0; pass < 2; ++pass) {
            if ((pass ^ (F.wave >> 2)) == 0) {
#pragma unroll 1
                for (int k = 0; has_pair; ++k) {
                    int i;
                    if (F.G == 256) { const int w = F.wave; const bool light = (w == 5 || w == 6);
                        if (k < 3 || (k == 3 && !light)) i = w + 8 * k; else if (k == 4 && w >= 1 && w <= 3) i = (w == 1) ? 29 : (w == 2) ? 30 : 32; else break; }
                    else { i = F.wave + NWAVES * k; if (i >= 33) break; }
                    lru_unit(F, A, blk, 33 * slot + i, wl, F.lds); }
            } else if (first) {
#pragma unroll 1
                for (int k = 0;; ++k) {
                    int u;
                    if (F.G == 256) {
                        int kk;
                        if (F.wave < 7) { if (k < 4) kk = F.wave + 8 * k; else if (k == 4 && F.wave >= 5) kk = (F.wave == 5) ? 23 : 31; else break; u = F.vcu * 32 + kk; }
                        else { if (k == 0) u = 512 * NH + F.vcu; else if (k < 3) u = F.vcu * 32 + 7 + 8 * (k - 1); else break; }
                    } else {
                        u = gw + k * NGW;
                        if (u >= 512 * NH) { const int e = F.vcu + ((u - 512 * NH) / NGW) * F.G; if (F.wave != NWAVES - 1 || e >= NDEC * NH) break; u = 512 * NH + e; }
                    }
                    attn_unit(F, A, u, wl); }
            }
        }
        first = false;
    }
}

__device__ __forceinline__ void p4_carry(Frame& F, KArgs& A) {
    const float* AGA = (const float*)(A.ws + WS_AGGA); const float* AGH = (const float*)(A.ws + WS_AGGH); float* CARRY = (float*)(A.ws + WS_CARRY);
    LAS float* LA = (LAS float*)F.lds; LAS float* LH = LA + 512;
    for (int j = F.vcu; j < DLRU / 32; j += F.G) {
        const int g = F.tid >> 5, cl = F.tid & 31, ch = 32 * j + cl;
        float a[32], hh[32]; float ca = 1.f, chh = 0.f;
#pragma unroll
        for (int i = 0; i < 32; ++i) { a[i] = AGA[(size_t)(32 * g + i) * DLRU + ch]; hh[i] = AGH[(size_t)(32 * g + i) * DLRU + ch]; }
#pragma unroll
        for (int i = 0; i < 32; ++i) { chh = a[i] * chh + hh[i]; ca = a[i] * ca; }
        __syncthreads();
        LA[g * 32 + cl] = ca; LH[g * 32 + cl] = chh;
        __syncthreads();
        float cin = 0.f;
        for (int gg = 0; gg < g; ++gg) cin = LA[gg * 32 + cl] * cin + LH[gg * 32 + cl];
#pragma unroll
        for (int i = 0; i < 32; ++i) { CARRY[(size_t)(32 * g + i) * DLRU + ch] = cin; cin = a[i] * cin + hh[i]; }
        if (g == 15) A.out[OUT_LP + ch] = cin;
        { const int b = g, c = 512 + b; const float h0 = A.in[I_SL][(size_t)b * DLRU + ch];
          CARRY[(size_t)c * DLRU + ch] = h0; A.out[OUT_LS + (size_t)b * DLRU + ch] = AGH[(size_t)c * DLRU + ch] + AGA[(size_t)c * DLRU + ch] * h0; }
    }
}

__device__ __forceinline__ void p5_mixnorm(Frame& F, KArgs& A) {
    const int gw = F.vcu * NWAVES + F.wave, NGW = F.G * NWAVES, lane = F.lane;
    const bf16* PROJ = (const bf16*)(A.ws + WS_PROJ); const bf16* OSB = (const bf16*)(A.ws + WS_OSB);
    const unsigned* HP = (const unsigned*)(A.ws + WS_HP); const float* CARRY = (const float*)(A.ws + WS_CARRY);
    bf16* A2 = (bf16*)(A.ws + WS_ACT);
    LAS float* LG = (LAS float*)F.lds;
    for (int i = F.tid; i < DSB; i += NWAVES * 64) { LG[i] = A.in[I_GGA][i]; LG[DSB + i] = A.in[I_GGL][i]; }
    __syncthreads();
    for (int m = gw; m < SEQ; m += NGW) {
        v4u ow[4], hq0[4], hq1[4], glw[4]; f32x4 cr0[4], cr1[4]; const int c = m >> 5;
#pragma unroll
        for (int j = 0; j < 4; ++j) { const int col = 8 * lane + 512 * j; const size_t o = (size_t)m * DLRU + col;
            ow[j] = __builtin_nontemporal_load((const v4u*)(OSB + (size_t)m * DSB + col));
            hq0[j] = __builtin_nontemporal_load((const v4u*)(HP + o)); hq1[j] = __builtin_nontemporal_load((const v4u*)(HP + o + 4));
            cr0[j] = *(const f32x4*)(CARRY + (size_t)c * DLRU + col); cr1[j] = *(const f32x4*)(CARRY + (size_t)c * DLRU + col + 4);
            glw[j] = *(const v4u*)(PROJ + (size_t)m * DIN + 8192 + col); }
        { float v[32]; float ss = 0.f;
#pragma unroll
          for (int j = 0; j < 4; ++j) { const v4u w = ow[j];
              v[8 * j] = bf_lo(w.x); v[8 * j + 1] = bf_hi(w.x); v[8 * j + 2] = bf_lo(w.y); v[8 * j + 3] = bf_hi(w.y); v[8 * j + 4] = bf_lo(w.z); v[8 * j + 5] = bf_hi(w.z); v[8 * j + 6] = bf_lo(w.w); v[8 * j + 7] = bf_hi(w.w); }
#pragma unroll
          for (int i = 0; i < 32; ++i) ss += v[i] * v[i];
          const float rstd = 1.0f / sqrtf(wave_sum(ss) * (1.0f / DSB) + EPS);
#pragma unroll
          for (int j = 0; j < 4; ++j) { const LAS float* g = LG + 8 * lane + 512 * j; const f32x4 g0 = *(const LAS f32x4*)g, g1 = *(const LAS f32x4*)(g + 4);
              v4u w; w.x = pk2(v[8 * j] * rstd * g0.x, v[8 * j + 1] * rstd * g0.y); w.y = pk2(v[8 * j + 2] * rstd * g0.z, v[8 * j + 3] * rstd * g0.w);
              w.z = pk2(v[8 * j + 4] * rstd * g1.x, v[8 * j + 5] * rstd * g1.y); w.w = pk2(v[8 * j + 6] * rstd * g1.z, v[8 * j + 7] * rstd * g1.w);
              __builtin_nontemporal_store(w, (v4u*)(A2 + (size_t)m * DM + 8 * lane + 512 * j)); } }
        { float v[32]; float ss = 0.f;
#pragma unroll
          for (int j = 0; j < 4; ++j) {
              const v4u q0 = hq0[j], q1 = hq1[j];
              const f32x4 h0 = (f32x4){bf_lo(q0.x), bf_lo(q0.y), bf_lo(q0.z), bf_lo(q0.w)}, h1 = (f32x4){bf_lo(q1.x), bf_lo(q1.y), bf_lo(q1.z), bf_lo(q1.w)}, p0 = (f32x4){bf_hi(q0.x), bf_hi(q0.y), bf_hi(q0.z), bf_hi(q0.w)}, p1 = (f32x4){bf_hi(q1.x), bf_hi(q1.y), bf_hi(q1.z), bf_hi(q1.w)};
              const f32x4 c0 = cr0[j], c1 = cr1[j];
              const v4u gw4 = glw[j];
              const f32x4 a0 = h0 + p0 * c0, a1 = h1 + p1 * c1;
              v[8 * j] = a0.x * gelu_tanh(bf_lo(gw4.x)); v[8 * j + 1] = a0.y * gelu_tanh(bf_hi(gw4.x)); v[8 * j + 2] = a0.z * gelu_tanh(bf_lo(gw4.y)); v[8 * j + 3] = a0.w * gelu_tanh(bf_hi(gw4.y));
              v[8 * j + 4] = a1.x * gelu_tanh(bf_lo(gw4.z)); v[8 * j + 5] = a1.y * gelu_tanh(bf_hi(gw4.z)); v[8 * j + 6] = a1.z * gelu_tanh(bf_lo(gw4.w)); v[8 * j + 7] = a1.w * gelu_tanh(bf_hi(gw4.w)); }
#pragma unroll
          for (int i = 0; i < 32; ++i) ss += v[i] * v[i];
          const float rstd = 1.0f / sqrtf(wave_sum(ss) * (1.0f / DLRU) + EPS);
#pragma unroll
          for (int j = 0; j < 4; ++j) { const LAS float* g = LG + DSB + 8 * lane + 512 * j; const f32x4 g0 = *(const LAS f32x4*)g, g1 = *(const LAS f32x4*)(g + 4);
              v4u w; w.x = pk2(v[8 * j] * rstd * g0.x, v[8 * j + 1] * rstd * g0.y); w.y = pk2(v[8 * j + 2] * rstd * g0.z, v[8 * j + 3] * rstd * g0.w);
              w.z = pk2(v[8 * j + 4] * rstd * g1.x, v[8 * j + 5] * rstd * g1.y); w.w = pk2(v[8 * j + 6] * rstd * g1.z, v[8 * j + 7] * rstd * g1.w);
              __builtin_nontemporal_store(w, (v4u*)(A2 + (size_t)m * DM + DSB + 8 * lane + 512 * j)); } }
    }
    { LAS float* red = (LAS float*)(F.lds + 65536); const int c4 = 4 * (64 * F.wave + lane);
#pragma unroll 1
      for (int j = 0; F.vcu + j * F.G < M - SEQ; j += 2) {
          const int sra = F.vcu + j * F.G, srb_ = sra + F.G; const bool hasb = srb_ < M - SEQ; const int srb = hasb ? srb_ : sra;
          const int mr[2] = {SEQ + sra, SEQ + srb};
          f32x4 va[2], vl[2]; float sa0 = 0.f, sa1 = 0.f, sl0 = 0.f, sl1 = 0.f;
#pragma unroll
          for (int r = 0; r < 2; ++r) { const int m = mr[r];
              const v2u ow = *(const v2u*)(OSB + (size_t)m * DSB + c4); va[r] = (f32x4){bf_lo(ow.x), bf_hi(ow.x), bf_lo(ow.y), bf_hi(ow.y)};
              const v4u hq = *(const v4u*)(HP + (size_t)m * DLRU + c4); const f32x4 cr = *(const f32x4*)(CARRY + (size_t)(m >> 5) * DLRU + c4); const v2u gw2 = *(const v2u*)(PROJ + (size_t)m * DIN + 8192 + c4);
              const f32x4 hh = (f32x4){bf_lo(hq.x), bf_lo(hq.y), bf_lo(hq.z), bf_lo(hq.w)} + (f32x4){bf_hi(hq.x), bf_hi(hq.y), bf_hi(hq.z), bf_hi(hq.w)} * cr;
              vl[r] = (f32x4){hh.x * gelu_tanh(bf_lo(gw2.x)), hh.y * gelu_tanh(bf_hi(gw2.x)), hh.z * gelu_tanh(bf_lo(gw2.y)), hh.w * gelu_tanh(bf_hi(gw2.y))};
              const float ea = (va[r].x * va[r].x + va[r].y * va[r].y) + (va[r].z * va[r].z + va[r].w * va[r].w), el = (vl[r].x * vl[r].x + vl[r].y * vl[r].y) + (vl[r].z * vl[r].z + vl[r].w * vl[r].w);
              if (r == 0) { sa0 += ea; sl0 += el; } else { sa1 += ea; sl1 += el; } }
          float ta0, ta1, tl0, tl1; wg_sum2(F, sa0, sa1, red, ta0, ta1); wg_sum2(F, sl0, sl1, red + 16, tl0, tl1);
          const float ra[2] = {1.0f / sqrtf(ta0 * (1.0f / DSB) + EPS), 1.0f / sqrtf(ta1 * (1.0f / DSB) + EPS)}, rl[2] = {1.0f / sqrtf(tl0 * (1.0f / DLRU) + EPS), 1.0f / sqrtf(tl1 * (1.0f / DLRU) + EPS)};
          const f32x4 ga = *(const LAS f32x4*)(LG + c4), gl4 = *(const LAS f32x4*)(LG + DSB + c4);
#pragma unroll
          for (int r = 0; r < 2; ++r) if (r == 0 || hasb) { const f32x4 ya = va[r] * ra[r] * ga, yl = vl[r] * rl[r] * gl4;
              v2u w; w.x = pk2(ya.x, ya.y); w.y = pk2(ya.z, ya.w); *(v2u*)(A2 + (size_t)mr[r] * DM + c4) = w;
              w.x = pk2(yl.x, yl.y); w.y = pk2(yl.z, yl.w); *(v2u*)(A2 + (size_t)mr[r] * DM + DSB + c4) = w; }
          __syncthreads();
      } }
}

template <bool PROMPT>
__device__ __forceinline__ void p7_row(Frame& F, KArgs& A, int m, const LAS f32x4* LA, const LAS f32x4* LB, const LAS f32x4* LC) {
    const int lane = F.lane;
    const float* MOD = (const float*)(A.ws + WS_MOD); const bf16* MIX = (const bf16*)(A.ws + WS_MIX); bf16* H = (bf16*)(A.ws + WS_ACT);
    const f32x4* xr = (const f32x4*)xrow_of(A, m) + lane;
    f32x4 v[16]; float ss = 0.f;
    if (PROMPT) {
#pragma unroll
        for (int j = 0; j < 16; ++j) { const v2u w = __builtin_nontemporal_load((const v2u*)(MIX + (size_t)m * DM) + lane + 64 * j); v[j] = (f32x4){bf_lo(w.x), bf_hi(w.x), bf_lo(w.y), bf_hi(w.y)}; }
    } else {
#pragma unroll
        for (int j = 0; j < 16; ++j) v[j] = (f32x4){0.f, 0.f, 0.f, 0.f};
#pragma unroll 1
        for (int ks = 0; ks < KS_OUT; ++ks) { const f32x4* pr = (const f32x4*)(A.ws + WS_PART) + ((size_t)ks * (M - SEQ) + (m - SEQ)) * (DM / 4) + lane;
#pragma unroll
            for (int j = 0; j < 16; ++j) v[j] += pr[64 * j]; }
    }
#pragma unroll
    for (int j = 0; j < 16; ++j) ss += (v[j].x * v[j].x + v[j].y * v[j].y) + (v[j].z * v[j].z + v[j].w * v[j].w);
    const float rstd = 1.0f / sqrtf(wave_sum(ss) * (1.0f / DM) + EPS);
    v2u* xo = (v2u*)((bf16*)(A.ws + WS_X1) + (size_t)m * DM) + lane; float s2 = 0.f;
    const float* mo = MOD + (size_t)modrow_of(m) * NMODC;
#pragma unroll
    for (int j = 0; j < 16; ++j) { const f32x4 ca = PROMPT ? LA[lane + 64 * j] : ((const f32x4*)(mo + 2 * DM) + lane)[64 * j] * ((const f32x4*)A.in[I_GPOM] + lane)[64 * j];
        const f32x4 x1 = __builtin_nontemporal_load(xr + 64 * j) + ca * (v[j] * rstd); v[j] = x1; { v2u w; w.x = pk2(x1.x, x1.y); w.y = pk2(x1.z, x1.w); __builtin_nontemporal_store(w, xo + 64 * j); }
        s2 += (x1.x * x1.x + x1.y * x1.y) + (x1.z * x1.z + x1.w * x1.w); if ((j & 3) == 3) asm volatile("" ::: "memory"); }
    const float rstd2 = 1.0f / sqrtf(wave_sum(s2) * (1.0f / DM) + EPS);
    v2u* o = (v2u*)(H + (size_t)m * DM) + lane;
#pragma unroll
    for (int j = 0; j < 16; ++j) { const f32x4 cb = PROMPT ? LB[lane + 64 * j] : ((const f32x4*)A.in[I_GPF] + lane)[64 * j] * (1.0f + ((const f32x4*)(mo + 4 * DM) + lane)[64 * j]), cc = PROMPT ? LC[lane + 64 * j] : ((const f32x4*)(mo + 3 * DM) + lane)[64 * j];
        const f32x4 y = v[j] * rstd2 * cb + cc; v2u w; w.x = pk2(y.x, y.y); w.y = pk2(y.z, y.w); __builtin_nontemporal_store(w, o + 64 * j); if ((j & 3) == 3) asm volatile("" ::: "memory"); }
}
__device__ __forceinline__ void p7_load(KArgs& A, int m, int lane, v2u (&mx)[16], f32x4 (&x)[16]) {
    const v2u* mr = (const v2u*)((const bf16*)(A.ws + WS_MIX) + (size_t)m * DM) + lane; const f32x4* xr = (const f32x4*)(A.in[I_XP] + (size_t)m * DM) + lane;
#pragma unroll
    for (int j = 0; j < 16; ++j) { mx[j] = __builtin_nontemporal_load(mr + 64 * j); x[j] = __builtin_nontemporal_load(xr + 64 * j); }
}
__device__ __forceinline__ void p7_proc(Frame& F, KArgs& A, int m, const v2u (&mx)[16], f32x4 (&x)[16], const LAS f32x4* LA, const LAS f32x4* LB, const LAS f32x4* LC) {
    const int lane = F.lane; float ss = 0.f;
#pragma unroll
    for (int j = 0; j < 16; ++j) { const f32x4 v = (f32x4){bf_lo(mx[j].x), bf_hi(mx[j].x), bf_lo(mx[j].y), bf_hi(mx[j].y)}; ss += (v.x * v.x + v.y * v.y) + (v.z * v.z + v.w * v.w); }
    const float rstd = 1.0f / sqrtf(wave_sum(ss) * (1.0f / DM) + EPS);
    v2u* xo = (v2u*)((bf16*)(A.ws + WS_X1) + (size_t)m * DM) + lane; float s2 = 0.f;
#pragma unroll
    for (int j = 0; j < 16; ++j) { const f32x4 v = (f32x4){bf_lo(mx[j].x), bf_hi(mx[j].x), bf_lo(mx[j].y), bf_hi(mx[j].y)};
        const f32x4 x1 = x[j] + LA[lane + 64 * j] * (v * rstd); x[j] = x1; { v2u w; w.x = pk2(x1.x, x1.y); w.y = pk2(x1.z, x1.w); __builtin_nontemporal_store(w, xo + 64 * j); }
        s2 += (x1.x * x1.x + x1.y * x1.y) + (x1.z * x1.z + x1.w * x1.w); if ((j & 3) == 3) asm volatile("" ::: "memory"); }
    const float rstd2 = 1.0f / sqrtf(wave_sum(s2) * (1.0f / DM) + EPS);
    v2u* o = (v2u*)((bf16*)(A.ws + WS_ACT) + (size_t)m * DM) + lane;
#pragma unroll
    for (int j = 0; j < 16; ++j) { const f32x4 y = x[j] * rstd2 * LB[lane + 64 * j] + LC[lane + 64 * j]; v2u w; w.x = pk2(y.x, y.y); w.y = pk2(y.z, y.w); __builtin_nontemporal_store(w, o + 64 * j); if ((j & 3) == 3) asm volatile("" ::: "memory"); }
}
__device__ __forceinline__ void p7_samples(Frame& F, KArgs& A) {
    LAS float* red = (LAS float*)(F.lds + 65536);
    const float* MOD = (const float*)(A.ws + WS_MOD);
    const int cb = 128 * F.wave + F.lane;
#pragma unroll 1
    for (int j = 0; F.vcu + j * F.G < M - SEQ; j += 2) {
        const int sra = F.vcu + j * F.G, srb_ = sra + F.G; const bool hasb = srb_ < M - SEQ; const int srb = hasb ? srb_ : sra;
        const int sr[2] = {sra, srb};
        f32x4 v[2][2];
#pragma unroll
        for (int r = 0; r < 2; ++r)
#pragma unroll
            for (int q = 0; q < 2; ++q) v[r][q] = (f32x4){0.f, 0.f, 0.f, 0.f};
#pragma unroll
        for (int ks = 0; ks < KS_OUT; ++ks)
#pragma unroll
            for (int r = 0; r < 2; ++r)
#pragma unroll
                for (int q = 0; q < 2; ++q) v[r][q] += ((const f32x4*)(A.ws + WS_PART))[((size_t)ks * (M - SEQ) + sr[r]) * (DM / 4) + cb + 64 * q];
        float s0 = 0.f, s1 = 0.f;
#pragma unroll
        for (int q = 0; q < 2; ++q) { s0 += (v[0][q].x * v[0][q].x + v[0][q].y * v[0][q].y) + (v[0][q].z * v[0][q].z + v[0][q].w * v[0][q].w); s1 += (v[1][q].x * v[1][q].x + v[1][q].y * v[1][q].y) + (v[1][q].z * v[1][q].z + v[1][q].w * v[1][q].w); }
        float t0, t1; wg_sum2(F, s0, s1, red, t0, t1);
        const float rstd[2] = {1.0f / sqrtf(t0 * (1.0f / DM) + EPS), 1.0f / sqrtf(t1 * (1.0f / DM) + EPS)};
        float u0 = 0.f, u1 = 0.f;
#pragma unroll
        for (int r = 0; r < 2; ++r) { const float* mo = MOD + (size_t)(1 + (sr[r] >> 5)) * NMODC;
#pragma unroll
            for (int q = 0; q < 2; ++q) { const int ci = cb + 64 * q;
                const f32x4 x1 = ((const f32x4*)(A.in[I_XS] + (size_t)sr[r] * DM))[ci] + ((const f32x4*)(mo + 2 * DM))[ci] * ((const f32x4*)A.in[I_GPOM])[ci] * (v[r][q] * rstd[r]);
                v[r][q] = x1;
                if (r == 0 || hasb) { v2u w; w.x = pk2(x1.x, x1.y); w.y = pk2(x1.z, x1.w); ((v2u*)((bf16*)(A.ws + WS_X1) + (size_t)(SEQ + sr[r]) * DM))[ci] = w; }
                const float e = (x1.x * x1.x + x1.y * x1.y) + (x1.z * x1.z + x1.w * x1.w); if (r == 0) u0 += e; else u1 += e; } }
        wg_sum2(F, u0, u1, red + 16, t0, t1);
        const float rstd2[2] = {1.0f / sqrtf(t0 * (1.0f / DM) + EPS), 1.0f / sqrtf(t1 * (1.0f / DM) + EPS)};
#pragma unroll
        for (int r = 0; r < 2; ++r) { const float* mo = MOD + (size_t)(1 + (sr[r] >> 5)) * NMODC;
#pragma unroll
            for (int q = 0; q < 2; ++q) { const int ci = cb + 64 * q;
                const f32x4 y = v[r][q] * rstd2[r] * ((const f32x4*)A.in[I_GPF])[ci] * (1.0f + ((const f32x4*)(mo + 4 * DM))[ci]) + ((const f32x4*)(mo + 3 * DM))[ci];
                if (r == 0 || hasb) { v2u w; w.x = pk2(y.x, y.y); w.y = pk2(y.z, y.w); ((v2u*)((bf16*)(A.ws + WS_ACT) + (size_t)(SEQ + sr[r]) * DM))[ci] = w; } } }
    }
}
__device__ __forceinline__ void p7_postmix(Frame& F, KArgs& A) {
    const int gw = F.vcu * NWAVES + F.wave, NGW = F.G * NWAVES;
    const float* MOD = (const float*)(A.ws + WS_MOD);
    LAS f32x4* LA = (LAS f32x4*)F.lds; LAS f32x4* LB = LA + DM / 4; LAS f32x4* LC = LB + DM / 4;
    for (int i = F.tid; i < DM / 4; i += NWAVES * 64) { const f32x4* m4 = (const f32x4*)MOD + i;
        LA[i] = m4[2 * DM / 4] * ((const f32x4*)A.in[I_GPOM])[i]; LB[i] = ((const f32x4*)A.in[I_GPF])[i] * (1.0f + m4[4 * DM / 4]); LC[i] = m4[3 * DM / 4]; }
    __syncthreads();
#pragma unroll 1
    for (int m = gw; m < SEQ; m += NGW) { v2u mx[16]; f32x4 xx[16]; p7_load(A, m, F.lane, mx, xx); p7_proc(F, A, m, mx, xx, LA, LB, LC); }
    p7_samples(F, A);
}

__device__ __forceinline__ void up8(const v4u w, float (&f)[8]) { f[0] = bf_lo(w.x); f[1] = bf_hi(w.x); f[2] = bf_lo(w.y); f[3] = bf_hi(w.y); f[4] = bf_lo(w.z); f[5] = bf_hi(w.z); f[6] = bf_lo(w.w); f[7] = bf_hi(w.w); }
__device__ __forceinline__ void ld8(const float* p, float (&f)[8]) { const f32x4 a = *(const f32x4*)p, b = *(const f32x4*)(p + 4); f[0] = a.x; f[1] = a.y; f[2] = a.z; f[3] = a.w; f[4] = b.x; f[5] = b.y; f[6] = b.z; f[7] = b.w; }
__device__ __forceinline__ void p9_fix(Frame& F, KArgs& A) {
    const int gw = F.vcu * NWAVES + F.wave, NGW = F.G * NWAVES, lane = F.lane;
    const float* RAWP = (const float*)(A.ws + WS_RAWP); const float* RAWS = (const float*)(A.ws + WS_RAWS); bf16* ACTF = (bf16*)(A.ws + WS_ACTF);
    constexpr int NCC = (DFF + 511) / 512;
#pragma unroll 1
    for (int u = gw; u < 160 * NCC; u += NGW) {
        const int cc = u % NCC, fi = u / NCC, col = 512 * cc + 8 * lane;
        if (col >= DFF) continue;
        float wg[3][8], wv[3][8], bg[8], bv[8], g2[8], g1[8], g0[8], v2[8], v1[8], v0[8];
#pragma unroll
        for (int j = 0; j < 3; ++j) { ld8(A.in[I_WCF] + (size_t)j * DFF2 + col, wg[j]); ld8(A.in[I_WCF] + (size_t)j * DFF2 + DFF + col, wv[j]); }
        ld8(A.in[I_BCF] + col, bg); ld8(A.in[I_BCF] + DFF + col, bv);
        int row; const float *p0, *p1, *p2;
        if (fi < 128) { const int j = fi >> 1, d = fi & 1; row = 256 * j + d; const float* b = RAWP + (size_t)j * 4 * DFF2;
            p0 = b + (size_t)(2 + d) * DFF2; p1 = d ? b + (size_t)2 * DFF2 : (j ? b + (size_t)1 * DFF2 : nullptr); p2 = j ? (d ? b + (size_t)1 * DFF2 : b) : nullptr; }
        else { const int s = (fi - 128) >> 1, d = fi & 1; row = SEQ + 32 * s + d; const float* b = RAWS + (size_t)s * 2 * DFF2; const float* st = A.in[I_SCF] + (size_t)s * 2 * DFF2;
            p0 = b + (size_t)d * DFF2; p1 = d ? b : st + DFF2; p2 = d ? st + DFF2 : st; }
        ld8(p0 + col, g0); ld8(p0 + DFF + col, v0);
        if (p1) { ld8(p1 + col, g1); ld8(p1 + DFF + col, v1); } else {
#pragma unroll
            for (int e = 0; e < 8; ++e) { g1[e] = 0.f; v1[e] = 0.f; } }
        if (p2) { ld8(p2 + col, g2); ld8(p2 + DFF + col, v2); } else {
#pragma unroll
            for (int e = 0; e < 8; ++e) { g2[e] = 0.f; v2[e] = 0.f; } }
        float y[8];
#pragma unroll
        for (int e = 0; e < 8; ++e) { const float gc = bg[e] + wg[0][e] * g2[e] + wg[1][e] * g1[e] + wg[2][e] * g0[e]; const float vc = bv[e] + wv[0][e] * v2[e] + wv[1][e] * v1[e] + wv[2][e] * v0[e]; y[e] = gelu_tanh(gc) * vc; }
        v4u w; w.x = pk2(y[0], y[1]); w.y = pk2(y[2], y[3]); w.z = pk2(y[4], y[5]); w.w = pk2(y[6], y[7]);
        *(v4u*)(ACTF + (size_t)row * DFF + col) = w;
    }
}

template <bool PROMPT>
__device__ __forceinline__ void p11_row(Frame& F, KArgs& A, int m, const LAS f32x4* LA) {
    const int lane = F.lane;
    const float* MOD = (const float*)(A.ws + WS_MOD); const bf16* YD = (const bf16*)(A.ws + WS_MIX);
    f32x4 v[16]; float ss = 0.f;
    if (PROMPT) {
#pragma unroll
        for (int j = 0; j < 16; ++j) { const v2u w = __builtin_nontemporal_load((const v2u*)(YD + (size_t)m * DM) + lane + 64 * j); v[j] = (f32x4){bf_lo(w.x), bf_hi(w.x), bf_lo(w.y), bf_hi(w.y)}; }
    } else {
#pragma unroll
        for (int j = 0; j < 16; ++j) v[j] = (f32x4){0.f, 0.f, 0.f, 0.f};
#pragma unroll 1
        for (int ks = 0; ks < KS_DOWN; ++ks) { const f32x4* pr = (const f32x4*)(A.ws + WS_PART) + ((size_t)ks * (M - SEQ) + (m - SEQ)) * (DM / 4) + lane;
#pragma unroll
            for (int j = 0; j < 16; ++j) v[j] += pr[64 * j]; }
    }
#pragma unroll
    for (int j = 0; j < 16; ++j) ss += (v[j].x * v[j].x + v[j].y * v[j].y) + (v[j].z * v[j].z + v[j].w * v[j].w);
    const float rstd = 1.0f / sqrtf(wave_sum(ss) * (1.0f / DM) + EPS);
    f32x4* yo = (f32x4*)(A.out + OUT_Y + (size_t)m * DM) + lane;
    const v2u* xi = (const v2u*)((const bf16*)(A.ws + WS_X1) + (size_t)m * DM) + lane;
#pragma unroll
    for (int j = 0; j < 16; ++j) { const v2u w = __builtin_nontemporal_load(xi + 64 * j); const f32x4 x1 = (f32x4){bf_lo(w.x), bf_hi(w.x), bf_lo(w.y), bf_hi(w.y)};
        const f32x4 ca = PROMPT ? LA[lane + 64 * j] : ((const f32x4*)(MOD + (size_t)modrow_of(m) * NMODC + 5 * DM) + lane)[64 * j] * ((const f32x4*)A.in[I_GPOF] + lane)[64 * j];
        const f32x4 y = x1 + ca * (v[j] * rstd); __builtin_nontemporal_store(y, yo + 64 * j); if ((j & 3) == 3) asm volatile("" ::: "memory"); }
}
__device__ __forceinline__ void p11_load(KArgs& A, int m, int lane, v2u (&y)[16], v2u (&x)[16]) {
    const v2u* yr = (const v2u*)((const bf16*)(A.ws + WS_MIX) + (size_t)m * DM) + lane; const v2u* xr = (const v2u*)((const bf16*)(A.ws + WS_X1) + (size_t)m * DM) + lane;
#pragma unroll
    for (int j = 0; j < 16; ++j) { y[j] = __builtin_nontemporal_load(yr + 64 * j); x[j] = __builtin_nontemporal_load(xr + 64 * j); }
}
__device__ __forceinline__ void p11_proc(Frame& F, KArgs& A, int m, const v2u (&y)[16], const v2u (&x)[16], const LAS f32x4* LA) {
    const int lane = F.lane; float ss = 0.f;
#pragma unroll
    for (int j = 0; j < 16; ++j) { const f32x4 v = (f32x4){bf_lo(y[j].x), bf_hi(y[j].x), bf_lo(y[j].y), bf_hi(y[j].y)}; ss += (v.x * v.x + v.y * v.y) + (v.z * v.z + v.w * v.w); }
    const float rstd = 1.0f / sqrtf(wave_sum(ss) * (1.0f / DM) + EPS);
    f32x4* yo = (f32x4*)(A.out + OUT_Y + (size_t)m * DM) + lane;
#pragma unroll
    for (int j = 0; j < 16; ++j) { const f32x4 v = (f32x4){bf_lo(y[j].x), bf_hi(y[j].x), bf_lo(y[j].y), bf_hi(y[j].y)}, x1 = (f32x4){bf_lo(x[j].x), bf_hi(x[j].x), bf_lo(x[j].y), bf_hi(x[j].y)};
        const f32x4 o = x1 + LA[lane + 64 * j] * (v * rstd); __builtin_nontemporal_store(o, yo + 64 * j); if ((j & 3) == 3) asm volatile("" ::: "memory"); }
}
__device__ __forceinline__ void p11_samples(Frame& F, KArgs& A) {
    LAS float* red = (LAS float*)(F.lds + 65536);
    const float* MOD = (const float*)(A.ws + WS_MOD);
    const int cb = 128 * F.wave + F.lane;
#pragma unroll 1
    for (int j = 0; F.vcu + j * F.G < M - SEQ; j += 2) {
        const int sra = F.vcu + j * F.G, srb_ = sra + F.G; const bool hasb = srb_ < M - SEQ; const int srb = hasb ? srb_ : sra;
        const int sr[2] = {sra, srb};
        f32x4 v[2][2];
#pragma unroll
        for (int r = 0; r < 2; ++r)
#pragma unroll
            for (int q = 0; q < 2; ++q) v[r][q] = (f32x4){0.f, 0.f, 0.f, 0.f};
#pragma unroll
        for (int ks = 0; ks < KS_DOWN; ++ks)
#pragma unroll
            for (int r = 0; r < 2; ++r)
#pragma unroll
                for (int q = 0; q < 2; ++q) v[r][q] += ((const f32x4*)(A.ws + WS_PART))[((size_t)ks * (M - SEQ) + sr[r]) * (DM / 4) + cb + 64 * q];
        float s0 = 0.f, s1 = 0.f;
#pragma unroll
        for (int q = 0; q < 2; ++q) { s0 += (v[0][q].x * v[0][q].x + v[0][q].y * v[0][q].y) + (v[0][q].z * v[0][q].z + v[0][q].w * v[0][q].w); s1 += (v[1][q].x * v[1][q].x + v[1][q].y * v[1][q].y) + (v[1][q].z * v[1][q].z + v[1][q].w * v[1][q].w); }
        float t0, t1; wg_sum2(F, s0, s1, red, t0, t1);
        const float rstd[2] = {1.0f / sqrtf(t0 * (1.0f / DM) + EPS), 1.0f / sqrtf(t1 * (1.0f / DM) + EPS)};
#pragma unroll
        for (int r = 0; r < 2; ++r) { const float* mo = MOD + (size_t)(1 + (sr[r] >> 5)) * NMODC;
#pragma unroll
            for (int q = 0; q < 2; ++q) { const int ci = cb + 64 * q;
                const v2u w = ((const v2u*)((const bf16*)(A.ws + WS_X1) + (size_t)(SEQ + sr[r]) * DM))[ci]; const f32x4 x1 = (f32x4){bf_lo(w.x), bf_hi(w.x), bf_lo(w.y), bf_hi(w.y)};
                const f32x4 y = x1 + ((const f32x4*)(mo + 5 * DM))[ci] * ((const f32x4*)A.in[I_GPOF])[ci] * (v[r][q] * rstd[r]);
                if (r == 0 || hasb) ((f32x4*)(A.out + OUT_Y + (size_t)(SEQ + sr[r]) * DM))[ci] = y; } }
        __syncthreads();
    }
}
__device__ __forceinline__ void p11_final(Frame& F, KArgs& A) {
    const int gw = F.vcu * NWAVES + F.wave, NGW = F.G * NWAVES;
    const float* MOD = (const float*)(A.ws + WS_MOD);
    LAS f32x4* LA = (LAS f32x4*)F.lds;
    for (int i = F.tid; i < DM / 4; i += NWAVES * 64) LA[i] = ((const f32x4*)(MOD + 5 * DM))[i] * ((const f32x4*)A.in[I_GPOF])[i];
    __syncthreads();
    { v2u ya[16], xa[16], yb[16], xb[16]; int m = gw;
      if (m < SEQ) p11_load(A, m, F.lane, ya, xa);
#pragma unroll 1
      for (; m < SEQ; m += 2 * NGW) {
          if (m + NGW < SEQ) p11_load(A, m + NGW, F.lane, yb, xb);
          p11_proc(F, A, m, ya, xa, LA);
          if (m + NGW < SEQ) { if (m + 2 * NGW < SEQ) p11_load(A, m + 2 * NGW, F.lane, ya, xa); p11_proc(F, A, m + NGW, yb, xb, LA); }
      } }
    p11_samples(F, A);
}

__global__ void __launch_bounds__(NWAVES * 64, 2) mk_fwd(Args args_by_value) {
    extern __shared__ __attribute__((aligned(16))) unsigned char lds[];
    KArgs& args = *(KArgs*)__builtin_amdgcn_kernarg_segment_ptr();
    Frame F;
    F.lds = (LAS unsigned char*)lds;
    F.MISC = (volatile LAS unsigned*)(F.lds + MISC_OFF);
    F.tid = threadIdx.x; F.lane = F.tid & 63; F.wave = __builtin_amdgcn_readfirstlane(F.tid >> 6);
    F.G = gridDim.x; { const int bx = blockIdx.x; F.vcu = (F.G % 8 == 0) ? (bx % 8) * (F.G / 8) + bx / 8 : bx; }
    F.ctl = (gu32*)(args.ws + WS_CTL);
    for (int u = F.tid; u < (LDS_BYTES - LDSCTL_OFF) / 4; u += NWAVES * 64) ((LAS unsigned*)(F.lds + LDSCTL_OFF))[u] = 0u;
    __syncthreads();
    XcdBarrier bar = xcd_barrier_post((unsigned*)(F.ctl + CW_BAR) + args.li * XCD_BAR_WORDS, F.MISC + 8);
    const int lo = args.ph_lo, hi = args.ph_hi;
#define IN(k) (lo <= (k) && (k) < hi)
#define SEAM(k) do { if (IN(k) && IN((k) + 1)) xcd_barrier(bar); } while (0)
    unsigned char* ws = args.ws;

    if (IN(0)) { p0_prologue(F, args); } SEAM(0);
    if (IN(1)) { p1_h1(F, args); } SEAM(1);
    if (IN(2)) {
        pg8::Gemm g{(const pg8::bf16_t*)(ws + WS_ACT), (const pg8::bf16_t*)(ws + WS_WIN), M, DIN, DM}; pg8::StaticOrder S; S.init(M, DIN, F.G, (int)blockIdx.x);
        pg8::EpiInProj E{(pg8::bf16_t*)(ws + WS_PROJ), args.out + OUT_KP, args.out + OUT_VP, args.out + OUT_KS, args.out + OUT_VS, args.out + OUT_CLP, args.out + OUT_CLS};
        pg8::gemm_phase<pg8::EpiInProj, pg8::StaticOrder, true, true>(F.lds, g, S, E);
        tail_convert<true>(F, args.in[I_WUP], DM, DFF2, (bf16*)(ws + WS_WUP), IT_UP_TAIL, (M / 256) * (DIN / 256));
    } SEAM(2);
    if (IN(3)) { p3_mixers(F, args); } SEAM(3);
    if (IN(4)) { p4_carry(F, args); } SEAM(4);
    if (IN(5)) { p5_mixnorm(F, args); } SEAM(5);
    if (IN(6)) {
        pg8::Gemm g{(const pg8::bf16_t*)(ws + WS_ACT), (const pg8::bf16_t*)(ws + WS_WOUT), M, DM, DM}; pg8::SplitOrder S; S.init(SEQ, M - SEQ, DM, KS_OUT, DM / 64 / KS_OUT, KS_OUT, F.G, (int)blockIdx.x);
        pg8::EpiMixS E{(pg8::bf16_t*)(ws + WS_MIX), DM, (float*)(ws + WS_PART), SEQ, M - SEQ};
        pg8::gemm_phase<pg8::EpiMixS, pg8::SplitOrder, true, true>(F.lds, g, S, E);
    } SEAM(6);
    if (IN(7)) { p7_postmix(F, args); } SEAM(7);
    if (IN(8)) {
        pg8::Gemm g{(const pg8::bf16_t*)(ws + WS_ACT), (const pg8::bf16_t*)(ws + WS_WUP), M, DFF2, DM}; pg8::StaticOrder S; S.init(M, DFF2, F.G, (int)blockIdx.x);
        pg8::EpiUpAct E{(pg8::bf16_t*)(ws + WS_ACTF), args.in[I_WCF], args.in[I_BCF], (float*)(ws + WS_RAWP), (float*)(ws + WS_RAWS), args.out + OUT_CFP, args.out + OUT_CFS, (LAS float*)(F.lds + EXCH_OFF)};
        pg8::gemm_phase<pg8::EpiUpAct, pg8::StaticOrder, true, true>(F.lds, g, S, E);
        tail_convert<false>(F, args.in[I_WDOWN], DFF, DM, (bf16*)(ws + WS_WDOWN), IT_DOWN_TAIL, (M / 256) * (DFF2 / 256));
    } SEAM(8);
    if (IN(9)) { p9_fix(F, args); } SEAM(9);
    if (IN(10)) {
        pg8::Gemm g{(const pg8::bf16_t*)(ws + WS_ACTF), (const pg8::bf16_t*)(ws + WS_WDOWN), M, DM, DFF}; pg8::SplitOrder S; S.init(SEQ, M - SEQ, DM, KS_DOWN, 44, 2, F.G, (int)blockIdx.x);
        pg8::EpiMixS E{(pg8::bf16_t*)(ws + WS_MIX), DM, (float*)(ws + WS_PART), SEQ, M - SEQ};
        pg8::gemm_phase<pg8::EpiMixS, pg8::SplitOrder, true, true>(F.lds, g, S, E);
    } SEAM(10);
    if (IN(11)) { p11_final(F, args); }
#undef IN
#undef SEAM
}

#ifndef MK_N_LAUNCHES
#define MK_N_LAUNCHES 1
#endif
extern "C" void kernel_launch(void* const* d_in, const int* in_sizes, int n_in, void* d_out, int out_size, void* d_ws, size_t ws_size, hipStream_t stream) {
    static int grid = 0;
    if (grid == 0) {
        if (n_in != N_IN || (size_t)out_size != OUT_END || ws_size < WS_END) { fprintf(stderr, "kernel_launch: unexpected shapes (n_in %d, out %d, ws %zu); nothing launched\n", n_in, out_size, ws_size); grid = -1; return; }
        int dev = 0, cus = 0, per_cu = 0;
        if (hipGetDevice(&dev) != hipSuccess || hipDeviceGetAttribute(&cus, hipDeviceAttributeMultiprocessorCount, dev) != hipSuccess) { grid = -1; return; }
        if (hipFuncSetAttribute((const void*)mk_fwd, hipFuncAttributeMaxDynamicSharedMemorySize, LDS_BYTES) != hipSuccess) { fprintf(stderr, "kernel_launch: hipFuncSetAttribute failed\n"); grid = -1; return; }
        if (hipOccupancyMaxActiveBlocksPerMultiprocessor(&per_cu, (const void*)mk_fwd, NWAVES * 64, LDS_BYTES) != hipSuccess || per_cu < 1) { fprintf(stderr, "kernel_launch: occupancy query says %d blocks per CU\n", per_cu); }
        (void)hipGetLastError();
        grid = cus;
    }
    if (grid < 0) return;
    if (hipMemsetAsync((char*)d_ws + WS_CTL, 0, CTL_ZERO_BYTES, stream) != hipSuccess) return;
    Args a{};
    for (int i = 0; i < N_IN; ++i) a.in[i] = (const float*)d_in[i];
    a.out = (float*)d_out; a.ws = (unsigned char*)d_ws; a.pad = 0;
#if defined(MK_PROBE_DUP)
    { static const int kDup[NPH] = MK_PROBE_DUP;
      for (int li = 0; li < NPH; ++li) for (int rep = 0; rep < kDup[li]; ++rep) { a.ph_lo = li; a.ph_hi = li + 1; a.li = li; hipLaunchKernelGGL(mk_fwd, dim3(grid), dim3(NWAVES * 64), LDS_BYTES, stream, a); } }
#elif MK_N_LAUNCHES == 1
    a.ph_lo = 0; a.ph_hi = NPH; a.li = 0;
    hipLaunchKernelGGL(mk_fwd, dim3(grid), dim3(NWAVES * 64), LDS_BYTES, stream, a);
#else
    for (int li = 0; li < NPH; ++li) { a.ph_lo = li; a.ph_hi = li + 1; a.li = li; hipLaunchKernelGGL(mk_fwd, dim3(grid), dim3(NWAVES * 64), LDS_BYTES, stream, a); }
#endif
}
```

```cpp
#include <hip/hip_runtime.h>
#include <cstdio>
#include <cstdint>
namespace pg8 {
#define PG8_LAS __attribute__((address_space(3)))
typedef unsigned short bf16_t;
typedef short bf16x8 __attribute__((ext_vector_type(8)));
typedef float f32x4 __attribute__((ext_vector_type(4)));
typedef unsigned u32x4 __attribute__((ext_vector_type(4)));
constexpr int BM = 256, BK = 64, HALF = 128, HTB = HALF * BK * 2  , STAGE_BYTES = 8 * HTB, NXCD = 8, WGM = 8;

__host__ __device__ __forceinline__ int lds_byte(int r, int c) { const int st = (r >> 4) * 2 + (c >> 5), rr = r & 15, cc = c & 31, ob = rr * 64 + cc * 2; return st * 1024 + (ob ^ (((ob >> 9) & 1) << 5)); }
__host__ __device__ __forceinline__ void stage_rc(int b, int& R, int& C) { const int st = b / 1024, sb = b % 1024, swz = sb ^ (((sb >> 9) & 1) << 5); R = (st >> 1) * 16 + swz / 64; C = (st & 1) * 32 + (swz % 64) / 2; }
__host__ __device__ __forceinline__ int perm32(int rho) { const int n = rho >> 4, i = rho & 15; return 8 * (i >> 2) + 4 * n + (i & 3); }

struct Unit { int pm, pn; };
struct Gemm { const bf16_t* A; const bf16_t* Bt; int M, N, K; };

struct StaticOrder {
    int nM, nN, nwg, G, c;
    __host__ __device__ void init(int M, int N, int G_, int c_) { nM = M / BM; nN = N / BM; nwg = nM * nN; G = G_; c = c_; }
    __host__ __device__ __forceinline__ bool next(int i, Unit& u) const {
        const long L = (long)i * G + c; if (L >= nwg) return false;
        int wgid = (int)L; { const int q = nwg / NXCD, r = nwg % NXCD, xcd = wgid % NXCD, off = wgid / NXCD; wgid = (xcd < r ? xcd * (q + 1) : r * (q + 1) + (xcd - r) * q) + off; }
        const int nig = WGM * nN, gid = wgid / nig, fm = gid * WGM, gsz = (nM - fm) < WGM ? (nM - fm) : WGM;
        u.pm = fm + ((wgid % nig) % gsz); u.pn = (wgid % nig) / gsz; return true;
    }
    __device__ __forceinline__ void a_ready(const Unit&) const {}
    __device__ __forceinline__ void done(const Unit&) const {}
    __device__ __forceinline__ void kslice(const Unit&, int ntf, int& kt0, int& nt) const { kt0 = 0; nt = ntf; }
};
struct SplitOrder {
    StaticOrder main; int pm0, npan, nN, nks, nt_hi, n_hi, G, c, nmine;
    __host__ __device__ void init(int Mmain, int Msplit, int N, int nks_, int nt_hi_, int n_hi_, int G_, int c_) {
        main.init(Mmain, N, G_, c_); pm0 = Mmain / BM; npan = Msplit / BM; nN = N / BM; nks = nks_; nt_hi = nt_hi_; n_hi = n_hi_; G = G_; c = c_;
        nmine = (main.nwg > c_) ? (main.nwg - c_ + G_ - 1) / G_ : 0; }
    __host__ __device__ __forceinline__ bool next(int i, Unit& u) const {
        const bool is_main = i < nmine; Unit m; m.pm = 0; m.pn = 0; const bool okm = main.next(is_main ? i : 0, m);
        const int j = (i - nmine) * G + c, ks = j % nks, rest = j / nks;
        u.pm = is_main ? m.pm : pm0 + rest / nN; u.pn = is_main ? m.pn : ((rest % nN) | ((ks + 1) << 8));
        return is_main ? okm : (j < npan * nN * nks);
    }
    __device__ __forceinline__ void a_ready(const Unit&) const {}
    __device__ __forceinline__ void done(const Unit&) const {}
    __device__ __forceinline__ void kslice(const Unit& u, int ntf, int& kt0, int& nt) const { const int ksp = u.pn >> 8, ks = ksp - 1;
        nt = ksp == 0 ? ntf : (ks < n_hi ? nt_hi : nt_hi - 2); kt0 = ksp == 0 ? 0 : (ks < n_hi ? ks * nt_hi : n_hi * nt_hi + (ks - n_hi) * (nt_hi - 2)); }
};
__device__ __forceinline__ unsigned cvt_pk_bf16(float lo, float hi) { unsigned r; asm volatile("v_cvt_pk_bf16_f32 %0, %1, %2" : "=v"(r) : "v"(lo), "v"(hi)); return r; }
typedef float f32x2 __attribute__((ext_vector_type(2)));
struct EpiF32 {
    static constexpr bool PERM = false, AFTER_DRAIN = false;
    float* C; int ldc; const float* bias;
    __device__ __forceinline__ void operator()(const f32x4 (&acc)[2][2][4][2], const Unit& u, int wr, int wc, int fr, int fq) const {
        const int row0 = u.pm * BM + wr * 64 + fr, col0 = u.pn * BM + wc * 32 + 4 * fq;
        f32x4 bv[2][2];
#pragma unroll
        for (int bj = 0; bj < 2; ++bj)
#pragma unroll
            for (int n = 0; n < 2; ++n) bv[bj][n] = bias ? *(const f32x4*)(bias + col0 + bj * HALF + n * 16) : (f32x4){0.f, 0.f, 0.f, 0.f};
#pragma unroll
        for (int ai = 0; ai < 2; ++ai)
#pragma unroll
            for (int m = 0; m < 4; ++m) { float* rowp = C + (size_t)(row0 + ai * HALF + m * 16) * ldc + col0;
#pragma unroll
                for (int bj = 0; bj < 2; ++bj)
#pragma unroll
                    for (int n = 0; n < 2; ++n) *(f32x4*)(rowp + bj * HALF + n * 16) = acc[ai][bj][m][n] + bv[bj][n]; }
    }
};
struct EpiInProj {
    static constexpr bool PERM = true, AFTER_DRAIN = false;
    bf16_t* P; float* kp; float* vp; float* ks; float* vs; float* clp; float* cls;
    __device__ __forceinline__ void operator()(const f32x4 (&acc)[2][2][4][2], const Unit& u, int wr, int wc, int fr, int fq) const {
        const int row0 = u.pm * BM + wr * 64 + fr, col0 = u.pn * BM + wc * 32 + 8 * fq;
        const int seg = u.pn >> 3;
#pragma unroll
        for (int ai = 0; ai < 2; ++ai)
#pragma unroll
            for (int m = 0; m < 4; ++m) { const int row = row0 + ai * HALF + m * 16; bf16_t* rowp = P + (size_t)row * 10240 + col0;
#pragma unroll
                for (int bj = 0; bj < 2; ++bj) { const f32x4 v0 = acc[ai][bj][m][0], v1 = acc[ai][bj][m][1];
                    u32x4 w; w.x = cvt_pk_bf16(v0[0], v0[1]); w.y = cvt_pk_bf16(v0[2], v0[3]); w.z = cvt_pk_bf16(v1[0], v1[1]); w.w = cvt_pk_bf16(v1[2], v1[3]);
                    *(u32x4*)(rowp + bj * HALF) = w; }
                if (seg == 1 || seg == 2) {
                    const int c = col0 - seg * 2048;
                    float* o = (row < 16384) ? ((seg == 1 ? kp : vp) + (size_t)row * 2048 + c) : ((seg == 1 ? ks : vs) + (size_t)(row - 16384) * 2048 + c);
#pragma unroll
                    for (int bj = 0; bj < 2; ++bj) { *(f32x4*)(o + bj * HALF) = acc[ai][bj][m][0]; *(f32x4*)(o + bj * HALF + 4) = acc[ai][bj][m][1]; }
                }
                if (seg == 3 && u.pm >= 63) {
                    const int c = col0 - 6144; float* o = nullptr;
                    if (row < 16384) { if (row >= 16381) o = clp + (size_t)(row - 16381) * 2048 + c; }
                    else { const int rs = row - 16384, j = (rs & 31) - 29; if (j >= 0) o = cls + (size_t)((rs >> 5) * 3 + j) * 2048 + c; }
                    if (o) {
#pragma unroll
                        for (int bj = 0; bj < 2; ++bj) { *(f32x4*)(o + bj * HALF) = acc[ai][bj][m][0]; *(f32x4*)(o + bj * HALF + 4) = acc[ai][bj][m][1]; } }
                }
            }
    }
};
struct EpiUp {
    static constexpr bool PERM = true, AFTER_DRAIN = false;
    bf16_t* U; float* cfp; float* cfs;
    __device__ __forceinline__ void operator()(const f32x4 (&acc)[2][2][4][2], const Unit& u, int wr, int wc, int fr, int fq) const {
        const int row0 = u.pm * BM + wr * 64 + fr, col0 = u.pn * BM + wc * 32 + 8 * fq;
#pragma unroll
        for (int ai = 0; ai < 2; ++ai)
#pragma unroll
            for (int m = 0; m < 4; ++m) { const int row = row0 + ai * HALF + m * 16; bf16_t* rowp = U + (size_t)row * 22016 + col0;
#pragma unroll
                for (int bj = 0; bj < 2; ++bj) { const f32x4 v0 = acc[ai][bj][m][0], v1 = acc[ai][bj][m][1];
                    u32x4 w; w.x = cvt_pk_bf16(v0[0], v0[1]); w.y = cvt_pk_bf16(v0[2], v0[3]); w.z = cvt_pk_bf16(v1[0], v1[1]); w.w = cvt_pk_bf16(v1[2], v1[3]);
                    *(u32x4*)(rowp + bj * HALF) = w; }
                if (u.pm >= 63) {
                    float* o = nullptr;
                    if (row < 16384) { if (row >= 16382) o = cfp + (size_t)(row - 16382) * 22016 + col0; }
                    else { const int rs = row - 16384, j = (rs & 31) - 30; if (j >= 0) o = cfs + (size_t)((rs >> 5) * 2 + j) * 22016 + col0; }
                    if (o) {
#pragma unroll
                        for (int bj = 0; bj < 2; ++bj) { *(f32x4*)(o + bj * HALF) = acc[ai][bj][m][0]; *(f32x4*)(o + bj * HALF + 4) = acc[ai][bj][m][1]; } }
                }
            }
    }
};
struct EpiMixS {
    static constexpr bool PERM = true, AFTER_DRAIN = false;
    bf16_t* C; int ldc; float* part; int row_split0, rows_split;
    __device__ __forceinline__ void operator()(const f32x4 (&acc)[2][2][4][2], const Unit& u, int wr, int wc, int fr, int fq) const {
        const int ksp = u.pn >> 8, row0 = u.pm * BM + wr * 64 + fr, col0 = (u.pn & 255) * BM + wc * 32 + 8 * fq;
        if (ksp == 0) {
#pragma unroll
            for (int ai = 0; ai < 2; ++ai)
#pragma unroll
                for (int m = 0; m < 4; ++m) { bf16_t* rowp = C + (size_t)(row0 + ai * HALF + m * 16) * ldc + col0;
#pragma unroll
                    for (int bj = 0; bj < 2; ++bj) { const f32x4 v0 = acc[ai][bj][m][0], v1 = acc[ai][bj][m][1];
                        u32x4 w; w.x = cvt_pk_bf16(v0[0], v0[1]); w.y = cvt_pk_bf16(v0[2], v0[3]); w.z = cvt_pk_bf16(v1[0], v1[1]); w.w = cvt_pk_bf16(v1[2], v1[3]);
                        *(u32x4*)(rowp + bj * HALF) = w; } }
        } else {
            float* base = part + ((size_t)(ksp - 1) * rows_split - (size_t)row_split0) * ldc;
#pragma unroll
            for (int ai = 0; ai < 2; ++ai)
#pragma unroll
                for (int m = 0; m < 4; ++m) { float* rowp = base + (size_t)(row0 + ai * HALF + m * 16) * ldc + col0;
#pragma unroll
                    for (int bj = 0; bj < 2; ++bj) { *(f32x4*)(rowp + bj * HALF) = acc[ai][bj][m][0]; *(f32x4*)(rowp + bj * HALF + 4) = acc[ai][bj][m][1]; } }
        }
    }
};
__device__ __forceinline__ float dpp_ror1(float v) { return __builtin_bit_cast(float, __builtin_amdgcn_mov_dpp(__builtin_bit_cast(int, v), 0x121, 0xf, 0xf, false)); }
__device__ __forceinline__ float dpp_shr1(float old, float v) { return __builtin_bit_cast(float, __builtin_amdgcn_update_dpp(__builtin_bit_cast(int, old), __builtin_bit_cast(int, v), 0x111, 0xf, 0xf, false)); }
__device__ __forceinline__ float dpp_ror2(float v) { return __builtin_bit_cast(float, __builtin_amdgcn_mov_dpp(__builtin_bit_cast(int, v), 0x122, 0xf, 0xf, false)); }
__device__ __forceinline__ float dpp_shr2(float old, float v) { return __builtin_bit_cast(float, __builtin_amdgcn_update_dpp(__builtin_bit_cast(int, old), __builtin_bit_cast(int, v), 0x112, 0xf, 0xf, false)); }
struct EpiUpAct {
    static constexpr bool PERM = true, AFTER_DRAIN = false;
    bf16_t* ACT; const float* wcv; const float* bcv; float* rawp; float* raws; float* cfp; float* cfs; PG8_LAS float* X;
    __device__ __forceinline__ void operator()(const f32x4 (&acc)[2][2][4][2], const Unit& u, int wr, int wc, int fr, int fq) const {
        const int x0 = wc * 32 + 8 * fq, gcol = u.pn * 128 + x0;
        if (fr >= 14) {
#pragma unroll
            for (int ai = 0; ai < 2; ++ai)
#pragma unroll
                for (int bj = 0; bj < 2; ++bj)
#pragma unroll
                    for (int n = 0; n < 2; ++n) *(PG8_LAS f32x4*)(X + (((2 * ai + wr) * 2 + (fr - 14)) * 256 + bj * 128 + x0 + 4 * n)) = acc[ai][bj][3][n];
        }
        asm volatile("s_waitcnt lgkmcnt(0)" ::: "memory"); __builtin_amdgcn_s_barrier(); asm volatile("" ::: "memory");
#pragma unroll
        for (int n = 0; n < 2; ++n) {
            f32x4 w0[2], w1[2], w2[2], bb[2];
#pragma unroll
            for (int bj = 0; bj < 2; ++bj) { const float* p = wcv + bj * 11008 + gcol + 4 * n; w0[bj] = *(const f32x4*)p; w1[bj] = *(const f32x4*)(p + 22016); w2[bj] = *(const f32x4*)(p + 44032);
                bb[bj] = *(const f32x4*)(bcv + bj * 11008 + gcol + 4 * n); }
#pragma unroll
            for (int ai = 0; ai < 2; ++ai) {
                const int ps = (2 * ai + wr + 3) & 3;
                f32x4 P14[2], P15[2];
#pragma unroll
                for (int bj = 0; bj < 2; ++bj) { P14[bj] = *(const PG8_LAS f32x4*)(X + ((ps * 2 + 0) * 256 + bj * 128 + x0 + 4 * n)); P15[bj] = *(const PG8_LAS f32x4*)(X + ((ps * 2 + 1) * 256 + bj * 128 + x0 + 4 * n)); }
                float outv[4][4];
#pragma unroll
                for (int e = 0; e < 4; ++e) {
                    float cv[2][4];
#pragma unroll
                    for (int bj = 0; bj < 2; ++bj) {
                        float pr1 = P15[bj][e], pr2 = (fr == 0) ? P14[bj][e] : P15[bj][e];
#pragma unroll
                        for (int m = 0; m < 4; ++m) { const float c = acc[ai][bj][m][n][e];
                            const float u1 = dpp_shr1(pr1, c), u2 = dpp_shr2(pr2, c);
                            cv[bj][m] = bb[bj][e] + w0[bj][e] * u2 + w1[bj][e] * u1 + w2[bj][e] * c;
                            if (m < 3) { pr1 = dpp_ror1(c); pr2 = dpp_ror2(c); } }
                    }
#pragma unroll
                    for (int m = 0; m < 4; ++m) { const float g = cv[0][m]; outv[m][e] = g * __builtin_amdgcn_rcpf(1.0f + __builtin_amdgcn_exp2f(g * (-2.3022082f - 0.10294324f * g * g))) * cv[1][m]; }
                }
#pragma unroll
                for (int m = 0; m < 4; ++m) { const int row = u.pm * BM + ai * HALF + wr * 64 + m * 16 + fr;
                    unsigned lo = cvt_pk_bf16(outv[m][0], outv[m][1]), hi = cvt_pk_bf16(outv[m][2], outv[m][3]);
                    *(unsigned long long*)(ACT + (size_t)row * 11008 + gcol + 4 * n) = (unsigned long long)lo | ((unsigned long long)hi << 32); }
            }
        }
        if (u.pm < 64) {
            if (wr == 0 && fr < 2) { float* d = rawp + (size_t)(u.pm * 4 + 2 + fr) * 22016 + gcol;
#pragma unroll
                for (int bj = 0; bj < 2; ++bj) { *(f32x4*)(d + bj * 11008) = acc[0][bj][0][0]; *(f32x4*)(d + bj * 11008 + 4) = acc[0][bj][0][1]; } }
            if (wr == 1 && fr >= 14) { float* d = (u.pm < 63 ? rawp + (size_t)((u.pm + 1) * 4 + (fr - 14)) * 22016 : cfp + (size_t)(fr - 14) * 22016) + gcol;
#pragma unroll
                for (int bj = 0; bj < 2; ++bj) { *(f32x4*)(d + bj * 11008) = acc[1][bj][3][0]; *(f32x4*)(d + bj * 11008 + 4) = acc[1][bj][3][1]; } }
        } else {
#pragma unroll
            for (int ai = 0; ai < 2; ++ai)
#pragma unroll
                for (int m = 0; m < 4; ++m) { const int rt = ai * HALF + wr * 64 + m * 16 + fr, q = rt & 31, s = ((u.pm - 64) * BM + rt) >> 5; float* d = nullptr;
                    if (q < 2) d = raws + (size_t)(s * 2 + q) * 22016 + gcol; else if (q >= 30) d = cfs + (size_t)(s * 2 + q - 30) * 22016 + gcol;
                    if (d) {
#pragma unroll
                        for (int bj = 0; bj < 2; ++bj) { *(f32x4*)(d + bj * 11008) = acc[ai][bj][m][0]; *(f32x4*)(d + bj * 11008 + 4) = acc[ai][bj][m][1]; } } }
        }
    }
};
template <class Epi, class Sched, bool ALIGN_EPI = false, bool SP2 = false>
__device__ __forceinline__ void gemm_phase(PG8_LAS unsigned char* lds, const Gemm g, const Sched& S, const Epi& E) {
    const int tid = threadIdx.x, wid = __builtin_amdgcn_readfirstlane(tid >> 6), lane = tid & 63, wr = wid >> 2, wc = wid & 3, fr = lane & 15, fq = lane >> 4;
    const int K = g.K, ntf = K / BK;
    unsigned voffA[2], voffB[2];
#pragma unroll
    for (int i = 0; i < 2; ++i) { int R, C; stage_rc(tid * 16 + i * 8192, R, C); const int Rb = Epi::PERM ? ((R & ~31) + perm32(R & 31)) : R;
        voffA[i] = (unsigned)(R * K + C) * 2u; voffB[i] = (unsigned)(Rb * K + C) * 2u; }
    const size_t kstep = (size_t)(BK * 2);
    const size_t hstep = (size_t)HALF * K * 2;
    const size_t tstep = 2 * hstep;
    const unsigned ldsw = (unsigned)wid * 1024u;
    const int aoff = lds_byte(wr * 64 + fr, fq * 8), boff = lds_byte(wc * 32 + fr, fq * 8);
#define PG8_SA(b, h) (((b) * 2 + (h)) * HTB)
#define PG8_SB(b, h) ((4 + (b) * 2 + (h)) * HTB)
#define PG8_STAGE(bufoff, gbase, voff) do { _Pragma("unroll") for (int _i = 0; _i < 2; ++_i) \
        __builtin_amdgcn_global_load_lds((const unsigned*)((const char*)(gbase) + (voff)[_i]), (PG8_LAS unsigned*)(lds + (bufoff) + ldsw + _i * 8192), 16, 0, 0); } while (0)
#define PG8_LDA(dst, b, h) do { _Pragma("unroll") for (int m = 0; m < 4; ++m) _Pragma("unroll") for (int k = 0; k < 2; ++k) dst[m][k] = *(const PG8_LAS bf16x8*)(lds + PG8_SA(b, h) + aoff + m * 2048 + k * 1024); } while (0)
#define PG8_LDB(dst, b, h) do { _Pragma("unroll") for (int n = 0; n < 2; ++n) _Pragma("unroll") for (int k = 0; k < 2; ++k) dst[n][k] = *(const PG8_LAS bf16x8*)(lds + PG8_SB(b, h) + boff + n * 2048 + k * 1024); } while (0)
#define PG8_MMA(ai, bj, At, Bt) do { __builtin_amdgcn_s_setprio(1); _Pragma("unroll") for (int m = 0; m < 4; ++m) _Pragma("unroll") for (int n = 0; n < 2; ++n) _Pragma("unroll") for (int k = 0; k < 2; ++k) \
        acc[ai][bj][m][n] = __builtin_amdgcn_mfma_f32_16x16x32_bf16(Bt[n][k], At[m][k], acc[ai][bj][m][n], 0, 0, 0); __builtin_amdgcn_s_setprio(0); } while (0)
#define PG8_WAIT_V(n) asm volatile("s_waitcnt vmcnt(" #n ")" ::: "memory")
#define PG8_WAIT_L(n) asm volatile("s_waitcnt lgkmcnt(" #n ")" ::: "memory")
#define PG8_BAR __builtin_amdgcn_s_barrier()
#define PG8_SCHED __builtin_amdgcn_sched_barrier(0)
    Unit cur, nxt; int ui = 0;
    if (!S.next(0, cur)) return;
    f32x4 acc[2][2][4][2];
#pragma unroll
    for (int a = 0; a < 2; ++a)
#pragma unroll
        for (int b = 0; b < 2; ++b)
#pragma unroll
            for (int m = 0; m < 4; ++m)
#pragma unroll
                for (int n = 0; n < 2; ++n) acc[a][b][m][n] = (f32x4){0.f, 0.f, 0.f, 0.f};
    bf16x8 At[4][2], B0[2][2], B1[2][2];
    int kt0, nt; S.kslice(cur, ntf, kt0, nt);
    const char* cA = (const char*)g.A + (size_t)cur.pm * tstep + (size_t)kt0 * kstep; const char* cB = (const char*)g.Bt + (size_t)(cur.pn & 255) * tstep + (size_t)kt0 * kstep;
    S.a_ready(cur);
    if constexpr (SP2) {
        PG8_STAGE(PG8_SB(0, 0), cB, voffB); PG8_STAGE(PG8_SB(0, 1), cB + hstep, voffB); PG8_STAGE(PG8_SA(0, 0), cA, voffA); PG8_STAGE(PG8_SA(0, 1), cA + hstep, voffA);
        if (wr == 1) PG8_BAR;
        PG8_WAIT_V(2); PG8_BAR;
        PG8_STAGE(PG8_SB(1, 0), cB + kstep, voffB); PG8_STAGE(PG8_SA(1, 0), cA + kstep, voffA); PG8_STAGE(PG8_SB(1, 1), cB + hstep + kstep, voffB);
        PG8_WAIT_V(6); PG8_BAR;
    } else {
        PG8_STAGE(PG8_SB(0, 0), cB, voffB); PG8_STAGE(PG8_SA(0, 0), cA, voffA); PG8_STAGE(PG8_SB(0, 1), cB + hstep, voffB); PG8_STAGE(PG8_SA(0, 1), cA + hstep, voffA);
        if (wr == 1) PG8_BAR;
        PG8_WAIT_V(4); PG8_BAR;
        PG8_STAGE(PG8_SB(1, 0), cB + kstep, voffB); PG8_STAGE(PG8_SA(1, 0), cA + kstep, voffA); PG8_STAGE(PG8_SB(1, 1), cB + hstep + kstep, voffB);
        PG8_WAIT_V(6); PG8_BAR;
    }
    for (;;) {
        const bool has_next = S.next(ui + 1, nxt);
        int nkt0 = 0, nnt = ntf; if (has_next) S.kslice(nxt, ntf, nkt0, nnt);
        const char* nA = has_next ? (const char*)g.A + (size_t)nxt.pm * tstep + (size_t)nkt0 * kstep : cA; const char* nB = has_next ? (const char*)g.Bt + (size_t)(nxt.pn & 255) * tstep + (size_t)nkt0 * kstep : cB;
        for (int t = 0; t < nt; t += 2) {
            const bool last = (t == nt - 2);
            const char* a1 = cA + (size_t)(t + 1) * kstep;
            const char* a2 = last ? nA : cA + (size_t)(t + 2) * kstep; const char* b2 = last ? nB : cB + (size_t)(t + 2) * kstep;
            const char* a3 = a2 + kstep; const char* b3 = b2 + kstep;
            if (last && has_next) S.a_ready(nxt);
            if constexpr (SP2) {
            PG8_LDB(B0, 0, 0); PG8_LDB(B1, 0, 1); PG8_SCHED; PG8_LDA(At, 0, 0); PG8_STAGE(PG8_SA(1, 1), a1 + hstep, voffA);
            PG8_WAIT_V(8); PG8_WAIT_L(0); PG8_BAR; PG8_MMA(0, 0, At, B0); PG8_MMA(0, 1, At, B1); PG8_BAR; PG8_SCHED;
            PG8_LDA(At, 0, 1); PG8_STAGE(PG8_SB(0, 0), b2, voffB); PG8_STAGE(PG8_SB(0, 1), b2 + hstep, voffB); PG8_STAGE(PG8_SA(0, 0), a2, voffA);
            PG8_WAIT_V(8); PG8_WAIT_L(0); PG8_BAR; PG8_MMA(1, 0, At, B0); PG8_MMA(1, 1, At, B1); PG8_BAR; PG8_SCHED;
            PG8_LDB(B0, 1, 0); PG8_LDB(B1, 1, 1); PG8_SCHED; PG8_LDA(At, 1, 0); PG8_STAGE(PG8_SA(0, 1), a2 + hstep, voffA);
            PG8_WAIT_V(8); PG8_WAIT_L(0); PG8_BAR; PG8_MMA(0, 0, At, B0); PG8_MMA(0, 1, At, B1); PG8_BAR; PG8_SCHED;
            PG8_LDA(At, 1, 1); PG8_STAGE(PG8_SB(1, 0), b3, voffB); PG8_STAGE(PG8_SB(1, 1), b3 + hstep, voffB); PG8_STAGE(PG8_SA(1, 0), a3, voffA);
            PG8_WAIT_V(8); PG8_WAIT_L(0); PG8_BAR; PG8_MMA(1, 0, At, B0); PG8_MMA(1, 1, At, B1); PG8_BAR; PG8_SCHED;
            } else {
            PG8_LDB(B0, 0, 0); PG8_SCHED; PG8_LDA(At, 0, 0); PG8_STAGE(PG8_SA(1, 1), a1 + hstep, voffA);
            PG8_WAIT_L(8); PG8_BAR; PG8_WAIT_L(0); PG8_MMA(0, 0, At, B0); PG8_BAR; PG8_SCHED;
            PG8_LDB(B1, 0, 1); PG8_STAGE(PG8_SB(0, 0), b2, voffB);
            PG8_BAR; PG8_WAIT_L(0); PG8_MMA(0, 1, At, B1); PG8_BAR;
            PG8_LDA(At, 0, 1); PG8_STAGE(PG8_SA(0, 0), a2, voffA);
            PG8_BAR; PG8_WAIT_L(0); PG8_MMA(1, 0, At, B0); PG8_BAR; PG8_SCHED;
            PG8_STAGE(PG8_SB(0, 1), b2 + hstep, voffB);
            PG8_WAIT_V(6); PG8_BAR; PG8_MMA(1, 1, At, B1); PG8_BAR;
            PG8_LDB(B0, 1, 0); PG8_SCHED; PG8_LDA(At, 1, 0); PG8_STAGE(PG8_SA(0, 1), a2 + hstep, voffA);
            PG8_WAIT_L(8); PG8_BAR; PG8_WAIT_L(0); PG8_MMA(0, 0, At, B0); PG8_BAR; PG8_SCHED;
            PG8_LDB(B1, 1, 1); PG8_STAGE(PG8_SB(1, 0), b3, voffB);
            PG8_BAR; PG8_WAIT_L(0); PG8_MMA(0, 1, At, B1); PG8_BAR;
            PG8_LDA(At, 1, 1); PG8_STAGE(PG8_SA(1, 0), a3, voffA);
            PG8_BAR; PG8_WAIT_L(0); PG8_MMA(1, 0, At, B0); PG8_BAR; PG8_SCHED;
            PG8_STAGE(PG8_SB(1, 1), b3 + hstep, voffB);
            PG8_WAIT_V(6); PG8_BAR; PG8_MMA(1, 1, At, B1); PG8_BAR;
            }
        }
        if constexpr (ALIGN_EPI) { if (wr == 0) PG8_BAR; }
        if constexpr (!Epi::AFTER_DRAIN) { E(acc, cur, wr, wc, fr, fq); S.done(cur); }
        if (!has_next) break;
#pragma unroll
        for (int a = 0; a < 2; ++a)
#pragma unroll
            for (int b = 0; b < 2; ++b)
#pragma unroll
                for (int m = 0; m < 4; ++m)
#pragma unroll
                    for (int n = 0; n < 2; ++n) acc[a][b][m][n] = (f32x4){0.f, 0.f, 0.f, 0.f};
        cur = nxt; cA = nA; cB = nB; nt = nnt; ++ui;
        if constexpr (ALIGN_EPI) { if (wr == 1) PG8_BAR; }
    }
    PG8_WAIT_V(0);
    if constexpr (!ALIGN_EPI) { if (wr == 0) PG8_BAR; }
    PG8_BAR;
    if constexpr (Epi::AFTER_DRAIN) { E.fused(acc, cur, wr, wc, fr, fq, lds, wid, lane); S.done(cur); }
#undef PG8_SA
#undef PG8_SB
#undef PG8_STAGE
#undef PG8_LDA
#undef PG8_LDB
#undef PG8_MMA
#undef PG8_WAIT_V
#undef PG8_WAIT_L
#undef PG8_BAR
#undef PG8_SCHED
}
}

constexpr int DM = 4096, SEQ = 16384, NDEC = 16, DSEQ = 32, PAST = 2048, HD = 128, DSB = 2048, NH = 16, DLRU = 2048, NBLK = 16, LBLK = 128;
constexpr int DIN = 10240, DFF = 11008, DFF2 = 22016, NMODC = 6 * DM, NB = 1 + NDEC;
constexpr int M = SEQ + NDEC * DSEQ;
constexpr int NCHUNK = M / 32;
constexpr float EPS = 1e-6f;
constexpr int NWAVES = 8;
constexpr int NPH = 12;

constexpr size_t OUT_Y = 0, OUT_KP = (size_t)M * DM, OUT_VP = OUT_KP + (size_t)SEQ * DSB, OUT_CLP = OUT_VP + (size_t)SEQ * DSB, OUT_LP = OUT_CLP + 3 * DLRU, OUT_CFP = OUT_LP + DLRU,
                 OUT_KS = OUT_CFP + 2 * DFF2, OUT_VS = OUT_KS + (size_t)512 * DSB, OUT_CLS = OUT_VS + (size_t)512 * DSB, OUT_LS = OUT_CLS + NDEC * 3 * DLRU, OUT_CFS = OUT_LS + NDEC * DLRU,
                 OUT_END = OUT_CFS + (size_t)NDEC * 2 * DFF2;
static_assert(OUT_END == 139299840ull, "output size");

constexpr size_t MiB = 1u << 20;
constexpr size_t WS_CTL = 0, CTL_ZERO_BYTES = 1 * MiB;
constexpr size_t WS_GATET = 1 * MiB;
constexpr size_t WS_MOD = 2 * MiB;
constexpr size_t WS_AGGA = 4 * MiB, WS_AGGH = 9 * MiB, WS_CARRY = 14 * MiB;
constexpr size_t WS_WDOWN = 20 * MiB;
constexpr size_t WS_WUP = 106 * MiB;
constexpr size_t WS_WOUT = 278 * MiB;
constexpr size_t WS_ACT = 310 * MiB;
constexpr size_t WS_MIX = 442 * MiB;
constexpr size_t WS_X1 = 574 * MiB;
constexpr size_t WS_R = 706 * MiB;
constexpr size_t WS_WIN = WS_R;
constexpr size_t WS_PROJ = WS_R + 80 * MiB;
constexpr size_t WS_OSB = WS_PROJ + 330 * MiB;
constexpr size_t WS_HP = WS_OSB + 66 * MiB;
constexpr size_t WS_PART = WS_R;
constexpr int KS_OUT = 8, KS_DOWN = 4;
constexpr size_t WS_RAWP = WS_R + 64 * MiB;
constexpr size_t WS_RAWS = WS_R + 88 * MiB;
constexpr size_t WS_ACTF = WS_R + 710 * MiB;
constexpr size_t WS_END = WS_ACTF + 355 * MiB;
static_assert(WS_HP + 132 * MiB <= WS_END && (size_t)M * DFF * 2 <= 355 * MiB && (size_t)M * DIN * 2 <= 330 * MiB, "ws map");
constexpr int CW_BAR = 4096;

constexpr int RING_BYTES = 131072;
constexpr int LDSCTL_OFF = RING_BYTES, MISC_OFF = LDSCTL_OFF + 320;
constexpr int LDS_BYTES = 147456;
constexpr int EXCH_OFF = LDSCTL_OFF + 2048;
static_assert(EXCH_OFF + 8192 <= LDS_BYTES, "lds map");
constexpr int WAVE_LDS = 9216;
constexpr int VROW = 288;
constexpr int XROW = 272;

#define GAS __attribute__((address_space(1)))
#define LAS __attribute__((address_space(3)))
typedef unsigned short bf16;
typedef unsigned v4u __attribute__((ext_vector_type(4)));
typedef unsigned v2u __attribute__((ext_vector_type(2)));
typedef float f32x4 __attribute__((ext_vector_type(4)));
typedef float f32x16 __attribute__((ext_vector_type(16)));
typedef short bf16x8 __attribute__((ext_vector_type(8)));
typedef short s16x4 __attribute__((ext_vector_type(4)));
typedef GAS unsigned gu32;
#define RLX_AGENT __ATOMIC_RELAXED, __HIP_MEMORY_SCOPE_AGENT
#define LDS_WAIT() asm volatile("s_waitcnt lgkmcnt(0)" ::: "memory")
__device__ __forceinline__ unsigned f2bf(float f) { unsigned u = __builtin_bit_cast(unsigned, f); return (u + 0x7fffu + ((u >> 16) & 1u)) >> 16; }
__device__ __forceinline__ unsigned pk2(float lo, float hi) { typedef float f2_t __attribute__((ext_vector_type(2))); typedef __bf16 b2_t __attribute__((ext_vector_type(2))); f2_t v = {lo, hi}; b2_t b = __builtin_convertvector(v, b2_t); return __builtin_bit_cast(unsigned, b); }
__device__ __forceinline__ float bf_lo(unsigned w) { return __builtin_bit_cast(float, w << 16); }
__device__ __forceinline__ float bf_hi(unsigned w) { return __builtin_bit_cast(float, w & 0xffff0000u); }
__device__ __forceinline__ float fexp2(float x) { return __builtin_amdgcn_exp2f(x); }
__device__ __forceinline__ float flog2(float x) { return __builtin_amdgcn_logf(x); }
__device__ __forceinline__ float frcp(float x) { return __builtin_amdgcn_rcpf(x); }
__device__ __forceinline__ float fsqrt(float x) { return __builtin_amdgcn_sqrtf(x); }
__device__ __forceinline__ float sigmoidf_(float x) { return frcp(1.0f + fexp2(-1.4426950408889634f * x)); }
__device__ __forceinline__ float gelu_tanh(float x) { return x * frcp(1.0f + fexp2(x * (-2.3022082f - 0.10294324f * x * x))); }
__device__ __forceinline__ float wave_sum(float v) {
#pragma unroll
    for (int o = 1; o < 64; o <<= 1) v += __shfl_xor(v, o);
    return v;
}
#define XB_TMO      128
#define XB_XCNT(j)  (256  + 64 * (j))
#define XB_XSUB(j)  (1280 + 64 * (j))
#define XB_XGEN(j)  (2304 + 64 * (j))
#define XB_TOP      3328
#define XB_TOPGEN   3392
#define XCD_BAR_WORDS 3456
#define XB_SPIN_CAP (1u << 18)

__device__ __forceinline__ unsigned xb_ld(unsigned* p)              { return __hip_atomic_load(p, __ATOMIC_RELAXED, __HIP_MEMORY_SCOPE_AGENT); }
__device__ __forceinline__ unsigned xb_add(unsigned* p, unsigned v) { return __hip_atomic_fetch_add(p, v, __ATOMIC_RELAXED, __HIP_MEMORY_SCOPE_AGENT); }
__device__ __forceinline__ unsigned xb_xcc_id() { return (unsigned)__builtin_amdgcn_s_getreg((3 << 11) | 20) & 0xFu; }
#define XB_SPIN(cond, bar) do { unsigned _sp = 0; while (cond) { __builtin_amdgcn_s_sleep(1); \
    if ((++_sp & 255u) == 0u) { if (xb_ld(&(bar)[XB_TMO])) break; if (_sp > XB_SPIN_CAP) { atomicAdd(&(bar)[XB_TMO], 1u); break; } } } } while (0)

struct XcdBarrier {
    unsigned* bar; unsigned x;
    volatile LAS unsigned* st;
};

__device__ __forceinline__ XcdBarrier xcd_barrier_post(unsigned* bar, volatile LAS unsigned* st) {
    XcdBarrier b; b.bar = bar; b.x = xb_xcc_id(); b.st = st;
    if (threadIdx.x == 0) (void)xb_add(&bar[XB_XCNT(b.x)], 1u);
    return b;
}
__device__ __forceinline__ void xcd_barrier_complete(unsigned* bar, unsigned x, unsigned& nloc, unsigned& nx) {
    const unsigned G = gridDim.x * gridDim.y * gridDim.z;
    unsigned sum, cnt, mine, sp = 0u;
    for (;;) {
        sum = 0u; cnt = 0u; mine = 0u;
#pragma unroll
        for (unsigned j = 0; j < 16; ++j) { const unsigned c = xb_ld(&bar[XB_XCNT(j)]); sum += c; cnt += (c > 0u) ? 1u : 0u; mine = (j == x) ? c : mine; }
        if (sum == G) break;
        __builtin_amdgcn_s_sleep(1);
        if ((++sp & 255u) == 0u) { if (xb_ld(&bar[XB_TMO])) break; if (sp > XB_SPIN_CAP) { atomicAdd(&bar[XB_TMO], 1u); break; } }
    }
    nloc = mine > 0u ? mine : 1u; nx = cnt > 0u ? cnt : 1u;
}

__device__ __forceinline__ void xcd_barrier(const XcdBarrier& b) {
    asm volatile("s_waitcnt vmcnt(0)" ::: "memory");
    __syncthreads();
    if (threadIdx.x == 0) {
        unsigned* bar = b.bar;
        __builtin_amdgcn_s_waitcnt(0);
        unsigned nloc = b.st[0], nx = b.st[1];
        if (nloc == 0u) { xcd_barrier_complete(bar, b.x, nloc, nx); b.st[0] = nloc; b.st[1] = nx; }
        const unsigned old = xb_add(&bar[XB_XSUB(b.x)], 1u);
        const unsigned gen = old / nloc;
        if (old + 1u == (gen + 1u) * nloc) {
            __builtin_amdgcn_fence(__ATOMIC_RELEASE, "agent");
            asm volatile("s_waitcnt vmcnt(0)" ::: "memory");
            const unsigned og = xb_add(&bar[XB_TOP], 1u);
            const unsigned tg = og / nx;
            if (og + 1u == (tg + 1u) * nx) xb_add(&bar[XB_TOPGEN], 1u);
            else XB_SPIN(xb_ld(&bar[XB_TOPGEN]) == tg, bar);
            __builtin_amdgcn_fence(__ATOMIC_ACQUIRE, "agent");
            xb_add(&bar[XB_XGEN(b.x)], 1u);
            asm volatile("s_waitcnt vmcnt(0)" ::: "memory");
        } else {
            XB_SPIN(xb_ld(&bar[XB_XGEN(b.x)]) == gen, bar);
            __builtin_amdgcn_fence(__ATOMIC_ACQUIRE, "agent");
            asm volatile("s_waitcnt vmcnt(0)" ::: "memory");
        }
    }
    __syncthreads();
}

enum InIdx { I_XP = 0, I_XS, I_CP, I_CS, I_CK, I_CV, I_SCL, I_SL, I_SCF, I_WADA, I_BADA, I_GPM, I_WIN, I_WCL, I_BCL, I_WGA, I_BGA, I_WGX, I_BGX, I_LAM, I_GGA, I_GGL,
             I_WOUT, I_GPOM, I_GPF, I_WUP, I_WCF, I_BCF, I_WDOWN, I_GPOF, N_IN };
struct Args { const float* in[N_IN]; float* out; unsigned char* ws; int ph_lo, ph_hi, li, pad; };
typedef const __attribute__((address_space(4))) Args KArgs;
struct Frame {
    LAS unsigned char* lds;
    volatile LAS unsigned* MISC;
    gu32* ctl;
    int tid, lane, wave, vcu, G;
};
__device__ __forceinline__ const float* xrow_of(KArgs& A, int m) { return m < SEQ ? A.in[I_XP] + (size_t)m * DM : A.in[I_XS] + (size_t)(m - SEQ) * DM; }
__device__ __forceinline__ int modrow_of(int m) { return m < SEQ ? 0 : 1 + ((m - SEQ) >> 5); }

template <bool UPMAP = false>
__device__ __forceinline__ void p0_transpose_item(const float* W, int K, int N, bf16* WT, LAS float* scr, int item, int lane) {
    const int nblk = N / 32, kb = item / nblk, nb = item % nblk, k0 = 64 * kb, n0 = 32 * nb;
    const int d0 = UPMAP ? (n0 < DFF ? (n0 >> 7) * 256 + (n0 & 127) : ((n0 - DFF) >> 7) * 256 + 128 + ((n0 - DFF) & 127)) : n0;
    float t[32];
    const float* wp = W + (size_t)(k0 + (lane >> 5)) * N + n0 + (lane & 31);
#pragma unroll
    for (int i = 0; i < 32; ++i) t[i] = wp[(size_t)(2 * i) * N];
#pragma unroll
    for (int i = 0; i < 32; ++i) scr[(2 * i + (lane >> 5)) * 33 + (lane & 31)] = t[i];
    LDS_WAIT(); asm volatile("" ::: "memory");
    const int c = lane & 7;
#pragma unroll
    for (int j = 0; j < 4; ++j) { const int n = (lane >> 3) + 8 * j; const LAS float* s = scr + (8 * c) * 33 + n;
        v4u o; o.x = pk2(s[0 * 33], s[1 * 33]); o.y = pk2(s[2 * 33], s[3 * 33]); o.z = pk2(s[4 * 33], s[5 * 33]); o.w = pk2(s[6 * 33], s[7 * 33]);
        *(GAS v4u*)(WT + (size_t)(d0 + n) * K + k0 + 8 * c) = o; }
    LDS_WAIT(); asm volatile("" ::: "memory");
}
constexpr int IT_UP = (DM / 64) * (DFF2 / 32), IT_DOWN = (DFF / 64) * (DM / 32);
constexpr int IT_DOWN_TAIL = 22016;
constexpr int IT_UP_TAIL = 44032;
template <bool UPMAP>
__device__ __forceinline__ void tail_convert(Frame& F, const float* W, int K, int N, bf16* WT, int nitems, int nunits) {
    const int G = F.G, c = (int)blockIdx.x, rounds = (nunits + G - 1) / G, nlast = nunits - (rounds - 1) * G;
    const bool all = (nlast == G); if (!all && c < nlast) return;
    const int nidle = all ? G : G - nlast, ii = (all ? c : c - nlast) * NWAVES + F.wave;
    LAS float* scr = (LAS float*)(F.lds + F.wave * 16384);
    for (int it = ii; it < nitems; it += nidle * NWAVES) p0_transpose_item<UPMAP>(W, K, N, WT, scr, it, F.lane);
}
__device__ __forceinline__ void p0_prologue(Frame& F, KArgs& A) {
    unsigned char* ws = A.ws;
    LAS float* scr = (LAS float*)(F.lds + F.wave * 16384);
    const int gw = F.vcu * NWAVES + F.wave, NGW = F.G * NWAVES;
    constexpr int IT_IN = (DM / 64) * (DIN / 32), IT_OUT = (DM / 64) * (DM / 32), IT_G = 2 * NBLK * 8;
    constexpr int NITEMS = IT_IN + IT_OUT + IT_G + (IT_UP - IT_UP_TAIL) + (IT_DOWN - IT_DOWN_TAIL);
    for (int it = gw; it < NITEMS; it += NGW) {
        int r = it;
        if (r < IT_IN) { p0_transpose_item(A.in[I_WIN], DM, DIN, (bf16*)(ws + WS_WIN), scr, r, F.lane); continue; } r -= IT_IN;
        if (r < IT_OUT) { p0_transpose_item(A.in[I_WOUT], DM, DM, (bf16*)(ws + WS_WOUT), scr, r, F.lane); continue; } r -= IT_OUT;
        if (r < IT_G) { const int gb = r >> 3, sub = r & 7;
          const float* Wg = (gb < NBLK ? A.in[I_WGA] : A.in[I_WGX]) + (size_t)(gb & 15) * LBLK * LBLK;
          p0_transpose_item(Wg, LBLK, LBLK, (bf16*)(ws + WS_GATET) + (size_t)gb * LBLK * LBLK, scr, sub, F.lane); continue; } r -= IT_G;
        if (r < IT_UP - IT_UP_TAIL) { p0_transpose_item<true>(A.in[I_WUP], DM, DFF2, (bf16*)(ws + WS_WUP), scr, IT_UP_TAIL + r, F.lane); continue; } r -= IT_UP - IT_UP_TAIL;
        p0_transpose_item(A.in[I_WDOWN], DFF, DM, (bf16*)(ws + WS_WDOWN), scr, IT_DOWN_TAIL + r, F.lane);
    }
    __syncthreads();
    float* MOD = (float*)(ws + WS_MOD);
    LAS float* RED = (LAS float*)F.lds;
    const int jj = F.lane & 15, kh = F.lane >> 4;
    typedef float f32x2v __attribute__((ext_vector_type(2)));
    for (int strip = F.vcu; strip < NMODC / 96; strip += F.G) {
        const int col0 = strip * 96;
        const float* wp = A.in[I_WADA] + (size_t)(512 * F.wave + kh) * NMODC + col0 + 6 * jj;
        const float* cs = A.in[I_CS] + (size_t)jj * DM + 512 * F.wave + kh;
        const float* cp = A.in[I_CP] + 512 * F.wave + kh;
        f32x4 acc[6]; float a0[6];
#pragma unroll
        for (int g = 0; g < 6; ++g) { acc[g] = (f32x4){0.f, 0.f, 0.f, 0.f}; a0[g] = 0.f; }
#pragma unroll 4
        for (int st = 0; st < 128; ++st) {
            const float* wr = wp + (size_t)(4 * st) * NMODC;
            const f32x2v w01 = *(const f32x2v*)wr, w23 = *(const f32x2v*)(wr + 2), wb = *(const f32x2v*)(wr + 4); const f32x4 wa = (f32x4){w01.x, w01.y, w23.x, w23.y};
            const float cv = cs[4 * st], c0 = cp[4 * st];
            const float sv = cv * sigmoidf_(cv), s0 = c0 * sigmoidf_(c0);
            acc[0] = __builtin_amdgcn_mfma_f32_16x16x4f32(sv, wa.x, acc[0], 0, 0, 0); acc[1] = __builtin_amdgcn_mfma_f32_16x16x4f32(sv, wa.y, acc[1], 0, 0, 0);
            acc[2] = __builtin_amdgcn_mfma_f32_16x16x4f32(sv, wa.z, acc[2], 0, 0, 0); acc[3] = __builtin_amdgcn_mfma_f32_16x16x4f32(sv, wa.w, acc[3], 0, 0, 0);
            acc[4] = __builtin_amdgcn_mfma_f32_16x16x4f32(sv, wb.x, acc[4], 0, 0, 0); acc[5] = __builtin_amdgcn_mfma_f32_16x16x4f32(sv, wb.y, acc[5], 0, 0, 0);
            a0[0] += s0 * wa.x; a0[1] += s0 * wa.y; a0[2] += s0 * wa.z; a0[3] += s0 * wa.w; a0[4] += s0 * wb.x; a0[5] += s0 * wb.y;
        }
#pragma unroll
        for (int g = 0; g < 6; ++g) { a0[g] += __shfl_xor(a0[g], 16); a0[g] += __shfl_xor(a0[g], 32); }
        LAS float* rw = RED + (size_t)F.wave * NB * 96;
#pragma unroll
        for (int g = 0; g < 6; ++g) {
#pragma unroll
            for (int rg = 0; rg < 4; ++rg) rw[(1 + 4 * kh + rg) * 96 + 6 * jj + g] = acc[g][rg];
            if (kh == 0) rw[6 * jj + g] = a0[g]; }
        __syncthreads();
        for (int idx = F.tid; idx < NB * 96; idx += 512) { float t = 0.f;
#pragma unroll
            for (int w = 0; w < NWAVES; ++w) t += RED[w * NB * 96 + idx];
            const int bb = idx / 96, c = idx % 96; MOD[(size_t)bb * NMODC + col0 + c] = t + A.in[I_BADA][col0 + c]; }
        __syncthreads();
    }
}

template <bool PROMPT>
__device__ __forceinline__ void p1_row(Frame& F, KArgs& A, int m, const LAS f32x4* LA, const LAS f32x4* LC) {
    const float* MOD = (const float*)(A.ws + WS_MOD); bf16* H = (bf16*)(A.ws + WS_ACT);
    const f32x4* xr = (const f32x4*)xrow_of(A, m) + F.lane;
    f32x4 v[16]; float ss = 0.f;
#pragma unroll
    for (int j = 0; j < 16; ++j) { v[j] = __builtin_nontemporal_load(xr + 64 * j); ss += (v[j].x * v[j].x + v[j].y * v[j].y) + (v[j].z * v[j].z + v[j].w * v[j].w); }
    const float rstd = 1.0f / sqrtf(wave_sum(ss) * (1.0f / DM) + EPS);
    v2u* o = (v2u*)(H + (size_t)m * DM) + F.lane;
    if (PROMPT) {
#pragma unroll
        for (int j = 0; j < 16; ++j) { const f32x4 y = v[j] * rstd * LA[F.lane + 64 * j] + LC[F.lane + 64 * j]; v2u w; w.x = pk2(y.x, y.y); w.y = pk2(y.z, y.w); __builtin_nontemporal_store(w, o + 64 * j); if ((j & 3) == 3) asm volatile("" ::: "memory"); }
    } else {
        const f32x4* g4 = (const f32x4*)A.in[I_GPM] + F.lane;
        const float* mr = MOD + (size_t)modrow_of(m) * NMODC; const f32x4* sh4 = (const f32x4*)mr + F.lane; const f32x4* sc4 = (const f32x4*)(mr + DM) + F.lane;
#pragma unroll
        for (int j = 0; j < 16; ++j) { const f32x4 g = g4[64 * j], sc = sc4[64 * j], sh = sh4[64 * j];
            const f32x4 y = v[j] * rstd * g * (1.0f + sc) + sh; v2u w; w.x = pk2(y.x, y.y); w.y = pk2(y.z, y.w); __builtin_nontemporal_store(w, o + 64 * j); }
    }
}
__device__ __forceinline__ void p1_load(KArgs& A, int m, int lane, f32x4 (&v)[16]) {
    const f32x4* xr = (const f32x4*)xrow_of(A, m) + lane;
#pragma unroll
    for (int j = 0; j < 16; ++j) v[j] = __builtin_nontemporal_load(xr + 64 * j);
}
__device__ __forceinline__ void p1_proc(Frame& F, KArgs& A, int m, const f32x4 (&v)[16], const LAS f32x4* LA, const LAS f32x4* LC) {
    float ss = 0.f;
#pragma unroll
    for (int j = 0; j < 16; ++j) ss += (v[j].x * v[j].x + v[j].y * v[j].y) + (v[j].z * v[j].z + v[j].w * v[j].w);
    const float rstd = 1.0f / sqrtf(wave_sum(ss) * (1.0f / DM) + EPS);
    v2u* o = (v2u*)((bf16*)(A.ws + WS_ACT) + (size_t)m * DM) + F.lane;
#pragma unroll
    for (int j = 0; j < 16; ++j) { const f32x4 y = v[j] * rstd * LA[F.lane + 64 * j] + LC[F.lane + 64 * j]; v2u w; w.x = pk2(y.x, y.y); w.y = pk2(y.z, y.w); __builtin_nontemporal_store(w, o + 64 * j); if ((j & 3) == 3) asm volatile("" ::: "memory"); }
}
__device__ __forceinline__ void wg_sum2(Frame& F, float a, float b, LAS float* red, float& ta, float& tb) {
    a = wave_sum(a); b = wave_sum(b);
    if (F.lane == 0) { red[F.wave] = a; red[8 + F.wave] = b; }
    __syncthreads();
    ta = 0.f; tb = 0.f;
#pragma unroll
    for (int w = 0; w < NWAVES; ++w) { ta += red[w]; tb += red[8 + w]; }
}
__device__ __forceinline__ void p1_samples(Frame& F, KArgs& A) {
    LAS float* red = (LAS float*)(F.lds + 65536);
    const float* MOD = (const float*)(A.ws + WS_MOD);
    const int cb = 128 * F.wave + F.lane;
#pragma unroll 1
    for (int j = 0; F.vcu + j * F.G < M - SEQ; j += 2) {
        const int sra = F.vcu + j * F.G, srb_ = sra + F.G; const bool hasb = srb_ < M - SEQ; const int srb = hasb ? srb_ : sra;
        const int sr[2] = {sra, srb};
        f32x4 v[2][2]; float s0 = 0.f, s1 = 0.f;
#pragma unroll
        for (int r = 0; r < 2; ++r)
#pragma unroll
            for (int q = 0; q < 2; ++q) { v[r][q] = ((const f32x4*)(A.in[I_XS] + (size_t)sr[r] * DM))[cb + 64 * q];
                const float e = (v[r][q].x * v[r][q].x + v[r][q].y * v[r][q].y) + (v[r][q].z * v[r][q].z + v[r][q].w * v[r][q].w); if (r == 0) s0 += e; else s1 += e; }
        float t0, t1; wg_sum2(F, s0, s1, red, t0, t1);
        const float rstd[2] = {1.0f / sqrtf(t0 * (1.0f / DM) + EPS), 1.0f / sqrtf(t1 * (1.0f / DM) + EPS)};
#pragma unroll
        for (int r = 0; r < 2; ++r) { const float* mo = MOD + (size_t)(1 + (sr[r] >> 5)) * NMODC;
#pragma unroll
            for (int q = 0; q < 2; ++q) { const int ci = cb + 64 * q;
                const f32x4 y = v[r][q] * rstd[r] * ((const f32x4*)A.in[I_GPM])[ci] * (1.0f + ((const f32x4*)(mo + DM))[ci]) + ((const f32x4*)mo)[ci];
                if (r == 0 || hasb) { v2u w; w.x = pk2(y.x, y.y); w.y = pk2(y.z, y.w); ((v2u*)((bf16*)(A.ws + WS_ACT) + (size_t)(SEQ + sr[r]) * DM))[ci] = w; } } }
        __syncthreads();
    }
}
__device__ __forceinline__ void p1_h1(Frame& F, KArgs& A) {
    const int gw = F.vcu * NWAVES + F.wave, NGW = F.G * NWAVES;
    const float* MOD = (const float*)(A.ws + WS_MOD);
    LAS f32x4* LA = (LAS f32x4*)F.lds; LAS f32x4* LC = LA + DM / 4;
    for (int i = F.tid; i < DM / 4; i += NWAVES * 64) { const f32x4 g = ((const f32x4*)A.in[I_GPM])[i], sh = ((const f32x4*)MOD)[i], sc = ((const f32x4*)(MOD + DM))[i]; LA[i] = g * (1.0f + sc); LC[i] = sh; }
    __syncthreads();
    { f32x4 va[16], vb[16]; int m = gw;
      if (m < SEQ) p1_load(A, m, F.lane, va);
#pragma unroll 1
      for (; m < SEQ; m += 2 * NGW) {
          if (m + NGW < SEQ) p1_load(A, m + NGW, F.lane, vb);
          p1_proc(F, A, m, va, LA, LC);
          if (m + NGW < SEQ) { if (m + 2 * NGW < SEQ) p1_load(A, m + 2 * NGW, F.lane, va); p1_proc(F, A, m + NGW, vb, LA, LC); }
      } }
    p1_samples(F, A);
}

__device__ __forceinline__ void lru_unit(Frame& F, KArgs& A, int blk, int c, LAS unsigned char* wl, const LAS unsigned char* gw_lds) {
    int lane_ = F.lane; asm volatile("" : "+v"(lane_));
    const int lane = lane_, r = lane & 31, h = lane >> 5;
    const int row0 = 32 * c;
    const bf16* PROJ = (const bf16*)(A.ws + WS_PROJ);
    {
        const int cg = lane & 31, th = lane >> 5, chg = blk * LBLK + 4 * cg;
        const bf16* xp = PROJ + (size_t)row0 * DIN + 6144 + chg;
        const int t0 = 16 * th;
        v2u cur[16];
#pragma unroll
        for (int i = 0; i < 16; ++i) cur[i] = *(const v2u*)(xp + (size_t)(t0 + i) * DIN);
        f32x4 x3, x2, x1;
        if (th == 1 || (c > 0 && c < 512)) {
            const v2u a = *(const v2u*)(xp + (ptrdiff_t)(t0 - 3) * DIN), b = *(const v2u*)(xp + (ptrdiff_t)(t0 - 2) * DIN), d = *(const v2u*)(xp + (ptrdiff_t)(t0 - 1) * DIN);
            x3 = (f32x4){bf_lo(a.x), bf_hi(a.x), bf_lo(a.y), bf_hi(a.y)}; x2 = (f32x4){bf_lo(b.x), bf_hi(b.x), bf_lo(b.y), bf_hi(b.y)}; x1 = (f32x4){bf_lo(d.x), bf_hi(d.x), bf_lo(d.y), bf_hi(d.y)};
        } else if (c == 0) { x3 = x2 = x1 = (f32x4){0.f, 0.f, 0.f, 0.f}; }
        else { const float* st = A.in[I_SCL] + (size_t)(c - 512) * 3 * DLRU + chg;
            x3 = *(const f32x4*)(st); x2 = *(const f32x4*)(st + DLRU); x1 = *(const f32x4*)(st + 2 * DLRU); }
        const f32x4 w0 = *(const f32x4*)(A.in[I_WCL] + 0 * DLRU + chg), w1 = *(const f32x4*)(A.in[I_WCL] + 1 * DLRU + chg), w2 = *(const f32x4*)(A.in[I_WCL] + 2 * DLRU + chg),
                    w3 = *(const f32x4*)(A.in[I_WCL] + 3 * DLRU + chg), bb = *(const f32x4*)(A.in[I_BCL] + chg);
#pragma unroll
        for (int i = 0; i < 16; ++i) { const int t = t0 + i; const v2u a = cur[i];
            const f32x4 x0 = (f32x4){bf_lo(a.x), bf_hi(a.x), bf_lo(a.y), bf_hi(a.y)};
            const f32x4 y = bb + w3 * x0 + w2 * x1 + w1 * x2 + w0 * x3;
            v2u o; o.x = pk2(y.x, y.y); o.y = pk2(y.z, y.w); *(LAS v2u*)(wl + t * XROW + 8 * cg) = o;
            x3 = x2; x2 = x1; x1 = x0; }
    }
    LDS_WAIT(); asm volatile("" ::: "memory");
    bf16x8 af[8];
#pragma unroll
    for (int kk = 0; kk < 8; ++kk) af[kk] = *(const LAS bf16x8*)(wl + r * XROW + (16 * kk + 8 * h) * 2);
    unsigned* HP = (unsigned*)(A.ws + WS_HP);
#pragma unroll 1
    for (int nt = 0; nt < 4; ++nt) {
        const int dl = 32 * nt + r, ch = blk * LBLK + dl;
        const float bga = A.in[I_BGA][ch], bgx = A.in[I_BGX][ch], lam = A.in[I_LAM][ch];
        f32x16 ga, gx;
#pragma unroll
        for (int i = 0; i < 16; ++i) { ga[i] = 0.f; gx[i] = 0.f; }
#pragma unroll
        for (int kk = 0; kk < 8; ++kk) { const int off = dl * 256 + (((2 * kk + h) ^ (dl & 15)) << 4);
            const bf16x8 fa = *(const LAS bf16x8*)(gw_lds + off), fx = *(const LAS bf16x8*)(gw_lds + 32768 + off);
            ga = __builtin_amdgcn_mfma_f32_32x32x16_bf16(af[kk], fa, ga, 0, 0, 0); gx = __builtin_amdgcn_mfma_f32_32x32x16_bf16(af[kk], fx, gx, 0, 0, 0); }
        const float spl8 = 8.0f * (fmaxf(-lam, 0.f) + 0.6931471805599453f * flog2(1.0f + fexp2(-1.4426950408889634f * fabsf(lam))));
#pragma unroll
        for (int i = 0; i < 16; ++i) { const int t = (i & 3) + 8 * (i >> 2) + 4 * h;
            const float xc = __builtin_bit_cast(float, (unsigned)(*(const LAS unsigned short*)(wl + t * XROW + 2 * dl)) << 16);
            const float rg = sigmoidf_(ga[i] + bga), ig = sigmoidf_(gx[i] + bgx);
            const float la = -rg * spl8, x2 = 2.0f * la, av = fexp2(1.4426950408889634f * la);
            const float om = (x2 > -0.125f) ? -x2 * (1.0f + x2 * (0.5f + x2 * (0.16666667f + x2 * (0.041666668f + x2 * 0.0083333338f)))) : 1.0f - av * av;
            ga[i] = av; gx[i] = fsqrt(om) * (ig * xc); }
        float TH[4], TP[4], OH[4], OP[4];
#pragma unroll
        for (int a = 0; a < 4; ++a) { float hl = 0.f, pl = 1.f;
#pragma unroll
            for (int e = 0; e < 4; ++e) { hl = ga[4 * a + e] * hl + gx[4 * a + e]; pl = pl * ga[4 * a + e]; gx[4 * a + e] = hl; ga[4 * a + e] = pl; }
            TH[a] = hl; TP[a] = pl; }
#pragma unroll
        for (int a = 0; a < 4; ++a) { OH[a] = __shfl_xor(TH[a], 32); OP[a] = __shfl_xor(TP[a], 32); }
        float hs = 0.f, pc = 1.f, cH[4], cP[4];
#pragma unroll
        for (int a = 0; a < 4; ++a) {
            const float eH = h ? OH[a] : TH[a], eP = h ? OP[a] : TP[a], oH = h ? TH[a] : OH[a], oP = h ? TP[a] : OP[a];
            const float h1 = eP * hs + eH, p1 = pc * eP;
            cH[a] = h ? h1 : hs; cP[a] = h ? p1 : pc;
            hs = oP * h1 + oH; pc = p1 * oP; }
#pragma unroll
        for (int a = 0; a < 4; ++a)
#pragma unroll
            for (int e = 0; e < 4; ++e) { gx[4 * a + e] = gx[4 * a + e] + ga[4 * a + e] * cH[a]; ga[4 * a + e] = ga[4 * a + e] * cP[a]; }
#pragma unroll
        for (int i = 0; i < 16; ++i) { const int t = (i & 3) + 8 * (i >> 2) + 4 * h; HP[(size_t)(row0 + t) * DLRU + ch] = pk2(gx[i], ga[i]); }
        if (h == 0) { ((float*)(A.ws + WS_AGGH))[(size_t)c * DLRU + ch] = hs; ((float*)(A.ws + WS_AGGA))[(size_t)c * DLRU + ch] = pc; }
    }
    LDS_WAIT(); asm volatile("" ::: "memory");
}

__device__ __forceinline__ s16x4 vtr(const LAS unsigned char* p) { typedef short v4i16_t __attribute__((ext_vector_type(4))); return __builtin_bit_cast(s16x4, __builtin_amdgcn_ds_read_tr16_b64_v4i16((LAS v4i16_t*)p)); }
__device__ __forceinline__ unsigned cvtpk(float lo, float hi) { return pk2(lo, hi); }
__device__ __forceinline__ f32x16 sb_qk(const bf16x8 (&kf)[8], const bf16x8 (&qf)[8]) {
    f32x16 s;
#pragma unroll
    for (int i = 0; i < 16; ++i) s[i] = 0.f;
#pragma unroll
    for (int kk = 0; kk < 8; ++kk) s = __builtin_amdgcn_mfma_f32_32x32x16_bf16(kf[kk], qf[kk], s, 0, 0, 0);
    return s;
}
template <bool DIAG>
__device__ __forceinline__ void sb_block(const f32x16& s, f32x16 (&o)[4], float& R, const LAS unsigned char* vl, int lane) {
    const int r = lane & 31, h = lane >> 5;
    float lb[16], lk[16];
#pragma unroll
    for (int i = 0; i < 16; ++i) { const float z = s[i] * 0.12751743082459868f;
        const float sp = fmaxf(-z, 0.f) + flog2(1.0f + fexp2(-fabsf(z)));
        lb[i] = -sp; lk[i] = -sp - z;
        if (DIAG) { const int key = (i & 3) + 8 * (i >> 2) + 4 * h; if (!(key < r)) lk[i] = 0.f; } }
    float p[16], tot[4], oth[4];
#pragma unroll
    for (int a = 0; a < 4; ++a) { p[4 * a + 3] = 0.f; p[4 * a + 2] = lk[4 * a + 3]; p[4 * a + 1] = p[4 * a + 2] + lk[4 * a + 2]; p[4 * a] = p[4 * a + 1] + lk[4 * a + 1]; tot[a] = p[4 * a] + lk[4 * a]; }
#pragma unroll
    for (int a = 0; a < 4; ++a) oth[a] = __shfl_xor(tot[a], 32);
    float E[4], Od[4];
#pragma unroll
    for (int a = 0; a < 4; ++a) { E[a] = h ? oth[a] : tot[a]; Od[a] = h ? tot[a] : oth[a]; }
    float suf[8]; suf[7] = 0.f; suf[6] = Od[3]; suf[5] = suf[6] + E[3]; suf[4] = suf[5] + Od[2]; suf[3] = suf[4] + E[2]; suf[2] = suf[3] + Od[1]; suf[1] = suf[2] + E[1]; suf[0] = suf[1] + Od[0];
    const float total = suf[0] + E[0];
    float w[16];
#pragma unroll
    for (int a = 0; a < 4; ++a) { const float off = R + (h ? suf[2 * a + 1] : suf[2 * a]);
#pragma unroll
        for (int e = 0; e < 4; ++e) { const int i = 4 * a + e; float x = fexp2(lb[i] + off + p[i]);
            if (DIAG) { const int key = e + 8 * a + 4 * h; if (!(key < r)) x = 0.f; }
            w[i] = x; } }
    R += total;
    const int i16 = lane & 15, q = i16 >> 2, pp = i16 & 3, rb = (lane >> 4) & 1;
#pragma unroll
    for (int st = 0; st < 2; ++st) {
        v4u pa; pa.x = cvtpk(w[8 * st], w[8 * st + 1]); pa.y = cvtpk(w[8 * st + 2], w[8 * st + 3]); pa.z = cvtpk(w[8 * st + 4], w[8 * st + 5]); pa.w = cvtpk(w[8 * st + 6], w[8 * st + 7]);
        const bf16x8 wa = __builtin_bit_cast(bf16x8, pa);
        const LAS unsigned char* vb = vl + (16 * st + 4 * h + q) * VROW + (16 * rb + 4 * pp) * 2;
        s16x4 vlo[4], vhi[4];
#pragma unroll
        for (int dt = 0; dt < 4; ++dt) { vlo[dt] = vtr(vb + 64 * dt); vhi[dt] = vtr(vb + 8 * VROW + 64 * dt); }
        __builtin_amdgcn_sched_barrier(0);
#pragma unroll
        for (int dt = 0; dt < 4; ++dt) { const bf16x8 f = __builtin_shufflevector(vlo[dt], vhi[dt], 0, 1, 2, 3, 4, 5, 6, 7);
            o[dt] = __builtin_amdgcn_mfma_f32_32x32x16_bf16(wa, f, o[dt], 0, 0, 0); }
    }
}
__device__ __forceinline__ void attn_load_kv(KArgs& A, const bf16* PROJ, int sb, int head, int qrow0, int j, int lane, v4u (&kr)[8], v4u (&vv)[8]) {
    const int vrow = lane >> 4, vch = lane & 15;
    if (sb < 0 || j == 0) {
        const int krow0 = qrow0 - 32 * j;
        const bf16* kp = PROJ + (size_t)(krow0 + vrow) * DIN + DSB + head * HD + 8 * vch;
#pragma unroll
        for (int i = 0; i < 8; ++i) kr[i] = *(const v4u*)(kp + (size_t)(4 * i) * DIN);
        const bf16* vp = kp + DSB;
#pragma unroll
        for (int i = 0; i < 8; ++i) vv[i] = *(const v4u*)(vp + (size_t)(4 * i) * DIN);
    } else {
        const int pos0 = PAST - 32 * j;
        const size_t off = (((size_t)sb * PAST + pos0 + vrow) * NH + head) * HD + 8 * vch;
        const float* kp = A.in[I_CK] + off;
#pragma unroll
        for (int i = 0; i < 8; ++i) { const float* k = kp + (size_t)(4 * i) * NH * HD; const f32x4 a = *(const f32x4*)k, b = *(const f32x4*)(k + 4);
            v4u t; t.x = pk2(a.x, a.y); t.y = pk2(a.z, a.w); t.z = pk2(b.x, b.y); t.w = pk2(b.z, b.w); kr[i] = t; }
        const float* vp = A.in[I_CV] + off;
#pragma unroll
        for (int i = 0; i < 8; ++i) { const float* v = vp + (size_t)(4 * i) * NH * HD; const f32x4 a = *(const f32x4*)v, b = *(const f32x4*)(v + 4);
            v4u t; t.x = pk2(a.x, a.y); t.y = pk2(a.z, a.w); t.z = pk2(b.x, b.y); t.w = pk2(b.z, b.w); vv[i] = t; }
    }
}
constexpr int KROW = 272;
__device__ __forceinline__ f32x16 attn_stage_qk(LAS unsigned char* wl, int lane, const v4u (&kr)[8], const v4u (&vn)[8], const bf16x8 (&qf)[8]) {
    const int r = lane & 31, h = lane >> 5, vrow = lane >> 4, vch = lane & 15;
#pragma unroll
    for (int i = 0; i < 8; ++i) *(LAS v4u*)(wl + (4 * i + vrow) * KROW + 16 * vch) = kr[i];
    LDS_WAIT(); asm volatile("" ::: "memory");
    f32x16 s;
#pragma unroll
    for (int i = 0; i < 16; ++i) s[i] = 0.f;
    const LAS unsigned char* kb = wl + r * KROW + 16 * h;
#pragma unroll
    for (int hf = 0; hf < 2; ++hf) {
        bf16x8 kf[4];
#pragma unroll
        for (int kk = 0; kk < 4; ++kk) kf[kk] = *(const LAS bf16x8*)(kb + 32 * (4 * hf + kk));
        LDS_WAIT(); asm volatile("" ::: "memory");
#pragma unroll
        for (int kk = 0; kk < 4; ++kk) s = __builtin_amdgcn_mfma_f32_32x32x16_bf16(kf[kk], qf[4 * hf + kk], s, 0, 0, 0);
    }
#pragma unroll
    for (int i = 0; i < 8; ++i) *(LAS v4u*)(wl + (4 * i + vrow) * VROW + 16 * vch) = vn[i];
    return s;
}
__device__ __forceinline__ void attn_unit(Frame& F, KArgs& A, int unit, LAS unsigned char* wl) {
    int lane_ = F.lane; asm volatile("" : "+v"(lane_));
    const int lane = lane_, r = lane & 31, h = lane >> 5;
    const bf16* PROJ = (const bf16*)(A.ws + WS_PROJ);
    int head, qrow0, npast, sb = -1;
    if (unit < 512 * NH) { head = unit >> 9; const int qb = unit & 511; qrow0 = 32 * qb; npast = qb; }
    else { const int us = unit - 512 * NH; sb = us >> 4; head = us & 15; qrow0 = SEQ + 32 * sb; npast = PAST / 32; }
    bf16x8 qf[8]; v4u kr[8], vn[8];
    attn_load_kv(A, PROJ, sb, head, qrow0, 0, lane, kr, vn);
    { const bf16* qp = PROJ + (size_t)(qrow0 + r) * DIN + head * HD + 8 * h;
#pragma unroll
      for (int kk = 0; kk < 8; ++kk) qf[kk] = *(const bf16x8*)(qp + 16 * kk); }
    f32x16 o[4];
#pragma unroll
    for (int dt = 0; dt < 4; ++dt)
#pragma unroll
        for (int i = 0; i < 16; ++i) o[dt][i] = 0.f;
    float R = 0.f;
    { const f32x16 s = attn_stage_qk(wl, lane, kr, vn, qf);
      if (npast > 0) attn_load_kv(A, PROJ, sb, head, qrow0, 1, lane, kr, vn);
      LDS_WAIT(); asm volatile("" ::: "memory");
      sb_block<true>(s, o, R, wl, lane); }
#pragma unroll 1
    for (int j = 1; j <= npast; ++j) {
        if (__all(R < -152.0f)) break;
        LDS_WAIT(); asm volatile("" ::: "memory");
        const f32x16 s = attn_stage_qk(wl, lane, kr, vn, qf);
        if (j < npast) attn_load_kv(A, PROJ, sb, head, qrow0, j + 1, lane, kr, vn);
        LDS_WAIT(); asm volatile("" ::: "memory");
        sb_block<false>(s, o, R, wl, lane);
    }
    LDS_WAIT(); asm volatile("" ::: "memory");
    bf16* OSB = (bf16*)(A.ws + WS_OSB);
#pragma unroll
    for (int dt = 0; dt < 4; ++dt)
#pragma unroll
        for (int i = 0; i < 16; ++i) { const int qq = (i & 3) + 8 * (i >> 2) + 4 * h; OSB[(size_t)(qrow0 + qq) * DSB + head * HD + 32 * dt + r] = (bf16)f2bf(o[dt][i]); }
}
__device__ __forceinline__ void lru_load_weights(LAS unsigned char* lds, const bf16* GT, int blk, int tid) {
    for (int idx = tid; idx < 2 * LBLK * 16; idx += NWAVES * 64) { const int gate = idx >> 11, row = (idx >> 4) & 127, ch = idx & 15;
        const v4u w = *(const v4u*)(GT + ((size_t)(gate * NBLK + blk) * LBLK + row) * LBLK + 8 * ch);
        *(LAS v4u*)(lds + gate * 32768 + row * 256 + ((ch ^ (row & 15)) << 4)) = w; }
}
__device__ __forceinline__ void p3_mixers(Frame& F, KArgs& A) {
    const int gw = F.vcu * NWAVES + F.wave, NGW = F.G * NWAVES;
    LAS unsigned char* wl = F.wave < 7 ? F.lds + 65536 + F.wave * WAVE_LDS : F.lds + EXCH_OFF;
    static_assert(65536 + 7 * WAVE_LDS <= RING_BYTES && EXCH_OFF + WAVE_LDS <= LDS_BYTES, "P3 LDS map");
    bool first = true;
#pragma unroll 1
    for (int p = F.vcu; first || p < NBLK * 16; p += F.G) {
        const bool has_pair = p < NBLK * 16; const int blk = has_pair ? p >> 4 : 0, slot = p & 15;
        if (!first) __syncthreads();
        lru_load_weights(F.lds, (const bf16*)(A.ws + WS_GATET), blk, F.tid);
        __syncthreads();
#pragma unroll 1
        for (int pass = 0; pass < 2; ++pass) {
            if ((pass ^ (F.wave >> 2)) == 0) {
#pragma unroll 1
                for (int k = 0; has_pair; ++k) {
                    int i;
                    if (F.G == 256) { const int w = F.wave; const bool light = (w == 5 || w == 6);
                        if (k < 3 || (k == 3 && !light)) i = w + 8 * k; else if (k == 4 && w >= 1 && w <= 3) i = (w == 1) ? 29 : (w == 2) ? 30 : 32; else break; }
                    else { i = F.wave + NWAVES * k; if (i >= 33) break; }
                    lru_unit(F, A, blk, 33 * slot + i, wl, F.lds); }
            } else if (first) {
#pragma unroll 1
                for (int k = 0;; ++k) {
                    int u;
                    if (F.G == 256) {
                        int kk;
                        if (F.wave < 7) { if (k < 4) kk = F.wave + 8 * k; else if (k == 4 && F.wave >= 5) kk = (F.wave == 5) ? 23 : 31; else break; u = F.vcu * 32 + kk; }
                        else { if (k == 0) u = 512 * NH + F.vcu; else if (k < 3) u = F.vcu * 32 + 7 + 8 * (k - 1); else break; }
                    } else {
                        u = gw + k * NGW;
                        if (u >= 512 * NH) { const int e = F.vcu + ((u - 512 * NH) / NGW) * F.G; if (F.wave != NWAVES - 1 || e >= NDEC * NH) break; u = 512 * NH + e; }
                    }
                    attn_unit(F, A, u, wl); }
            }
        }
        first = false;
    }
}

__device__ __forceinline__ void p4_carry(Frame& F, KArgs& A) {
    const float* AGA = (const float*)(A.ws + WS_AGGA); const float* AGH = (const float*)(A.ws + WS_AGGH); float* CARRY = (float*)(A.ws + WS_CARRY);
    LAS float* LA = (LAS float*)F.lds; LAS float* LH = LA + 512;
    for (int j = F.vcu; j < DLRU / 32; j += F.G) {
        const int g = F.tid >> 5, cl = F.tid & 31, ch = 32 * j + cl;
        float a[32], hh[32]; float ca = 1.f, chh = 0.f;
#pragma unroll
        for (int i = 0; i < 32; ++i) { a[i] = AGA[(size_t)(32 * g + i) * DLRU + ch]; hh[i] = AGH[(size_t)(32 * g + i) * DLRU + ch]; }
#pragma unroll
        for (int i = 0; i < 32; ++i) { chh = a[i] * chh + hh[i]; ca = a[i] * ca; }
        __syncthreads();
        LA[g * 32 + cl] = ca; LH[g * 32 + cl] = chh;
        __syncthreads();
        float cin = 0.f;
        for (int gg = 0; gg < g; ++gg) cin = LA[gg * 32 + cl] * cin + LH[gg * 32 + cl];
#pragma unroll
        for (int i = 0; i < 32; ++i) { CARRY[(size_t)(32 * g + i) * DLRU + ch] = cin; cin = a[i] * cin + hh[i]; }
        if (g == 15) A.out[OUT_LP + ch] = cin;
        { const int b = g, c = 512 + b; const float h0 = A.in[I_SL][(size_t)b * DLRU + ch];
          CARRY[(size_t)c * DLRU + ch] = h0; A.out[OUT_LS + (size_t)b * DLRU + ch] = AGH[(size_t)c * DLRU + ch] + AGA[(size_t)c * DLRU + ch] * h0; }
    }
}

__device__ __forceinline__ void p5_mixnorm(Frame& F, KArgs& A) {
    const int gw = F.vcu * NWAVES + F.wave, NGW = F.G * NWAVES, lane = F.lane;
    const bf16* PROJ = (const bf16*)(A.ws + WS_PROJ); const bf16* OSB = (const bf16*)(A.ws + WS_OSB);
    const unsigned* HP = (const unsigned*)(A.ws + WS_HP); const float* CARRY = (const float*)(A.ws + WS_CARRY);
    bf16* A2 = (bf16*)(A.ws + WS_ACT);
    LAS float* LG = (LAS float*)F.lds;
    for (int i = F.tid; i < DSB; i += NWAVES * 64) { LG[i] = A.in[I_GGA][i]; LG[DSB + i] = A.in[I_GGL][i]; }
    __syncthreads();
    for (int m = gw; m < SEQ; m += NGW) {
        v4u ow[4], hq0[4], hq1[4], glw[4]; f32x4 cr0[4], cr1[4]; const int c = m >> 5;
#pragma unroll
        for (int j = 0; j < 4; ++j) { const int col = 8 * lane + 512 * j; const size_t o = (size_t)m * DLRU + col;
            ow[j] = __builtin_nontemporal_load((const v4u*)(OSB + (size_t)m * DSB + col));
            hq0[j] = __builtin_nontemporal_load((const v4u*)(HP + o)); hq1[j] = __builtin_nontemporal_load((const v4u*)(HP + o + 4));
            cr0[j] = *(const f32x4*)(CARRY + (size_t)c * DLRU + col); cr1[j] = *(const f32x4*)(CARRY + (size_t)c * DLRU + col + 4);
            glw[j] = *(const v4u*)(PROJ + (size_t)m * DIN + 8192 + col); }
        { float v[32]; float ss = 0.f;
#pragma unroll
          for (int j = 0; j < 4; ++j) { const v4u w = ow[j];
              v[8 * j] = bf_lo(w.x); v[8 * j + 1] = bf_hi(w.x); v[8 * j + 2] = bf_lo(w.y); v[8 * j + 3] = bf_hi(w.y); v[8 * j + 4] = bf_lo(w.z); v[8 * j + 5] = bf_hi(w.z); v[8 * j + 6] = bf_lo(w.w); v[8 * j + 7] = bf_hi(w.w); }
#pragma unroll
          for (int i = 0; i < 32; ++i) ss += v[i] * v[i];
          const float rstd = 1.0f / sqrtf(wave_sum(ss) * (1.0f / DSB) + EPS);
#pragma unroll
          for (int j = 0; j < 4; ++j) { const LAS float* g = LG + 8 * lane + 512 * j; const f32x4 g0 = *(const LAS f32x4*)g, g1 = *(const LAS f32x4*)(g + 4);
              v4u w; w.x = pk2(v[8 * j] * rstd * g0.x, v[8 * j + 1] * rstd * g0.y); w.y = pk2(v[8 * j + 2] * rstd * g0.z, v[8 * j + 3] * rstd * g0.w);
              w.z = pk2(v[8 * j + 4] * rstd * g1.x, v[8 * j + 5] * rstd * g1.y); w.w = pk2(v[8 * j + 6] * rstd * g1.z, v[8 * j + 7] * rstd * g1.w);
              __builtin_nontemporal_store(w, (v4u*)(A2 + (size_t)m * DM + 8 * lane + 512 * j)); } }
        { float v[32]; float ss = 0.f;
#pragma unroll
          for (int j = 0; j < 4; ++j) {
              const v4u q0 = hq0[j], q1 = hq1[j];
              const f32x4 h0 = (f32x4){bf_lo(q0.x), bf_lo(q0.y), bf_lo(q0.z), bf_lo(q0.w)}, h1 = (f32x4){bf_lo(q1.x), bf_lo(q1.y), bf_lo(q1.z), bf_lo(q1.w)}, p0 = (f32x4){bf_hi(q0.x), bf_hi(q0.y), bf_hi(q0.z), bf_hi(q0.w)}, p1 = (f32x4){bf_hi(q1.x), bf_hi(q1.y), bf_hi(q1.z), bf_hi(q1.w)};
              const f32x4 c0 = cr0[j], c1 = cr1[j];
              const v4u gw4 = glw[j];
              const f32x4 a0 = h0 + p0 * c0, a1 = h1 + p1 * c1;
              v[8 * j] = a0.x * gelu_tanh(bf_lo(gw4.x)); v[8 * j + 1] = a0.y * gelu_tanh(bf_hi(gw4.x)); v[8 * j + 2] = a0.z * gelu_tanh(bf_lo(gw4.y)); v[8 * j + 3] = a0.w * gelu_tanh(bf_hi(gw4.y));
              v[8 * j + 4] = a1.x * gelu_tanh(bf_lo(gw4.z)); v[8 * j + 5] = a1.y * gelu_tanh(bf_hi(gw4.z)); v[8 * j + 6] = a1.z * gelu_tanh(bf_lo(gw4.w)); v[8 * j + 7] = a1.w * gelu_tanh(bf_hi(gw4.w)); }
#pragma unroll
          for (int i = 0; i < 32; ++i) ss += v[i] * v[i];
          const float rstd = 1.0f / sqrtf(wave_sum(ss) * (1.0f / DLRU) + EPS);
#pragma unroll
          for (int j = 0; j < 4; ++j) { const LAS float* g = LG + DSB + 8 * lane + 512 * j; const f32x4 g0 = *(const LAS f32x4*)g, g1 = *(const LAS f32x4*)(g + 4);
              v4u w; w.x = pk2(v[8 * j] * rstd * g0.x, v[8 * j + 1] * rstd * g0.y); w.y = pk2(v[8 * j + 2] * rstd * g0.z, v[8 * j + 3] * rstd * g0.w);
              w.z = pk2(v[8 * j + 4] * rstd * g1.x, v[8 * j + 5] * rstd * g1.y); w.w = pk2(v[8 * j + 6] * rstd * g1.z, v[8 * j + 7] * rstd * g1.w);
              __builtin_nontemporal_store(w, (v4u*)(A2 + (size_t)m * DM + DSB + 8 * lane + 512 * j)); } }
    }
    { LAS float* red = (LAS float*)(F.lds + 65536); const int c4 = 4 * (64 * F.wave + lane);
#pragma unroll 1
      for (int j = 0; F.vcu + j * F.G < M - SEQ; j += 2) {
          const int sra = F.vcu + j * F.G, srb_ = sra + F.G; const bool hasb = srb_ < M - SEQ; const int srb = hasb ? srb_ : sra;
          const int mr[2] = {SEQ + sra, SEQ + srb};
          f32x4 va[2], vl[2]; float sa0 = 0.f, sa1 = 0.f, sl0 = 0.f, sl1 = 0.f;
#pragma unroll
          for (int r = 0; r < 2; ++r) { const int m = mr[r];
              const v2u ow = *(const v2u*)(OSB + (size_t)m * DSB + c4); va[r] = (f32x4){bf_lo(ow.x), bf_hi(ow.x), bf_lo(ow.y), bf_hi(ow.y)};
              const v4u hq = *(const v4u*)(HP + (size_t)m * DLRU + c4); const f32x4 cr = *(const f32x4*)(CARRY + (size_t)(m >> 5) * DLRU + c4); const v2u gw2 = *(const v2u*)(PROJ + (size_t)m * DIN + 8192 + c4);
              const f32x4 hh = (f32x4){bf_lo(hq.x), bf_lo(hq.y), bf_lo(hq.z), bf_lo(hq.w)} + (f32x4){bf_hi(hq.x), bf_hi(hq.y), bf_hi(hq.z), bf_hi(hq.w)} * cr;
              vl[r] = (f32x4){hh.x * gelu_tanh(bf_lo(gw2.x)), hh.y * gelu_tanh(bf_hi(gw2.x)), hh.z * gelu_tanh(bf_lo(gw2.y)), hh.w * gelu_tanh(bf_hi(gw2.y))};
              const float ea = (va[r].x * va[r].x + va[r].y * va[r].y) + (va[r].z * va[r].z + va[r].w * va[r].w), el = (vl[r].x * vl[r].x + vl[r].y * vl[r].y) + (vl[r].z * vl[r].z + vl[r].w * vl[r].w);
              if (r == 0) { sa0 += ea; sl0 += el; } else { sa1 += ea; sl1 += el; } }
          float ta0, ta1, tl0, tl1; wg_sum2(F, sa0, sa1, red, ta0, ta1); wg_sum2(F, sl0, sl1, red + 16, tl0, tl1);
          const float ra[2] = {1.0f / sqrtf(ta0 * (1.0f / DSB) + EPS), 1.0f / sqrtf(ta1 * (1.0f / DSB) + EPS)}, rl[2] = {1.0f / sqrtf(tl0 * (1.0f / DLRU) + EPS), 1.0f / sqrtf(tl1 * (1.0f / DLRU) + EPS)};
          const f32x4 ga = *(const LAS f32x4*)(LG + c4), gl4 = *(const LAS f32x4*)(LG + DSB + c4);
#pragma unroll
          for (int r = 0; r < 2; ++r) if (r == 0 || hasb) { const f32x4 ya = va[r] * ra[r] * ga, yl = vl[r] * rl[r] * gl4;
              v2u w; w.x = pk2(ya.x, ya.y); w.y = pk2(ya.z, ya.w); *(v2u*)(A2 + (size_t)mr[r] * DM + c4) = w;
              w.x = pk2(yl.x, yl.y); w.y = pk2(yl.z, yl.w); *(v2u*)(A2 + (size_t)mr[r] * DM + DSB + c4) = w; }
          __syncthreads();
      } }
}

template <bool PROMPT>
__device__ __forceinline__ void p7_row(Frame& F, KArgs& A, int m, const LAS f32x4* LA, const LAS f32x4* LB, const LAS f32x4* LC) {
    const int lane = F.lane;
    const float* MOD = (const float*)(A.ws + WS_MOD); const bf16* MIX = (const bf16*)(A.ws + WS_MIX); bf16* H = (bf16*)(A.ws + WS_ACT);
    const f32x4* xr = (const f32x4*)xrow_of(A, m) + lane;
    f32x4 v[16]; float ss = 0.f;
    if (PROMPT) {
#pragma unroll
        for (int j = 0; j < 16; ++j) { const v2u w = __builtin_nontemporal_load((const v2u*)(MIX + (size_t)m * DM) + lane + 64 * j); v[j] = (f32x4){bf_lo(w.x), bf_hi(w.x), bf_lo(w.y), bf_hi(w.y)}; }
    } else {
#pragma unroll
        for (int j = 0; j < 16; ++j) v[j] = (f32x4){0.f, 0.f, 0.f, 0.f};
#pragma unroll 1
        for (int ks = 0; ks < KS_OUT; ++ks) { const f32x4* pr = (const f32x4*)(A.ws + WS_PART) + ((size_t)ks * (M - SEQ) + (m - SEQ)) * (DM / 4) + lane;
#pragma unroll
            for (int j = 0; j < 16; ++j) v[j] += pr[64 * j]; }
    }
#pragma unroll
    for (int j = 0; j < 16; ++j) ss += (v[j].x * v[j].x + v[j].y * v[j].y) + (v[j].z * v[j].z + v[j].w * v[j].w);
    const float rstd = 1.0f / sqrtf(wave_sum(ss) * (1.0f / DM) + EPS);
    v2u* xo = (v2u*)((bf16*)(A.ws + WS_X1) + (size_t)m * DM) + lane; float s2 = 0.f;
    const float* mo = MOD + (size_t)modrow_of(m) * NMODC;
#pragma unroll
    for (int j = 0; j < 16; ++j) { const f32x4 ca = PROMPT ? LA[lane + 64 * j] : ((const f32x4*)(mo + 2 * DM) + lane)[64 * j] * ((const f32x4*)A.in[I_GPOM] + lane)[64 * j];
        const f32x4 x1 = __builtin_nontemporal_load(xr + 64 * j) + ca * (v[j] * rstd); v[j] = x1; { v2u w; w.x = pk2(x1.x, x1.y); w.y = pk2(x1.z, x1.w); __builtin_nontemporal_store(w, xo + 64 * j); }
        s2 += (x1.x * x1.x + x1.y * x1.y) + (x1.z * x1.z + x1.w * x1.w); if ((j & 3) == 3) asm volatile("" ::: "memory"); }
    const float rstd2 = 1.0f / sqrtf(wave_sum(s2) * (1.0f / DM) + EPS);
    v2u* o = (v2u*)(H + (size_t)m * DM) + lane;
#pragma unroll
    for (int j = 0; j < 16; ++j) { const f32x4 cb = PROMPT ? LB[lane + 64 * j] : ((const f32x4*)A.in[I_GPF] + lane)[64 * j] * (1.0f + ((const f32x4*)(mo + 4 * DM) + lane)[64 * j]), cc = PROMPT ? LC[lane + 64 * j] : ((const f32x4*)(mo + 3 * DM) + lane)[64 * j];
        const f32x4 y = v[j] * rstd2 * cb + cc; v2u w; w.x = pk2(y.x, y.y); w.y = pk2(y.z, y.w); __builtin_nontemporal_store(w, o + 64 * j); if ((j & 3) == 3) asm volatile("" ::: "memory"); }
}
__device__ __forceinline__ void p7_load(KArgs& A, int m, int lane, v2u (&mx)[16], f32x4 (&x)[16]) {
    const v2u* mr = (const v2u*)((const bf16*)(A.ws + WS_MIX) + (size_t)m * DM) + lane; const f32x4* xr = (const f32x4*)(A.in[I_XP] + (size_t)m * DM) + lane;
#pragma unroll
    for (int j = 0; j < 16; ++j) { mx[j] = __builtin_nontemporal_load(mr + 64 * j); x[j] = __builtin_nontemporal_load(xr + 64 * j); }
}
__device__ __forceinline__ void p7_proc(Frame& F, KArgs& A, int m, const v2u (&mx)[16], f32x4 (&x)[16], const LAS f32x4* LA, const LAS f32x4* LB, const LAS f32x4* LC) {
    const int lane = F.lane; float ss = 0.f;
#pragma unroll
    for (int j = 0; j < 16; ++j) { const f32x4 v = (f32x4){bf_lo(mx[j].x), bf_hi(mx[j].x), bf_lo(mx[j].y), bf_hi(mx[j].y)}; ss += (v.x * v.x + v.y * v.y) + (v.z * v.z + v.w * v.w); }
    const float rstd = 1.0f / sqrtf(wave_sum(ss) * (1.0f / DM) + EPS);
    v2u* xo = (v2u*)((bf16*)(A.ws + WS_X1) + (size_t)m * DM) + lane; float s2 = 0.f;
#pragma unroll
    for (int j = 0; j < 16; ++j) { const f32x4 v = (f32x4){bf_lo(mx[j].x), bf_hi(mx[j].x), bf_lo(mx[j].y), bf_hi(mx[j].y)};
        const f32x4 x1 = x[j] + LA[lane + 64 * j] * (v * rstd); x[j] = x1; { v2u w; w.x = pk2(x1.x, x1.y); w.y = pk2(x1.z, x1.w); __builtin_nontemporal_store(w, xo + 64 * j); }
        s2 += (x1.x * x1.x + x1.y * x1.y) + (x1.z * x1.z + x1.w * x1.w); if ((j & 3) == 3) asm volatile("" ::: "memory"); }
    const float rstd2 = 1.0f / sqrtf(wave_sum(s2) * (1.0f / DM) + EPS);
    v2u* o = (v2u*)((bf16*)(A.ws + WS_ACT) + (size_t)m * DM) + lane;
#pragma unroll
    for (int j = 0; j < 16; ++j) { const f32x4 y = x[j] * rstd2 * LB[lane + 64 * j] + LC[lane + 64 * j]; v2u w; w.x = pk2(y.x, y.y); w.y = pk2(y.z, y.w); __builtin_nontemporal_store(w, o + 64 * j); if ((j & 3) == 3) asm volatile("" ::: "memory"); }
}
__device__ __forceinline__ void p7_samples(Frame& F, KArgs& A) {
    LAS float* red = (LAS float*)(F.lds + 65536);
    const float* MOD = (const float*)(A.ws + WS_MOD);
    const int cb = 128 * F.wave + F.lane;
#pragma unroll 1
    for (int j = 0; F.vcu + j * F.G < M - SEQ; j += 2) {
        const int sra = F.vcu + j * F.G, srb_ = sra + F.G; const bool hasb = srb_ < M - SEQ; const int srb = hasb ? srb_ : sra;
        const int sr[2] = {sra, srb};
        f32x4 v[2][2];
#pragma unroll
        for (int r = 0; r < 2; ++r)
#pragma unroll
            for (int q = 0; q < 2; ++q) v[r][q] = (f32x4){0.f, 0.f, 0.f, 0.f};
#pragma unroll
        for (int ks = 0; ks < KS_OUT; ++ks)
#pragma unroll
            for (int r = 0; r < 2; ++r)
#pragma unroll
                for (int q = 0; q < 2; ++q) v[r][q] += ((const f32x4*)(A.ws + WS_PART))[((size_t)ks * (M - SEQ) + sr[r]) * (DM / 4) + cb + 64 * q];
        float s0 = 0.f, s1 = 0.f;
#pragma unroll
        for (int q = 0; q < 2; ++q) { s0 += (v[0][q].x * v[0][q].x + v[0][q].y * v[0][q].y) + (v[0][q].z * v[0][q].z + v[0][q].w * v[0][q].w); s1 += (v[1][q].x * v[1][q].x + v[1][q].y * v[1][q].y) + (v[1][q].z * v[1][q].z + v[1][q].w * v[1][q].w); }
        float t0, t1; wg_sum2(F, s0, s1, red, t0, t1);
        const float rstd[2] = {1.0f / sqrtf(t0 * (1.0f / DM) + EPS), 1.0f / sqrtf(t1 * (1.0f / DM) + EPS)};
        float u0 = 0.f, u1 = 0.f;
#pragma unroll
        for (int r = 0; r < 2; ++r) { const float* mo = MOD + (size_t)(1 + (sr[r] >> 5)) * NMODC;
#pragma unroll
            for (int q = 0; q < 2; ++q) { const int ci = cb + 64 * q;
                const f32x4 x1 = ((const f32x4*)(A.in[I_XS] + (size_t)sr[r] * DM))[ci] + ((const f32x4*)(mo + 2 * DM))[ci] * ((const f32x4*)A.in[I_GPOM])[ci] * (v[r][q] * rstd[r]);
                v[r][q] = x1;
                if (r == 0 || hasb) { v2u w; w.x = pk2(x1.x, x1.y); w.y = pk2(x1.z, x1.w); ((v2u*)((bf16*)(A.ws + WS_X1) + (size_t)(SEQ + sr[r]) * DM))[ci] = w; }
                const float e = (x1.x * x1.x + x1.y * x1.y) + (x1.z * x1.z + x1.w * x1.w); if (r == 0) u0 += e; else u1 += e; } }
        wg_sum2(F, u0, u1, red + 16, t0, t1);
        const float rstd2[2] = {1.0f / sqrtf(t0 * (1.0f / DM) + EPS), 1.0f / sqrtf(t1 * (1.0f / DM) + EPS)};
#pragma unroll
        for (int r = 0; r < 2; ++r) { const float* mo = MOD + (size_t)(1 + (sr[r] >> 5)) * NMODC;
#pragma unroll
            for (int q = 0; q < 2; ++q) { const int ci = cb + 64 * q;
                const f32x4 y = v[r][q] * rstd2[r] * ((const f32x4*)A.in[I_GPF])[ci] * (1.0f + ((const f32x4*)(mo + 4 * DM))[ci]) + ((const f32x4*)(mo + 3 * DM))[ci];
                if (r == 0 || hasb) { v2u w; w.x = pk2(y.x, y.y); w.y = pk2(y.z, y.w); ((v2u*)((bf16*)(A.ws + WS_ACT) + (size_t)(SEQ + sr[r]) * DM))[ci] = w; } } }
    }
}
__device__ __forceinline__ void p7_postmix(Frame& F, KArgs& A) {
    const int gw = F.vcu * NWAVES + F.wave, NGW = F.G * NWAVES;
    const float* MOD = (const float*)(A.ws + WS_MOD);
    LAS f32x4* LA = (LAS f32x4*)F.lds; LAS f32x4* LB = LA + DM / 4; LAS f32x4* LC = LB + DM / 4;
    for (int i = F.tid; i < DM / 4; i += NWAVES * 64) { const f32x4* m4 = (const f32x4*)MOD + i;
        LA[i] = m4[2 * DM / 4] * ((const f32x4*)A.in[I_GPOM])[i]; LB[i] = ((const f32x4*)A.in[I_GPF])[i] * (1.0f + m4[4 * DM / 4]); LC[i] = m4[3 * DM / 4]; }
    __syncthreads();
#pragma unroll 1
    for (int m = gw; m < SEQ; m += NGW) { v2u mx[16]; f32x4 xx[16]; p7_load(A, m, F.lane, mx, xx); p7_proc(F, A, m, mx, xx, LA, LB, LC); }
    p7_samples(F, A);
}

__device__ __forceinline__ void up8(const v4u w, float (&f)[8]) { f[0] = bf_lo(w.x); f[1] = bf_hi(w.x); f[2] = bf_lo(w.y); f[3] = bf_hi(w.y); f[4] = bf_lo(w.z); f[5] = bf_hi(w.z); f[6] = bf_lo(w.w); f[7] = bf_hi(w.w); }
__device__ __forceinline__ void ld8(const float* p, float (&f)[8]) { const f32x4 a = *(const f32x4*)p, b = *(const f32x4*)(p + 4); f[0] = a.x; f[1] = a.y; f[2] = a.z; f[3] = a.w; f[4] = b.x; f[5] = b.y; f[6] = b.z; f[7] = b.w; }
__device__ __forceinline__ void p9_fix(Frame& F, KArgs& A) {
    const int gw = F.vcu * NWAVES + F.wave, NGW = F.G * NWAVES, lane = F.lane;
    const float* RAWP = (const float*)(A.ws + WS_RAWP); const float* RAWS = (const float*)(A.ws + WS_RAWS); bf16* ACTF = (bf16*)(A.ws + WS_ACTF);
    constexpr int NCC = (DFF + 511) / 512;
#pragma unroll 1
    for (int u = gw; u < 160 * NCC; u += NGW) {
        const int cc = u % NCC, fi = u / NCC, col = 512 * cc + 8 * lane;
        if (col >= DFF) continue;
        float wg[3][8], wv[3][8], bg[8], bv[8], g2[8], g1[8], g0[8], v2[8], v1[8], v0[8];
#pragma unroll
        for (int j = 0; j < 3; ++j) { ld8(A.in[I_WCF] + (size_t)j * DFF2 + col, wg[j]); ld8(A.in[I_WCF] + (size_t)j * DFF2 + DFF + col, wv[j]); }
        ld8(A.in[I_BCF] + col, bg); ld8(A.in[I_BCF] + DFF + col, bv);
        int row; const float *p0, *p1, *p2;
        if (fi < 128) { const int j = fi >> 1, d = fi & 1; row = 256 * j + d; const float* b = RAWP + (size_t)j * 4 * DFF2;
            p0 = b + (size_t)(2 + d) * DFF2; p1 = d ? b + (size_t)2 * DFF2 : (j ? b + (size_t)1 * DFF2 : nullptr); p2 = j ? (d ? b + (size_t)1 * DFF2 : b) : nullptr; }
        else { const int s = (fi - 128) >> 1, d = fi & 1; row = SEQ + 32 * s + d; const float* b = RAWS + (size_t)s * 2 * DFF2; const float* st = A.in[I_SCF] + (size_t)s * 2 * DFF2;
            p0 = b + (size_t)d * DFF2; p1 = d ? b : st + DFF2; p2 = d ? st + DFF2 : st; }
        ld8(p0 + col, g0); ld8(p0 + DFF + col, v0);
        if (p1) { ld8(p1 + col, g1); ld8(p1 + DFF + col, v1); } else {
#pragma unroll
            for (int e = 0; e < 8; ++e) { g1[e] = 0.f; v1[e] = 0.f; } }
        if (p2) { ld8(p2 + col, g2); ld8(p2 + DFF + col, v2); } else {
#pragma unroll
            for (int e = 0; e < 8; ++e) { g2[e] = 0.f; v2[e] = 0.f; } }
        float y[8];
#pragma unroll
        for (int e = 0; e < 8; ++e) { const float gc = bg[e] + wg[0][e] * g2[e] + wg[1][e] * g1[e] + wg[2][e] * g0[e]; const float vc = bv[e] + wv[0][e] * v2[e] + wv[1][e] * v1[e] + wv[2][e] * v0[e]; y[e] = gelu_tanh(gc) * vc; }
        v4u w; w.x = pk2(y[0], y[1]); w.y = pk2(y[2], y[3]); w.z = pk2(y[4], y[5]); w.w = pk2(y[6], y[7]);
        *(v4u*)(ACTF + (size_t)row * DFF + col) = w;
    }
}

template <bool PROMPT>
__device__ __forceinline__ void p11_row(Frame& F, KArgs& A, int m, const LAS f32x4* LA) {
    const int lane = F.lane;
    const float* MOD = (const float*)(A.ws + WS_MOD); const bf16* YD = (const bf16*)(A.ws + WS_MIX);
    f32x4 v[16]; float ss = 0.f;
    if (PROMPT) {
#pragma unroll
        for (int j = 0; j < 16; ++j) { const v2u w = __builtin_nontemporal_load((const v2u*)(YD + (size_t)m * DM) + lane + 64 * j); v[j] = (f32x4){bf_lo(w.x), bf_hi(w.x), bf_lo(w.y), bf_hi(w.y)}; }
    } else {
#pragma unroll
        for (int j = 0; j < 16; ++j) v[j] = (f32x4){0.f, 0.f, 0.f, 0.f};
#pragma unroll 1
        for (int ks = 0; ks < KS_DOWN; ++ks) { const f32x4* pr = (const f32x4*)(A.ws + WS_PART) + ((size_t)ks * (M - SEQ) + (m - SEQ)) * (DM / 4) + lane;
#pragma unroll
            for (int j = 0; j < 16; ++j) v[j] += pr[64 * j]; }
    }
#pragma unroll
    for (int j = 0; j < 16; ++j) ss += (v[j].x * v[j].x + v[j].y * v[j].y) + (v[j].z * v[j].z + v[j].w * v[j].w);
    const float rstd = 1.0f / sqrtf(wave_sum(ss) * (1.0f / DM) + EPS);
    f32x4* yo = (f32x4*)(A.out + OUT_Y + (size_t)m * DM) + lane;
    const v2u* xi = (const v2u*)((const bf16*)(A.ws + WS_X1) + (size_t)m * DM) + lane;
#pragma unroll
    for (int j = 0; j < 16; ++j) { const v2u w = __builtin_nontemporal_load(xi + 64 * j); const f32x4 x1 = (f32x4){bf_lo(w.x), bf_hi(w.x), bf_lo(w.y), bf_hi(w.y)};
        const f32x4 ca = PROMPT ? LA[lane + 64 * j] : ((const f32x4*)(MOD + (size_t)modrow_of(m) * NMODC + 5 * DM) + lane)[64 * j] * ((const f32x4*)A.in[I_GPOF] + lane)[64 * j];
        const f32x4 y = x1 + ca * (v[j] * rstd); __builtin_nontemporal_store(y, yo + 64 * j); if ((j & 3) == 3) asm volatile("" ::: "memory"); }
}
__device__ __forceinline__ void p11_load(KArgs& A, int m, int lane, v2u (&y)[16], v2u (&x)[16]) {
    const v2u* yr = (const v2u*)((const bf16*)(A.ws + WS_MIX) + (size_t)m * DM) + lane; const v2u* xr = (const v2u*)((const bf16*)(A.ws + WS_X1) + (size_t)m * DM) + lane;
#pragma unroll
    for (int j = 0; j < 16; ++j) { y[j] = __builtin_nontemporal_load(yr + 64 * j); x[j] = __builtin_nontemporal_load(xr + 64 * j); }
}
__device__ __forceinline__ void p11_proc(Frame& F, KArgs& A, int m, const v2u (&y)[16], const v2u (&x)[16], const LAS f32x4* LA) {
    const int lane = F.lane; float ss = 0.f;
#pragma unroll
    for (int j = 0; j < 16; ++j) { const f32x4 v = (f32x4){bf_lo(y[j].x), bf_hi(y[j].x), bf_lo(y[j].y), bf_hi(y[j].y)}; ss += (v.x * v.x + v.y * v.y) + (v.z * v.z + v.w * v.w); }
    const float rstd = 1.0f / sqrtf(wave_sum(ss) * (1.0f / DM) + EPS);
    f32x4* yo = (f32x4*)(A.out + OUT_Y + (size_t)m * DM) + lane;
#pragma unroll
    for (int j = 0; j < 16; ++j) { const f32x4 v = (f32x4){bf_lo(y[j].x), bf_hi(y[j].x), bf_lo(y[j].y), bf_hi(y[j].y)}, x1 = (f32x4){bf_lo(x[j].x), bf_hi(x[j].x), bf_lo(x[j].y), bf_hi(x[j].y)};
        const f32x4 o = x1 + LA[lane + 64 * j] * (v * rstd); __builtin_nontemporal_store(o, yo + 64 * j); if ((j & 3) == 3) asm volatile("" ::: "memory"); }
}
__device__ __forceinline__ void p11_samples(Frame& F, KArgs& A) {
    LAS float* red = (LAS float*)(F.lds + 65536);
    const float* MOD = (const float*)(A.ws + WS_MOD);
    const int cb = 128 * F.wave + F.lane;
#pragma unroll 1
    for (int j = 0; F.vcu + j * F.G < M - SEQ; j += 2) {
        const int sra = F.vcu + j * F.G, srb_ = sra + F.G; const bool hasb = srb_ < M - SEQ; const int srb = hasb ? srb_ : sra;
        const int sr[2] = {sra, srb};
        f32x4 v[2][2];
#pragma unroll
        for (int r = 0; r < 2; ++r)
#pragma unroll
            for (int q = 0; q < 2; ++q) v[r][q] = (f32x4){0.f, 0.f, 0.f, 0.f};
#pragma unroll
        for (int ks = 0; ks < KS_DOWN; ++ks)
#pragma unroll
            for (int r = 0; r < 2; ++r)
#pragma unroll
                for (int q = 0; q < 2; ++q) v[r][q] += ((const f32x4*)(A.ws + WS_PART))[((size_t)ks * (M - SEQ) + sr[r]) * (DM / 4) + cb + 64 * q];
        float s0 = 0.f, s1 = 0.f;
#pragma unroll
        for (int q = 0; q < 2; ++q) { s0 += (v[0][q].x * v[0][q].x + v[0][q].y * v[0][q].y) + (v[0][q].z * v[0][q].z + v[0][q].w * v[0][q].w); s1 += (v[1][q].x * v[1][q].x + v[1][q].y * v[1][q].y) + (v[1][q].z * v[1][q].z + v[1][q].w * v[1][q].w); }
        float t0, t1; wg_sum2(F, s0, s1, red, t0, t1);
        const float rstd[2] = {1.0f / sqrtf(t0 * (1.0f / DM) + EPS), 1.0f / sqrtf(t1 * (1.0f / DM) + EPS)};
#pragma unroll
        for (int r = 0; r < 2; ++r) { const float* mo = MOD + (size_t)(1 + (sr[r] >> 5)) * NMODC;
#pragma unroll
            for (int q = 0; q < 2; ++q) { const int ci = cb + 64 * q;
                const v2u w = ((const v2u*)((const bf16*)(A.ws + WS_X1) + (size_t)(SEQ + sr[r]) * DM))[ci]; const f32x4 x1 = (f32x4){bf_lo(w.x), bf_hi(w.x), bf_lo(w.y), bf_hi(w.y)};
                const f32x4 y = x1 + ((const f32x4*)(mo + 5 * DM))[ci] * ((const f32x4*)A.in[I_GPOF])[ci] * (v[r][q] * rstd[r]);
                if (r == 0 || hasb) ((f32x4*)(A.out + OUT_Y + (size_t)(SEQ + sr[r]) * DM))[ci] = y; } }
        __syncthreads();
    }
}
__device__ __forceinline__ void p11_final(Frame& F, KArgs& A) {
    const int gw = F.vcu * NWAVES + F.wave, NGW = F.G * NWAVES;
    const float* MOD = (const float*)(A.ws + WS_MOD);
    LAS f32x4* LA = (LAS f32x4*)F.lds;
    for (int i = F.tid; i < DM / 4; i += NWAVES * 64) LA[i] = ((const f32x4*)(MOD + 5 * DM))[i] * ((const f32x4*)A.in[I_GPOF])[i];
    __syncthreads();
    { v2u ya[16], xa[16], yb[16], xb[16]; int m = gw;
      if (m < SEQ) p11_load(A, m, F.lane, ya, xa);
#pragma unroll 1
      for (; m < SEQ; m += 2 * NGW) {
          if (m + NGW < SEQ) p11_load(A, m + NGW, F.lane, yb, xb);
          p11_proc(F, A, m, ya, xa, LA);
          if (m + NGW < SEQ) { if (m + 2 * NGW < SEQ) p11_load(A, m + 2 * NGW, F.lane, ya, xa); p11_proc(F, A, m + NGW, yb, xb, LA); }
      } }
    p11_samples(F, A);
}

__global__ void __launch_bounds__(NWAVES * 64, 2) mk_fwd(Args args_by_value) {
    extern __shared__ __attribute__((aligned(16))) unsigned char lds[];
    KArgs& args = *(KArgs*)__builtin_amdgcn_kernarg_segment_ptr();
    Frame F;
    F.lds = (LAS unsigned char*)lds;
    F.MISC = (volatile LAS unsigned*)(F.lds + MISC_OFF);
    F.tid = threadIdx.x; F.lane = F.tid & 63; F.wave = __builtin_amdgcn_readfirstlane(F.tid >> 6);
    F.G = gridDim.x; { const int bx = blockIdx.x; F.vcu = (F.G % 8 == 0) ? (bx % 8) * (F.G / 8) + bx / 8 : bx; }
    F.ctl = (gu32*)(args.ws + WS_CTL);
    for (int u = F.tid; u < (LDS_BYTES - LDSCTL_OFF) / 4; u += NWAVES * 64) ((LAS unsigned*)(F.lds + LDSCTL_OFF))[u] = 0u;
    __syncthreads();
    XcdBarrier bar = xcd_barrier_post((unsigned*)(F.ctl + CW_BAR) + args.li * XCD_BAR_WORDS, F.MISC + 8);
    const int lo = args.ph_lo, hi = args.ph_hi;
#define IN(k) (lo <= (k) && (k) < hi)
#define SEAM(k) do { if (IN(k) && IN((k) + 1)) xcd_barrier(bar); } while (0)
    unsigned char* ws = args.ws;

    if (IN(0)) { p0_prologue(F, args); } SEAM(0);
    if (IN(1)) { p1_h1(F, args); } SEAM(1);
    if (IN(2)) {
        pg8::Gemm g{(const pg8::bf16_t*)(ws + WS_ACT), (const pg8::bf16_t*)(ws + WS_WIN), M, DIN, DM}; pg8::StaticOrder S; S.init(M, DIN, F.G, (int)blockIdx.x);
        pg8::EpiInProj E{(pg8::bf16_t*)(ws + WS_PROJ), args.out + OUT_KP, args.out + OUT_VP, args.out + OUT_KS, args.out + OUT_VS, args.out + OUT_CLP, args.out + OUT_CLS};
        pg8::gemm_phase<pg8::EpiInProj, pg8::StaticOrder, true, true>(F.lds, g, S, E);
        tail_convert<true>(F, args.in[I_WUP], DM, DFF2, (bf16*)(ws + WS_WUP), IT_UP_TAIL, (M / 256) * (DIN / 256));
    } SEAM(2);
    if (IN(3)) { p3_mixers(F, args); } SEAM(3);
    if (IN(4)) { p4_carry(F, args); } SEAM(4);
    if (IN(5)) { p5_mixnorm(F, args); } SEAM(5);
    if (IN(6)) {
        pg8::Gemm g{(const pg8::bf16_t*)(ws + WS_ACT), (const pg8::bf16_t*)(ws + WS_WOUT), M, DM, DM}; pg8::SplitOrder S; S.init(SEQ, M - SEQ, DM, KS_OUT, DM / 64 / KS_OUT, KS_OUT, F.G, (int)blockIdx.x);
        pg8::EpiMixS E{(pg8::bf16_t*)(ws + WS_MIX), DM, (float*)(ws + WS_PART), SEQ, M - SEQ};
        pg8::gemm_phase<pg8::EpiMixS, pg8::SplitOrder, true, true>(F.lds, g, S, E);
    } SEAM(6);
    if (IN(7)) { p7_postmix(F, args); } SEAM(7);
    if (IN(8)) {
        pg8::Gemm g{(const pg8::bf16_t*)(ws + WS_ACT), (const pg8::bf16_t*)(ws + WS_WUP), M, DFF2, DM}; pg8::StaticOrder S; S.init(M, DFF2, F.G, (int)blockIdx.x);
        pg8::EpiUpAct E{(pg8::bf16_t*)(ws + WS_ACTF), args.in[I_WCF], args.in[I_BCF], (float*)(ws + WS_RAWP), (float*)(ws + WS_RAWS), args.out + OUT_CFP, args.out + OUT_CFS, (LAS float*)(F.lds + EXCH_OFF)};
        pg8::gemm_phase<pg8::EpiUpAct, pg8::StaticOrder, true, true>(F.lds, g, S, E);
        tail_convert<false>(F, args.in[I_WDOWN], DFF, DM, (bf16*)(ws + WS_WDOWN), IT_DOWN_TAIL, (M / 256) * (DFF2 / 256));
    } SEAM(8);
    if (IN(9)) { p9_fix(F, args); } SEAM(9);
    if (IN(10)) {
        pg8::Gemm g{(const pg8::bf16_t*)(ws + WS_ACTF), (const pg8::bf16_t*)(ws + WS_WDOWN), M, DM, DFF}; pg8::SplitOrder S; S.init(SEQ, M - SEQ, DM, KS_DOWN, 44, 2, F.G, (int)blockIdx.x);
        pg8::EpiMixS E{(pg8::bf16_t*)(ws + WS_MIX), DM, (float*)(ws + WS_PART), SEQ, M - SEQ};
        pg8::gemm_phase<pg8::EpiMixS, pg8::SplitOrder, true, true>(F.lds, g, S, E);
    } SEAM(10);
    if (IN(11)) { p11_final(F, args); }
#undef IN
#undef SEAM
}

#ifndef MK_N_LAUNCHES
#define MK_N_LAUNCHES 1
#endif
extern "C" void kernel_launch(void* const* d_in, const int* in_sizes, int n_in, void* d_out, int out_size, void* d_ws, size_t ws_size, hipStream_t stream) {
    static int grid = 0;
    if (grid == 0) {
        if (n_in != N_IN || (size_t)out_size != OUT_END || ws_size < WS_END) { fprintf(stderr, "kernel_launch: unexpected shapes (n_in %d, out %d, ws %zu); nothing launched\n", n_in, out_size, ws_size); grid = -1; return; }
        int dev = 0, cus = 0, per_cu = 0;
        if (hipGetDevice(&dev) != hipSuccess || hipDeviceGetAttribute(&cus, hipDeviceAttributeMultiprocessorCount, dev) != hipSuccess) { grid = -1; return; }
        if (hipFuncSetAttribute((const void*)mk_fwd, hipFuncAttributeMaxDynamicSharedMemorySize, LDS_BYTES) != hipSuccess) { fprintf(stderr, "kernel_launch: hipFuncSetAttribute failed\n"); grid = -1; return; }
        if (hipOccupancyMaxActiveBlocksPerMultiprocessor(&per_cu, (const void*)mk_fwd, NWAVES * 64, LDS_BYTES) != hipSuccess || per_cu < 1) { fprintf(stderr, "kernel_launch: occupancy query says %d blocks per CU\n", per_cu); }
        (void)hipGetLastError();
        grid = cus;
    }
    if (grid < 0) return;
    if (hipMemsetAsync((char*)d_ws + WS_CTL, 0, CTL_ZERO_BYTES, stream) != hipSuccess) return;
    Args a{};
    for (int i = 0; i < N_IN; ++i) a.in[i] = (const float*)d_in[i];
    a.out = (float*)d_out; a.ws = (unsigned char*)d_ws; a.pad = 0;
#if defined(MK_PROBE_DUP)
    { static const int kDup[NPH] = MK_PROBE_DUP;
      for (int li = 0; li < NPH; ++li) for (int rep = 0; rep < kDup[li]; ++rep) { a.ph_lo = li; a.ph_hi = li + 1; a.li = li; hipLaunchKernelGGL(mk_fwd, dim3(grid), dim3(NWAVES * 64), LDS_BYTES, stream, a); } }
#elif MK_N_LAUNCHES == 1
    a.ph_lo = 0; a.ph_hi = NPH; a.li = 0;
    hipLaunchKernelGGL(mk_fwd, dim3(grid), dim3(NWAVES * 64), LDS_BYTES, stream, a);
#else
    for (int li = 0; li < NPH; ++li) { a.ph_lo = li; a.ph_hi = li + 1; a.li = li; hipLaunchKernelGGL(mk_fwd, dim3(grid), dim3(NWAVES * 64), LDS_BYTES, stream, a); }
#endif
}
```

```cpp
#include <hip/hip_runtime.h>
#include <cstdio>
#include <cstdint>
namespace pg8 {
#define PG8_LAS __attribute__((address_space(3)))
typedef unsigned short bf16_t;
typedef short bf16x8 __attribute__((ext_vector_type(8)));
typedef float f32x4 __attribute__((ext_vector_type(4)));
typedef unsigned u32x4 __attribute__((ext_vector_type(4)));
constexpr int BM = 256, BK = 64, HALF = 128, HTB = HALF * BK * 2  , STAGE_BYTES = 8 * HTB, NXCD = 8, WGM = 8;

__host__ __device__ __forceinline__ int lds_byte(int r, int c) { const int st = (r >> 4) * 2 + (c >> 5), rr = r & 15, cc = c & 31, ob = rr * 64 + cc * 2; return st * 1024 + (ob ^ (((ob >> 9) & 1) << 5)); }
__host__ __device__ __forceinline__ void stage_rc(int b, int& R, int& C) { const int st = b / 1024, sb = b % 1024, swz = sb ^ (((sb >> 9) & 1) << 5); R = (st >> 1) * 16 + swz / 64; C = (st & 1) * 32 + (swz % 64) / 2; }
__host__ __device__ __forceinline__ int perm32(int rho) { const int n = rho >> 4, i = rho & 15; return 8 * (i >> 2) + 4 * n + (i & 3); }

struct Unit { int pm, pn; };
struct Gemm { const bf16_t* A; const bf16_t* Bt; int M, N, K; };

struct StaticOrder {
    int nM, nN, nwg, G, c;
    __host__ __device__ void init(int M, int N, int G_, int c_) { nM = M / BM; nN = N / BM; nwg = nM * nN; G = G_; c = c_; }
    __host__ __device__ __forceinline__ bool next(int i, Unit& u) const {
        const long L = (long)i * G + c; if (L >= nwg) return false;
        int wgid = (int)L; { const int q = nwg / NXCD, r = nwg % NXCD, xcd = wgid % NXCD, off = wgid / NXCD; wgid = (xcd < r ? xcd * (q + 1) : r * (q + 1) + (xcd - r) * q) + off; }
        const int nig = WGM * nN, gid = wgid / nig, fm = gid * WGM, gsz = (nM - fm) < WGM ? (nM - fm) : WGM;
        u.pm = fm + ((wgid % nig) % gsz); u.pn = (wgid % nig) / gsz; return true;
    }
    __device__ __forceinline__ void a_ready(const Unit&) const {}
    __device__ __forceinline__ void done(const Unit&) const {}
    __device__ __forceinline__ void kslice(const Unit&, int ntf, int& kt0, int& nt) const { kt0 = 0; nt = ntf; }
};
struct SplitOrder {
    StaticOrder main; int pm0, npan, nN, nks, nt_hi, n_hi, G, c, nmine;
    __host__ __device__ void init(int Mmain, int Msplit, int N, int nks_, int nt_hi_, int n_hi_, int G_, int c_) {
        main.init(Mmain, N, G_, c_); pm0 = Mmain / BM; npan = Msplit / BM; nN = N / BM; nks = nks_; nt_hi = nt_hi_; n_hi = n_hi_; G = G_; c = c_;
        nmine = (main.nwg > c_) ? (main.nwg - c_ + G_ - 1) / G_ : 0; }
    __host__ __device__ __forceinline__ bool next(int i, Unit& u) const {
        const bool is_main = i < nmine; Unit m; m.pm = 0; m.pn = 0; const bool okm = main.next(is_main ? i : 0, m);
        const int j = (i - nmine) * G + c, ks = j % nks, rest = j / nks;
        u.pm = is_main ? m.pm : pm0 + rest / nN; u.pn = is_main ? m.pn : ((rest % nN) | ((ks + 1) << 8));
        return is_main ? okm : (j < npan * nN * nks);
    }
    __device__ __forceinline__ void a_ready(const Unit&) const {}
    __device__ __forceinline__ void done(const Unit&) const {}
    __device__ __forceinline__ void kslice(const Unit& u, int ntf, int& kt0, int& nt) const { const int ksp = u.pn >> 8, ks = ksp - 1;
        nt = ksp == 0 ? ntf : (ks < n_hi ? nt_hi : nt_hi - 2); kt0 = ksp == 0 ? 0 : (ks < n_hi ? ks * nt_hi : n_hi * nt_hi + (ks - n_hi) * (nt_hi - 2)); }
};
__device__ __forceinline__ unsigned cvt_pk_bf16(float lo, float hi) { unsigned r; asm volatile("v_cvt_pk_bf16_f32 %0, %1, %2" : "=v"(r) : "v"(lo), "v"(hi)); return r; }
typedef float f32x2 __attribute__((ext_vector_type(2)));
struct EpiF32 {
    static constexpr bool PERM = false, AFTER_DRAIN = false;
    float* C; int ldc; const float* bias;
    __device__ __forceinline__ void operator()(const f32x4 (&acc)[2][2][4][2], const Unit& u, int wr, int wc, int fr, int fq) const {
        const int row0 = u.pm * BM + wr * 64 + fr, col0 = u.pn * BM + wc * 32 + 4 * fq;
        f32x4 bv[2][2];
#pragma unroll
        for (int bj = 0; bj < 2; ++bj)
#pragma unroll
            for (int n = 0; n < 2; ++n) bv[bj][n] = bias ? *(const f32x4*)(bias + col0 + bj * HALF + n * 16) : (f32x4){0.f, 0.f, 0.f, 0.f};
#pragma unroll
        for (int ai = 0; ai < 2; ++ai)
#pragma unroll
            for (int m = 0; m < 4; ++m) { float* rowp = C + (size_t)(row0 + ai * HALF + m * 16) * ldc + col0;
#pragma unroll
                for (int bj = 0; bj < 2; ++bj)
#pragma unroll
                    for (int n = 0; n < 2; ++n) *(f32x4*)(rowp + bj * HALF + n * 16) = acc[ai][bj][m][n] + bv[bj][n]; }
    }
};
struct EpiInProj {
    static constexpr bool PERM = true, AFTER_DRAIN = false;
    bf16_t* P; float* kp; float* vp; float* ks; float* vs; float* clp; float* cls;
    __device__ __forceinline__ void operator()(const f32x4 (&acc)[2][2][4][2], const Unit& u, int wr, int wc, int fr, int fq) const {
        const int row0 = u.pm * BM + wr * 64 + fr, col0 = u.pn * BM + wc * 32 + 8 * fq;
        const int seg = u.pn >> 3;
#pragma unroll
        for (int ai = 0; ai < 2; ++ai)
#pragma unroll
            for (int m = 0; m < 4; ++m) { const int row = row0 + ai * HALF + m * 16; bf16_t* rowp = P + (size_t)row * 10240 + col0;
#pragma unroll
                for (int bj = 0; bj < 2; ++bj) { const f32x4 v0 = acc[ai][bj][m][0], v1 = acc[ai][bj][m][1];
                    u32x4 w; w.x = cvt_pk_bf16(v0[0], v0[1]); w.y = cvt_pk_bf16(v0[2], v0[3]); w.z = cvt_pk_bf16(v1[0], v1[1]); w.w = cvt_pk_bf16(v1[2], v1[3]);
                    *(u32x4*)(rowp + bj * HALF) = w; }
                if (seg == 1 || seg == 2) {
                    const int c = col0 - seg * 2048;
                    float* o = (row < 16384) ? ((seg == 1 ? kp : vp) + (size_t)row * 2048 + c) : ((seg == 1 ? ks : vs) + (size_t)(row - 16384) * 2048 + c);
#pragma unroll
                    for (int bj = 0; bj < 2; ++bj) { *(f32x4*)(o + bj * HALF) = acc[ai][bj][m][0]; *(f32x4*)(o + bj * HALF + 4) = acc[ai][bj][m][1]; }
                }
                if (seg == 3 && u.pm >= 63) {
                    const int c = col0 - 6144; float* o = nullptr;
                    if (row < 16384) { if (row >= 16381) o = clp + (size_t)(row - 16381) * 2048 + c; }
                    else { const int rs = row - 16384, j = (rs & 31) - 29; if (j >= 0) o = cls + (size_t)((rs >> 5) * 3 + j) * 2048 + c; }
                    if (o) {
#pragma unroll
                        for (int bj = 0; bj < 2; ++bj) { *(f32x4*)(o + bj * HALF) = acc[ai][bj][m][0]; *(f32x4*)(o + bj * HALF + 4) = acc[ai][bj][m][1]; } }
                }
            }
    }
};
struct EpiUp {
    static constexpr bool PERM = true, AFTER_DRAIN = false;
    bf16_t* U; float* cfp; float* cfs;
    __device__ __forceinline__ void operator()(const f32x4 (&acc)[2][2][4][2], const Unit& u, int wr, int wc, int fr, int fq) const {
        const int row0 = u.pm * BM + wr * 64 + fr, col0 = u.pn * BM + wc * 32 + 8 * fq;
#pragma unroll
        for (int ai = 0; ai < 2; ++ai)
#pragma unroll
            for (int m = 0; m < 4; ++m) { const int row = row0 + ai * HALF + m * 16; bf16_t* rowp = U + (size_t)row * 22016 + col0;
#pragma unroll
                for (int bj = 0; bj < 2; ++bj) { const f32x4 v0 = acc[ai][bj][m][0], v1 = acc[ai][bj][m][1];
                    u32x4 w; w.x = cvt_pk_bf16(v0[0], v0[1]); w.y = cvt_pk_bf16(v0[2], v0[3]); w.z = cvt_pk_bf16(v1[0], v1[1]); w.w = cvt_pk_bf16(v1[2], v1[3]);
                    *(u32x4*)(rowp + bj * HALF) = w; }
                if (u.pm >= 63) {
                    float* o = nullptr;
                    if (row < 16384) { if (row >= 16382) o = cfp + (size_t)(row - 16382) * 22016 + col0; }
                    else { const int rs = row - 16384, j = (rs & 31) - 30; if (j >= 0) o = cfs + (size_t)((rs >> 5) * 2 + j) * 22016 + col0; }
                    if (o) {
#pragma unroll
                        for (int bj = 0; bj < 2; ++bj) { *(f32x4*)(o + bj * HALF) = acc[ai][bj][m][0]; *(f32x4*)(o + bj * HALF + 4) = acc[ai][bj][m][1]; } }
                }
            }
    }
};
struct EpiMixS {
    static constexpr bool PERM = true, AFTER_DRAIN = false;
    bf16_t* C; int ldc; float* part; int row_split0, rows_split;
    __device__ __forceinline__ void operator()(const f32x4 (&acc)[2][2][4][2], const Unit& u, int wr, int wc, int fr, int fq) const {
        const int ksp = u.pn >> 8, row0 = u.pm * BM + wr * 64 + fr, col0 = (u.pn & 255) * BM + wc * 32 + 8 * fq;
        if (ksp == 0) {
#pragma unroll
            for (int ai = 0; ai < 2; ++ai)
#pragma unroll
                for (int m = 0; m < 4; ++m) { bf16_t* rowp = C + (size_t)(row0 + ai * HALF + m * 16) * ldc + col0;
#pragma unroll
                    for (int bj = 0; bj < 2; ++bj) { const f32x4 v0 = acc[ai][bj][m][0], v1 = acc[ai][bj][m][1];
                        u32x4 w; w.x = cvt_pk_bf16(v0[0], v0[1]); w.y = cvt_pk_bf16(v0[2], v0[3]); w.z = cvt_pk_bf16(v1[0], v1[1]); w.w = cvt_pk_bf16(v1[2], v1[3]);
                        *(u32x4*)(rowp + bj * HALF) = w; } }
        } else {
            float* base = part + ((size_t)(ksp - 1) * rows_split - (size_t)row_split0) * ldc;
#pragma unroll
            for (int ai = 0; ai < 2; ++ai)
#pragma unroll
                for (int m = 0; m < 4; ++m) { float* rowp = base + (size_t)(row0 + ai * HALF + m * 16) * ldc + col0;
#pragma unroll
                    for (int bj = 0; bj < 2; ++bj) { *(f32x4*)(rowp + bj * HALF) = acc[ai][bj][m][0]; *(f32x4*)(rowp + bj * HALF + 4) = acc[ai][bj][m][1]; } }
        }
    }
};
__device__ __forceinline__ float dpp_ror1(float v) { return __builtin_bit_cast(float, __builtin_amdgcn_mov_dpp(__builtin_bit_cast(int, v), 0x121, 0xf, 0xf, false)); }
__device__ __forceinline__ float dpp_shr1(float old, float v) { return __builtin_bit_cast(float, __builtin_amdgcn_update_dpp(__builtin_bit_cast(int, old), __builtin_bit_cast(int, v), 0x111, 0xf, 0xf, false)); }
__device__ __forceinline__ float dpp_ror2(float v) { return __builtin_bit_cast(float, __builtin_amdgcn_mov_dpp(__builtin_bit_cast(int, v), 0x122, 0xf, 0xf, false)); }
__device__ __forceinline__ float dpp_shr2(float old, float v) { return __builtin_bit_cast(float, __builtin_amdgcn_update_dpp(__builtin_bit_cast(int, old), __builtin_bit_cast(int, v), 0x112, 0xf, 0xf, false)); }
struct EpiUpAct {
    static constexpr bool PERM = true, AFTER_DRAIN = false;
    bf16_t* ACT; const float* wcv; const float* bcv; float* rawp; float* raws; float* cfp; float* cfs; PG8_LAS float* X;
    __device__ __forceinline__ void operator()(const f32x4 (&acc)[2][2][4][2], const Unit& u, int wr, int wc, int fr, int fq) const {
        const int x0 = wc * 32 + 8 * fq, gcol = u.pn * 128 + x0;
        if (fr >= 14) {
#pragma unroll
            for (int ai = 0; ai < 2; ++ai)
#pragma unroll
                for (int bj = 0; bj < 2; ++bj)
#pragma unroll
                    for (int n = 0; n < 2; ++n) *(PG8_LAS f32x4*)(X + (((2 * ai + wr) * 2 + (fr - 14)) * 256 + bj * 128 + x0 + 4 * n)) = acc[ai][bj][3][n];
        }
        asm volatile("s_waitcnt lgkmcnt(0)" ::: "memory"); __builtin_amdgcn_s_barrier(); asm volatile("" ::: "memory");
#pragma unroll
        for (int n = 0; n < 2; ++n) {
            f32x4 w0[2], w1[2], w2[2], bb[2];
#pragma unroll
            for (int bj = 0; bj < 2; ++bj) { const float* p = wcv + bj * 11008 + gcol + 4 * n; w0[bj] = *(const f32x4*)p; w1[bj] = *(const f32x4*)(p + 22016); w2[bj] = *(const f32x4*)(p + 44032);
                bb[bj] = *(const f32x4*)(bcv + bj * 11008 + gcol + 4 * n); }
#pragma unroll
            for (int ai = 0; ai < 2; ++ai) {
                const int ps = (2 * ai + wr + 3) & 3;
                f32x4 P14[2], P15[2];
#pragma unroll
                for (int bj = 0; bj < 2; ++bj) { P14[bj] = *(const PG8_LAS f32x4*)(X + ((ps * 2 + 0) * 256 + bj * 128 + x0 + 4 * n)); P15[bj] = *(const PG8_LAS f32x4*)(X + ((ps * 2 + 1) * 256 + bj * 128 + x0 + 4 * n)); }
                float outv[4][4];
#pragma unroll
                for (int e = 0; e < 4; ++e) {
                    float cv[2][4];
#pragma unroll
                    for (int bj = 0; bj < 2; ++bj) {
                        float pr1 = P15[bj][e], pr2 = (fr == 0) ? P14[bj][e] : P15[bj][e];
#pragma unroll
                        for (int m = 0; m < 4; ++m) { const float c = acc[ai][bj][m][n][e];
                            const float u1 = dpp_shr1(pr1, c), u2 = dpp_shr2(pr2, c);
                            cv[bj][m] = bb[bj][e] + w0[bj][e] * u2 + w1[bj][e] * u1 + w2[bj][e] * c;
                            if (m < 3) { pr1 = dpp_ror1(c); pr2 = dpp_ror2(c); } }
                    }
#pragma unroll
                    for (int m = 0; m < 4; ++m) { const float g = cv[0][m]; outv[m][e] = g * __builtin_amdgcn_rcpf(1.0f + __builtin_amdgcn_exp2f(g * (-2.3022082f - 0.10294324f * g * g))) * cv[1][m]; }
                }
#pragma unroll
                for (int m = 0; m < 4; ++m) { const int row = u.pm * BM + ai * HALF + wr * 64 + m * 16 + fr;
                    unsigned lo = cvt_pk_bf16(outv[m][0], outv[m][1]), hi = cvt_pk_bf16(outv[m][2], outv[m][3]);
                    *(unsigned long long*)(ACT + (size_t)row * 11008 + gcol + 4 * n) = (unsigned long long)lo | ((unsigned long long)hi << 32); }
            }
        }
        if (u.pm < 64) {
            if (wr == 0 && fr < 2) { float* d = rawp + (size_t)(u.pm * 4 + 2 + fr) * 22016 + gcol;
#pragma unroll
                for (int bj = 0; bj < 2; ++bj) { *(f32x4*)(d + bj * 11008) = acc[0][bj][0][0]; *(f32x4*)(d + bj * 11008 + 4) = acc[0][bj][0][1]; } }
            if (wr == 1 && fr >= 14) { float* d = (u.pm < 63 ? rawp + (size_t)((u.pm + 1) * 4 + (fr - 14)) * 22016 : cfp + (size_t)(fr - 14) * 22016) + gcol;
#pragma unroll
                for (int bj = 0; bj < 2; ++bj) { *(f32x4*)(d + bj * 11008) = acc[1][bj][3][0]; *(f32x4*)(d + bj * 11008 + 4) = acc[1][bj][3][1]; } }
        } else {
#pragma unroll
            for (int ai = 0; ai < 2; ++ai)
#pragma unroll
                for (int m = 0; m < 4; ++m) { const int rt = ai * HALF + wr * 64 + m * 16 + fr, q = rt & 31, s = ((u.pm - 64) * BM + rt) >> 5; float* d = nullptr;
                    if (q < 2) d = raws + (size_t)(s * 2 + q) * 22016 + gcol; else if (q >= 30) d = cfs + (size_t)(s * 2 + q - 30) * 22016 + gcol;
                    if (d) {
#pragma unroll
                        for (int bj = 0; bj < 2; ++bj) { *(f32x4*)(d + bj * 11008) = acc[ai][bj][m][0]; *(f32x4*)(d + bj * 11008 + 4) = acc[ai][bj][m][1]; } } }
        }
    }
};
template <class Epi, class Sched, bool ALIGN_EPI = false, bool SP2 = false>
__device__ __forceinline__ void gemm_phase(PG8_LAS unsigned char* lds, const Gemm g, const Sched& S, const Epi& E) {
    const int tid = threadIdx.x, wid = __builtin_amdgcn_readfirstlane(tid >> 6), lane = tid & 63, wr = wid >> 2, wc = wid & 3, fr = lane & 15, fq = lane >> 4;
    const int K = g.K, ntf = K / BK;
    unsigned voffA[2], voffB[2];
#pragma unroll
    for (int i = 0; i < 2; ++i) { int R, C; stage_rc(tid * 16 + i * 8192, R, C); const int Rb = Epi::PERM ? ((R & ~31) + perm32(R & 31)) : R;
        voffA[i] = (unsigned)(R * K + C) * 2u; voffB[i] = (unsigned)(Rb * K + C) * 2u; }
    const size_t kstep = (size_t)(BK * 2);
    const size_t hstep = (size_t)HALF * K * 2;
    const size_t tstep = 2 * hstep;
    const unsigned ldsw = (unsigned)wid * 1024u;
    const int aoff = lds_byte(wr * 64 + fr, fq * 8), boff = lds_byte(wc * 32 + fr, fq * 8);
#define PG8_SA(b, h) (((b) * 2 + (h)) * HTB)
#define PG8_SB(b, h) ((4 + (b) * 2 + (h)) * HTB)
#define PG8_STAGE(bufoff, gbase, voff) do { _Pragma("unroll") for (int _i = 0; _i < 2; ++_i) \
        __builtin_amdgcn_global_load_lds((const unsigned*)((const char*)(gbase) + (voff)[_i]), (PG8_LAS unsigned*)(lds + (bufoff) + ldsw + _i * 8192), 16, 0, 0); } while (0)
#define PG8_LDA(dst, b, h) do { _Pragma("unroll") for (int m = 0; m < 4; ++m) _Pragma("unroll") for (int k = 0; k < 2; ++k) dst[m][k] = *(const PG8_LAS bf16x8*)(lds + PG8_SA(b, h) + aoff + m * 2048 + k * 1024); } while (0)
#define PG8_LDB(dst, b, h) do { _Pragma("unroll") for (int n = 0; n < 2; ++n) _Pragma("unroll") for (int k = 0; k < 2; ++k) dst[n][k] = *(const PG8_LAS bf16x8*)(lds + PG8_SB(b, h) + boff + n * 2048 + k * 1024); } while (0)
#define PG8_MMA(ai, bj, At, Bt) do { __builtin_amdgcn_s_setprio(1); _Pragma("unroll") for (int m = 0; m < 4; ++m) _Pragma("unroll") for (int n = 0; n < 2; ++n) _Pragma("unroll") for (int k = 0; k < 2; ++k) \
        acc[ai][bj][m][n] = __builtin_amdgcn_mfma_f32_16x16x32_bf16(Bt[n][k], At[m][k], acc[ai][bj][m][n], 0, 0, 0); __builtin_amdgcn_s_setprio(0); } while (0)
#define PG8_WAIT_V(n) asm volatile("s_waitcnt vmcnt(" #n ")" ::: "memory")
#define PG8_WAIT_L(n) asm volatile("s_waitcnt lgkmcnt(" #n ")" ::: "memory")
#define PG8_BAR __builtin_amdgcn_s_barrier()
#define PG8_SCHED __builtin_amdgcn_sched_barrier(0)
    Unit cur, nxt; int ui = 0;
    if (!S.next(0, cur)) return;
    f32x4 acc[2][2][4][2];
#pragma unroll
    for (int a = 0; a < 2; ++a)
#pragma unroll
        for (int b = 0; b < 2; ++b)
#pragma unroll
            for (int m = 0; m < 4; ++m)
#pragma unroll
                for (int n = 0; n < 2; ++n) acc[a][b][m][n] = (f32x4){0.f, 0.f, 0.f, 0.f};
    bf16x8 At[4][2], B0[2][2], B1[2][2];
    int kt0, nt; S.kslice(cur, ntf, kt0, nt);
    const char* cA = (const char*)g.A + (size_t)cur.pm * tstep + (size_t)kt0 * kstep; const char* cB = (const char*)g.Bt + (size_t)(cur.pn & 255) * tstep + (size_t)kt0 * kstep;
    S.a_ready(cur);
    if constexpr (SP2) {
        PG8_STAGE(PG8_SB(0, 0), cB, voffB); PG8_STAGE(PG8_SB(0, 1), cB + hstep, voffB); PG8_STAGE(PG8_SA(0, 0), cA, voffA); PG8_STAGE(PG8_SA(0, 1), cA + hstep, voffA);
        if (wr == 1) PG8_BAR;
        PG8_WAIT_V(2); PG8_BAR;
        PG8_STAGE(PG8_SB(1, 0), cB + kstep, voffB); PG8_STAGE(PG8_SA(1, 0), cA + kstep, voffA); PG8_STAGE(PG8_SB(1, 1), cB + hstep + kstep, voffB);
        PG8_WAIT_V(6); PG8_BAR;
    } else {
        PG8_STAGE(PG8_SB(0, 0), cB, voffB); PG8_STAGE(PG8_SA(0, 0), cA, voffA); PG8_STAGE(PG8_SB(0, 1), cB + hstep, voffB); PG8_STAGE(PG8_SA(0, 1), cA + hstep, voffA);
        if (wr == 1) PG8_BAR;
        PG8_WAIT_V(4); PG8_BAR;
        PG8_STAGE(PG8_SB(1, 0), cB + kstep, voffB); PG8_STAGE(PG8_SA(1, 0), cA + kstep, voffA); PG8_STAGE(PG8_SB(1, 1), cB + hstep + kstep, voffB);
        PG8_WAIT_V(6); PG8_BAR;
    }
    for (;;) {
        const bool has_next = S.next(ui + 1, nxt);
        int nkt0 = 0, nnt = ntf; if (has_next) S.kslice(nxt, ntf, nkt0, nnt);
        const char* nA = has_next ? (const char*)g.A + (size_t)nxt.pm * tstep + (size_t)nkt0 * kstep : cA; const char* nB = has_next ? (const char*)g.Bt + (size_t)(nxt.pn & 255) * tstep + (size_t)nkt0 * kstep : cB;
        for (int t = 0; t < nt; t += 2) {
            const bool last = (t == nt - 2);
            const char* a1 = cA + (size_t)(t + 1) * kstep;
            const char* a2 = last ? nA : cA + (size_t)(t + 2) * kstep; const char* b2 = last ? nB : cB + (size_t)(t + 2) * kstep;
            const char* a3 = a2 + kstep; const char* b3 = b2 + kstep;
            if (last && has_next) S.a_ready(nxt);
            if constexpr (SP2) {
            PG8_LDB(B0, 0, 0); PG8_LDB(B1, 0, 1); PG8_SCHED; PG8_LDA(At, 0, 0); PG8_STAGE(PG8_SA(1, 1), a1 + hstep, voffA);
            PG8_WAIT_V(8); PG8_WAIT_L(0); PG8_BAR; PG8_MMA(0, 0, At, B0); PG8_MMA(0, 1, At, B1); PG8_BAR; PG8_SCHED;
            PG8_LDA(At, 0, 1); PG8_STAGE(PG8_SB(0, 0), b2, voffB); PG8_STAGE(PG8_SB(0, 1), b2 + hstep, voffB); PG8_STAGE(PG8_SA(0, 0), a2, voffA);
            PG8_WAIT_V(8); PG8_WAIT_L(0); PG8_BAR; PG8_MMA(1, 0, At, B0); PG8_MMA(1, 1, At, B1); PG8_BAR; PG8_SCHED;
            PG8_LDB(B0, 1, 0); PG8_LDB(B1, 1, 1); PG8_SCHED; PG8_LDA(At, 1, 0); PG8_STAGE(PG8_SA(0, 1), a2 + hstep, voffA);
            PG8_WAIT_V(8); PG8_WAIT_L(0); PG8_BAR; PG8_MMA(0, 0, At, B0); PG8_MMA(0, 1, At, B1); PG8_BAR; PG8_SCHED;
            PG8_LDA(At, 1, 1); PG8_STAGE(PG8_SB(1, 0), b3, voffB); PG8_STAGE(PG8_SB(1, 1), b3 + hstep, voffB); PG8_STAGE(PG8_SA(1, 0), a3, voffA);
            PG8_WAIT_V(8); PG8_WAIT_L(0); PG8_BAR; PG8_MMA(1, 0, At, B0); PG8_MMA(1, 1, At, B1); PG8_BAR; PG8_SCHED;
            } else {
            PG8_LDB(B0, 0, 0); PG8_SCHED; PG8_LDA(At, 0, 0); PG8_STAGE(PG8_SA(1, 1), a1 + hstep, voffA);
            PG8_WAIT_L(8); PG8_BAR; PG8_WAIT_L(0); PG8_MMA(0, 0, At, B0); PG8_BAR; PG8_SCHED;
            PG8_LDB(B1, 0, 1); PG8_STAGE(PG8_SB(0, 0), b2, voffB);
            PG8_BAR; PG8_WAIT_L(0); PG8_MMA(0, 1, At, B1); PG8_BAR;
            PG8_LDA(At, 0, 1); PG8_STAGE(PG8_SA(0, 0), a2, voffA);
            PG8_BAR; PG8_WAIT_L(0); PG8_MMA(1, 0, At, B0); PG8_BAR; PG8_SCHED;
            PG8_STAGE(PG8_SB(0, 1), b2 + hstep, voffB);
            PG8_WAIT_V(6); PG8_BAR; PG8_MMA(1, 1, At, B1); PG8_BAR;
            PG8_LDB(B0, 1, 0); PG8_SCHED; PG8_LDA(At, 1, 0); PG8_STAGE(PG8_SA(0, 1), a2 + hstep, voffA);
            PG8_WAIT_L(8); PG8_BAR; PG8_WAIT_L(0); PG8_MMA(0, 0, At, B0); PG8_BAR; PG8_SCHED;
            PG8_LDB(B1, 1, 1); PG8_STAGE(PG8_SB(1, 0), b3, voffB);
            PG8_BAR; PG8_WAIT_L(0); PG8_MMA(0, 1, At, B1); PG8_BAR;
            PG8_LDA(At, 1, 1); PG8_STAGE(PG8_SA(1, 0), a3, voffA);
            PG8_BAR; PG8_WAIT_L(0); PG8_MMA(1, 0, At, B0); PG8_BAR; PG8_SCHED;
            PG8_STAGE(PG8_SB(1, 1), b3 + hstep, voffB);
            PG8_WAIT_V(6); PG8_BAR; PG8_MMA(1, 1, At, B1); PG8_BAR;
            }
        }
        if constexpr (ALIGN_EPI) { if (wr == 0) PG8_BAR; }
        if constexpr (!Epi::AFTER_DRAIN) { E(acc, cur, wr, wc, fr, fq); S.done(cur); }
        if (!has_next) break;
#pragma unroll
        for (int a = 0; a < 2; ++a)
#pragma unroll
            for (int b = 0; b < 2; ++b)
#pragma unroll
                for (int m = 0; m < 4; ++m)
#pragma unroll
                    for (int n = 0; n < 2; ++n) acc[a][b][m][n] = (f32x4){0.f, 0.f, 0.f, 0.f};
        cur = nxt; cA = nA; cB = nB; nt = nnt; ++ui;
        if constexpr (ALIGN_EPI) { if (wr == 1) PG8_BAR; }
    }
    PG8_WAIT_V(0);
    if constexpr (!ALIGN_EPI) { if (wr == 0) PG8_BAR; }
    PG8_BAR;
    if constexpr (Epi::AFTER_DRAIN) { E.fused(acc, cur, wr, wc, fr, fq, lds, wid, lane); S.done(cur); }
#undef PG8_SA
#undef PG8_SB
#undef PG8_STAGE
#undef PG8_LDA
#undef PG8_LDB
#undef PG8_MMA
#undef PG8_WAIT_V
#undef PG8_WAIT_L
#undef PG8_BAR
#undef PG8_SCHED
}
}

constexpr int DM = 4096, SEQ = 16384, NDEC = 16, DSEQ = 32, PAST = 2048, HD = 128, DSB = 2048, NH = 16, DLRU = 2048, NBLK = 16, LBLK = 128;
constexpr int DIN = 10240, DFF = 11008, DFF2 = 22016, NMODC = 6 * DM, NB = 1 + NDEC;
constexpr int M = SEQ + NDEC * DSEQ;
constexpr int NCHUNK = M / 32;
constexpr float EPS = 1e-6f;
constexpr int NWAVES = 8;
constexpr int NPH = 12;

constexpr size_t OUT_Y = 0, OUT_KP = (size_t)M * DM, OUT_VP = OUT_KP + (size_t)SEQ * DSB, OUT_CLP = OUT_VP + (size_t)SEQ * DSB, OUT_LP = OUT_CLP + 3 * DLRU, OUT_CFP = OUT_LP + DLRU,
                 OUT_KS = OUT_CFP + 2 * DFF2, OUT_VS = OUT_KS + (size_t)512 * DSB, OUT_CLS = OUT_VS + (size_t)512 * DSB, OUT_LS = OUT_CLS + NDEC * 3 * DLRU, OUT_CFS = OUT_LS + NDEC * DLRU,
                 OUT_END = OUT_CFS + (size_t)NDEC * 2 * DFF2;
static_assert(OUT_END == 139299840ull, "output size");

constexpr size_t MiB = 1u << 20;
constexpr size_t WS_CTL = 0, CTL_ZERO_BYTES = 1 * MiB;
constexpr size_t WS_GATET = 1 * MiB;
constexpr size_t WS_MOD = 2 * MiB;
constexpr size_t WS_AGGA = 4 * MiB, WS_AGGH = 9 * MiB, WS_CARRY = 14 * MiB;
constexpr size_t WS_WDOWN = 20 * MiB;
constexpr size_t WS_WUP = 106 * MiB;
constexpr size_t WS_WOUT = 278 * MiB;
constexpr size_t WS_ACT = 310 * MiB;
constexpr size_t WS_MIX = 442 * MiB;
constexpr size_t WS_X1 = 574 * MiB;
constexpr size_t WS_R = 706 * MiB;
constexpr size_t WS_WIN = WS_R;
constexpr size_t WS_PROJ = WS_R + 80 * MiB;
constexpr size_t WS_OSB = WS_PROJ + 330 * MiB;
constexpr size_t WS_HP = WS_OSB + 66 * MiB;
constexpr size_t WS_PART = WS_R;
constexpr int KS_OUT = 8, KS_DOWN = 4;
constexpr size_t WS_RAWP = WS_R + 64 * MiB;
constexpr size_t WS_RAWS = WS_R + 88 * MiB;
constexpr size_t WS_ACTF = WS_R + 710 * MiB;
constexpr size_t WS_END = WS_ACTF + 355 * MiB;
static_assert(WS_HP + 132 * MiB <= WS_END && (size_t)M * DFF * 2 <= 355 * MiB && (size_t)M * DIN * 2 <= 330 * MiB, "ws map");
constexpr int CW_BAR = 4096;

constexpr int RING_BYTES = 131072;
constexpr int LDSCTL_OFF = RING_BYTES, MISC_OFF = LDSCTL_OFF + 320;
constexpr int LDS_BYTES = 147456;
constexpr int EXCH_OFF = LDSCTL_OFF + 2048;
static_assert(EXCH_OFF + 8192 <= LDS_BYTES, "lds map");
constexpr int WAVE_LDS = 9216;
constexpr int VROW = 288;
constexpr int XROW = 272;

#define GAS __attribute__((address_space(1)))
#define LAS __attribute__((address_space(3)))
typedef unsigned short bf16;
typedef unsigned v4u __attribute__((ext_vector_type(4)));
typedef unsigned v2u __attribute__((ext_vector_type(2)));
typedef float f32x4 __attribute__((ext_vector_type(4)));
typedef float f32x16 __attribute__((ext_vector_type(16)));
typedef short bf16x8 __attribute__((ext_vector_type(8)));
typedef short s16x4 __attribute__((ext_vector_type(4)));
typedef GAS unsigned gu32;
#define RLX_AGENT __ATOMIC_RELAXED, __HIP_MEMORY_SCOPE_AGENT
#define LDS_WAIT() asm volatile("s_waitcnt lgkmcnt(0)" ::: "memory")
__device__ __forceinline__ unsigned f2bf(float f) { unsigned u = __builtin_bit_cast(unsigned, f); return (u + 0x7fffu + ((u >> 16) & 1u)) >> 16; }
__device__ __forceinline__ unsigned pk2(float lo, float hi) { typedef float f2_t __attribute__((ext_vector_type(2))); typedef __bf16 b2_t __attribute__((ext_vector_type(2))); f2_t v = {lo, hi}; b2_t b = __builtin_convertvector(v, b2_t); return __builtin_bit_cast(unsigned, b); }
__device__ __forceinline__ float bf_lo(unsigned w) { return __builtin_bit_cast(float, w << 16); }
__device__ __forceinline__ float bf_hi(unsigned w) { return __builtin_bit_cast(float, w & 0xffff0000u); }
__device__ __forceinline__ float fexp2(float x) { return __builtin_amdgcn_exp2f(x); }
__device__ __forceinline__ float flog2(float x) { return __builtin_amdgcn_logf(x); }
__device__ __forceinline__ float frcp(float x) { return __builtin_amdgcn_rcpf(x); }
__device__ __forceinline__ float fsqrt(float x) { return __builtin_amdgcn_sqrtf(x); }
__device__ __forceinline__ float sigmoidf_(float x) { return frcp(1.0f + fexp2(-1.4426950408889634f * x)); }
__device__ __forceinline__ float gelu_tanh(float x) { return x * frcp(1.0f + fexp2(x * (-2.3022082f - 0.10294324f * x * x))); }
__device__ __forceinline__ float wave_sum(float v) {
#pragma unroll
    for (int o = 1; o < 64; o <<= 1) v += __shfl_xor(v, o);
    return v;
}
#define XB_TMO      128
#define XB_XCNT(j)  (256  + 64 * (j))
#define XB_XSUB(j)  (1280 + 64 * (j))
#define XB_XGEN(j)  (2304 + 64 * (j))
#define XB_TOP      3328
#define XB_TOPGEN   3392
#define XCD_BAR_WORDS 3456
#define XB_SPIN_CAP (1u << 18)

__device__ __forceinline__ unsigned xb_ld(unsigned* p)              { return __hip_atomic_load(p, __ATOMIC_RELAXED, __HIP_MEMORY_SCOPE_AGENT); }
__device__ __forceinline__ unsigned xb_add(unsigned* p, unsigned v) { return __hip_atomic_fetch_add(p, v, __ATOMIC_RELAXED, __HIP_MEMORY_SCOPE_AGENT); }
__device__ __forceinline__ unsigned xb_xcc_id() { return (unsigned)__builtin_amdgcn_s_getreg((3 << 11) | 20) & 0xFu; }
#define XB_SPIN(cond, bar) do { unsigned _sp = 0; while (cond) { __builtin_amdgcn_s_sleep(1); \
    if ((++_sp & 255u) == 0u) { if (xb_ld(&(bar)[XB_TMO])) break; if (_sp > XB_SPIN_CAP) { atomicAdd(&(bar)[XB_TMO], 1u); break; } } } } while (0)

struct XcdBarrier {
    unsigned* bar; unsigned x;
    volatile LAS unsigned* st;
};

__device__ __forceinline__ XcdBarrier xcd_barrier_post(unsigned* bar, volatile LAS unsigned* st) {
    XcdBarrier b; b.bar = bar; b.x = xb_xcc_id(); b.st = st;
    if (threadIdx.x == 0) (void)xb_add(&bar[XB_XCNT(b.x)], 1u);
    return b;
}
__device__ __forceinline__ void xcd_barrier_complete(unsigned* bar, unsigned x, unsigned& nloc, unsigned& nx) {
    const unsigned G = gridDim.x * gridDim.y * gridDim.z;
    unsigned sum, cnt, mine, sp = 0u;
    for (;;) {
        sum = 0u; cnt = 0u; mine = 0u;
#pragma unroll
        for (unsigned j = 0; j < 16; ++j) { const unsigned c = xb_ld(&bar[XB_XCNT(j)]); sum += c; cnt += (c > 0u) ? 1u : 0u; mine = (j == x) ? c : mine; }
        if (sum == G) break;
        __builtin_amdgcn_s_sleep(1);
        if ((++sp & 255u) == 0u) { if (xb_ld(&bar[XB_TMO])) break; if (sp > XB_SPIN_CAP) { atomicAdd(&bar[XB_TMO], 1u); break; } }
    }
    nloc = mine > 0u ? mine : 1u; nx = cnt > 0u ? cnt : 1u;
}

__device__ __forceinline__ void xcd_barrier(const XcdBarrier& b) {
    asm volatile("s_waitcnt vmcnt(0)" ::: "memory");
    __syncthreads();
    if (threadIdx.x == 0) {
        unsigned* bar = b.bar;
        __builtin_amdgcn_s_waitcnt(0);
        unsigned nloc = b.st[0], nx = b.st[1];
        if (nloc == 0u) { xcd_barrier_complete(bar, b.x, nloc, nx); b.st[0] = nloc; b.st[1] = nx; }
        const unsigned old = xb_add(&bar[XB_XSUB(b.x)], 1u);
        const unsigned gen = old / nloc;
        if (old + 1u == (gen + 1u) * nloc) {
            __builtin_amdgcn_fence(__ATOMIC_RELEASE, "agent");
            asm volatile("s_waitcnt vmcnt(0)" ::: "memory");
            const unsigned og = xb_add(&bar[XB_TOP], 1u);
            const unsigned tg = og / nx;
            if (og + 1u == (tg + 1u) * nx) xb_add(&bar[XB_TOPGEN], 1u);
            else XB_SPIN(xb_ld(&bar[XB_TOPGEN]) == tg, bar);
            __builtin_amdgcn_fence(__ATOMIC_ACQUIRE, "agent");
            xb_add(&bar[XB_XGEN(b.x)], 1u);
            asm volatile("s_waitcnt vmcnt(0)" ::: "memory");
        } else {
            XB_SPIN(xb_ld(&bar[XB_XGEN(b.x)]) == gen, bar);
            __builtin_amdgcn_fence(__ATOMIC_ACQUIRE, "agent");
            asm volatile("s_waitcnt vmcnt(0)" ::: "memory");
        }
    }
    __syncthreads();
}

enum InIdx { I_XP = 0, I_XS, I_CP, I_CS, I_CK, I_CV, I_SCL, I_SL, I_SCF, I_WADA, I_BADA, I_GPM, I_WIN, I_WCL, I_BCL, I_WGA, I_BGA, I_WGX, I_BGX, I_LAM, I_GGA, I_GGL,
             I_WOUT, I_GPOM, I_GPF, I_WUP, I_WCF, I_BCF, I_WDOWN, I_GPOF, N_IN };
struct Args { const float* in[N_IN]; float* out; unsigned char* ws; int ph_lo, ph_hi, li, pad; };
typedef const __attribute__((address_space(4))) Args KArgs;
struct Frame {
    LAS unsigned char* lds;
    volatile LAS unsigned* MISC;
    gu32* ctl;
    int tid, lane, wave, vcu, G;
};
__device__ __forceinline__ const float* xrow_of(KArgs& A, int m) { return m < SEQ ? A.in[I_XP] + (size_t)m * DM : A.in[I_XS] + (size_t)(m - SEQ) * DM; }
__device__ __forceinline__ int modrow_of(int m) { return m < SEQ ? 0 : 1 + ((m - SEQ) >> 5); }

template <bool UPMAP = false>
__device__ __forceinline__ void p0_transpose_item(const float* W, int K, int N, bf16* WT, LAS float* scr, int item, int lane) {
    const int nblk = N / 32, kb = item / nblk, nb = item % nblk, k0 = 64 * kb, n0 = 32 * nb;
    const int d0 = UPMAP ? (n0 < DFF ? (n0 >> 7) * 256 + (n0 & 127) : ((n0 - DFF) >> 7) * 256 + 128 + ((n0 - DFF) & 127)) : n0;
    float t[32];
    const float* wp = W + (size_t)(k0 + (lane >> 5)) * N + n0 + (lane & 31);
#pragma unroll
    for (int i = 0; i < 32; ++i) t[i] = wp[(size_t)(2 * i) * N];
#pragma unroll
    for (int i = 0; i < 32; ++i) scr[(2 * i + (lane >> 5)) * 33 + (lane & 31)] = t[i];
    LDS_WAIT(); asm volatile("" ::: "memory");
    const int c = lane & 7;
#pragma unroll
    for (int j = 0; j < 4; ++j) { const int n = (lane >> 3) + 8 * j; const LAS float* s = scr + (8 * c) * 33 + n;
        v4u o; o.x = pk2(s[0 * 33], s[1 * 33]); o.y = pk2(s[2 * 33], s[3 * 33]); o.z = pk2(s[4 * 33], s[5 * 33]); o.w = pk2(s[6 * 33], s[7 * 33]);
        *(GAS v4u*)(WT + (size_t)(d0 + n) * K + k0 + 8 * c) = o; }
    LDS_WAIT(); asm volatile("" ::: "memory");
}
constexpr int IT_UP = (DM / 64) * (DFF2 / 32), IT_DOWN = (DFF / 64) * (DM / 32);
constexpr int IT_DOWN_TAIL = 22016;
constexpr int IT_UP_TAIL = 44032;
template <bool UPMAP>
__device__ __forceinline__ void tail_convert(Frame& F, const float* W, int K, int N, bf16* WT, int nitems, int nunits) {
    const int G = F.G, c = (int)blockIdx.x, rounds = (nunits + G - 1) / G, nlast = nunits - (rounds - 1) * G;
    const bool all = (nlast == G); if (!all && c < nlast) return;
    const int nidle = all ? G : G - nlast, ii = (all ? c : c - nlast) * NWAVES + F.wave;
    LAS float* scr = (LAS float*)(F.lds + F.wave * 16384);
    for (int it = ii; it < nitems; it += nidle * NWAVES) p0_transpose_item<UPMAP>(W, K, N, WT, scr, it, F.lane);
}
__device__ __forceinline__ void p0_prologue(Frame& F, KArgs& A) {
    unsigned char* ws = A.ws;
    LAS float* scr = (LAS float*)(F.lds + F.wave * 16384);
    const int gw = F.vcu * NWAVES + F.wave, NGW = F.G * NWAVES;
    constexpr int IT_IN = (DM / 64) * (DIN / 32), IT_OUT = (DM / 64) * (DM / 32), IT_G = 2 * NBLK * 8;
    constexpr int NITEMS = IT_IN + IT_OUT + IT_G + (IT_UP - IT_UP_TAIL) + (IT_DOWN - IT_DOWN_TAIL);
    for (int it = gw; it < NITEMS; it += NGW) {
        int r = it;
        if (r < IT_IN) { p0_transpose_item(A.in[I_WIN], DM, DIN, (bf16*)(ws + WS_WIN), scr, r, F.lane); continue; } r -= IT_IN;
        if (r < IT_OUT) { p0_transpose_item(A.in[I_WOUT], DM, DM, (bf16*)(ws + WS_WOUT), scr, r, F.lane); continue; } r -= IT_OUT;
        if (r < IT_G) { const int gb = r >> 3, sub = r & 7;
          const float* Wg = (gb < NBLK ? A.in[I_WGA] : A.in[I_WGX]) + (size_t)(gb & 15) * LBLK * LBLK;
          p0_transpose_item(Wg, LBLK, LBLK, (bf16*)(ws + WS_GATET) + (size_t)gb * LBLK * LBLK, scr, sub, F.lane); continue; } r -= IT_G;
        if (r < IT_UP - IT_UP_TAIL) { p0_transpose_item<true>(A.in[I_WUP], DM, DFF2, (bf16*)(ws + WS_WUP), scr, IT_UP_TAIL + r, F.lane); continue; } r -= IT_UP - IT_UP_TAIL;
        p0_transpose_item(A.in[I_WDOWN], DFF, DM, (bf16*)(ws + WS_WDOWN), scr, IT_DOWN_TAIL + r, F.lane);
    }
    __syncthreads();
    float* MOD = (float*)(ws + WS_MOD);
    LAS float* RED = (LAS float*)F.lds;
    const int jj = F.lane & 15, kh = F.lane >> 4;
    typedef float f32x2v __attribute__((ext_vector_type(2)));
    for (int strip = F.vcu; strip < NMODC / 96; strip += F.G) {
        const int col0 = strip * 96;
        const float* wp = A.in[I_WADA] + (size_t)(512 * F.wave + kh) * NMODC + col0 + 6 * jj;
        const float* cs = A.in[I_CS] + (size_t)jj * DM + 512 * F.wave + kh;
        const float* cp = A.in[I_CP] + 512 * F.wave + kh;
        f32x4 acc[6]; float a0[6];
#pragma unroll
        for (int g = 0; g < 6; ++g) { acc[g] = (f32x4){0.f, 0.f, 0.f, 0.f}; a0[g] = 0.f; }
#pragma unroll 4
        for (int st = 0; st < 128; ++st) {
            const float* wr = wp + (size_t)(4 * st) * NMODC;
            const f32x2v w01 = *(const f32x2v*)wr, w23 = *(const f32x2v*)(wr + 2), wb = *(const f32x2v*)(wr + 4); const f32x4 wa = (f32x4){w01.x, w01.y, w23.x, w23.y};
            const float cv = cs[4 * st], c0 = cp[4 * st];
            const float sv = cv * sigmoidf_(cv), s0 = c0 * sigmoidf_(c0);
            acc[0] = __builtin_amdgcn_mfma_f32_16x16x4f32(sv, wa.x, acc[0], 0, 0, 0); acc[1] = __builtin_amdgcn_mfma_f32_16x16x4f32(sv, wa.y, acc[1], 0, 0, 0);
            acc[2] = __builtin_amdgcn_mfma_f32_16x16x4f32(sv, wa.z, acc[2], 0, 0, 0); acc[3] = __builtin_amdgcn_mfma_f32_16x16x4f32(sv, wa.w, acc[3], 0, 0, 0);
            acc[4] = __builtin_amdgcn_mfma_f32_16x16x4f32(sv, wb.x, acc[4], 0, 0, 0); acc[5] = __builtin_amdgcn_mfma_f32_16x16x4f32(sv, wb.y, acc[5], 0, 0, 0);
            a0[0] += s0 * wa.x; a0[1] += s0 * wa.y; a0[2] += s0 * wa.z; a0[3] += s0 * wa.w; a0[4] += s0 * wb.x; a0[5] += s0 * wb.y;
        }
#pragma unroll
        for (int g = 0; g < 6; ++g) { a0[g] += __shfl_xor(a0[g], 16); a0[g] += __shfl_xor(a0[g], 32); }
        LAS float* rw = RED + (size_t)F.wave * NB * 96;
#pragma unroll
        for (int g = 0; g < 6; ++g) {
#pragma unroll
            for (int rg = 0; rg < 4; ++rg) rw[(1 + 4 * kh + rg) * 96 + 6 * jj + g] = acc[g][rg];
            if (kh == 0) rw[6 * jj + g] = a0[g]; }
        __syncthreads();
        for (int idx = F.tid; idx < NB * 96; idx += 512) { float t = 0.f;
#pragma unroll
            for (int w = 0; w < NWAVES; ++w) t += RED[w * NB * 96 + idx];
            const int bb = idx / 96, c = idx % 96; MOD[(size_t)bb * NMODC + col0 + c] = t + A.in[I_BADA][col0 + c]; }
        __syncthreads();
    }
}

template <bool PROMPT>
__device__ __forceinline__ void p1_row(Frame& F, KArgs& A, int m, const LAS f32x4* LA, const LAS f32x4* LC) {
    const float* MOD = (const float*)(A.ws + WS_MOD); bf16* H = (bf16*)(A.ws + WS_ACT);
    const f32x4* xr = (const f32x4*)xrow_of(A, m) + F.lane;
    f32x4 v[16]; float ss = 0.f;
#pragma unroll
    for (int j = 0; j < 16; ++j) { v[j] = __builtin_nontemporal_load(xr + 64 * j); ss += (v[j].x * v[j].x + v[j].y * v[j].y) + (v[j].z * v[j].z + v[j].w * v[j].w); }
    const float rstd = 1.0f / sqrtf(wave_sum(ss) * (1.0f / DM) + EPS);
    v2u* o = (v2u*)(H + (size_t)m * DM) + F.lane;
    if (PROMPT) {
#pragma unroll
        for (int j = 0; j < 16; ++j) { const f32x4 y = v[j] * rstd * LA[F.lane + 64 * j] + LC[F.lane + 64 * j]; v2u w; w.x = pk2(y.x, y.y); w.y = pk2(y.z, y.w); __builtin_nontemporal_store(w, o + 64 * j); if ((j & 3) == 3) asm volatile("" ::: "memory"); }
    } else {
        const f32x4* g4 = (const f32x4*)A.in[I_GPM] + F.lane;
        const float* mr = MOD + (size_t)modrow_of(m) * NMODC; const f32x4* sh4 = (const f32x4*)mr + F.lane; const f32x4* sc4 = (const f32x4*)(mr + DM) + F.lane;
#pragma unroll
        for (int j = 0; j < 16; ++j) { const f32x4 g = g4[64 * j], sc = sc4[64 * j], sh = sh4[64 * j];
            const f32x4 y = v[j] * rstd * g * (1.0f + sc) + sh; v2u w; w.x = pk2(y.x, y.y); w.y = pk2(y.z, y.w); __builtin_nontemporal_store(w, o + 64 * j); }
    }
}
__device__ __forceinline__ void p1_load(KArgs& A, int m, int lane, f32x4 (&v)[16]) {
    const f32x4* xr = (const f32x4*)xrow_of(A, m) + lane;
#pragma unroll
    for (int j = 0; j < 16; ++j) v[j] = __builtin_nontemporal_load(xr + 64 * j);
}
__device__ __forceinline__ void p1_proc(Frame& F, KArgs& A, int m, const f32x4 (&v)[16], const LAS f32x4* LA, const LAS f32x4* LC) {
    float ss = 0.f;
#pragma unroll
    for (int j = 0; j < 16; ++j) ss += (v[j].x * v[j].x + v[j].y * v[j].y) + (v[j].z * v[j].z + v[j].w * v[j].w);
    const float rstd = 1.0f / sqrtf(wave_sum(ss) * (1.0f / DM) + EPS);
    v2u* o = (v2u*)((bf16*)(A.ws + WS_ACT) + (size_t)m * DM) + F.lane;
#pragma unroll
    for (int j = 0; j < 16; ++j) { const f32x4 y = v[j] * rstd * LA[F.lane + 64 * j] + LC[F.lane + 64 * j]; v2u w; w.x = pk2(y.x, y.y); w.y = pk2(y.z, y.w); __builtin_nontemporal_store(w, o + 64 * j); if ((j & 3) == 3) asm volatile("" ::: "memory"); }
}
__device__ __forceinline__ void wg_sum2(Frame& F, float a, float b, LAS float* red, float& ta, float& tb) {
    a = wave_sum(a); b = wave_sum(b);
    if (F.lane == 0) { red[F.wave] = a; red[8 + F.wave] = b; }
    __syncthreads();
    ta = 0.f; tb = 0.f;
#pragma unroll
    for (int w = 0; w < NWAVES; ++w) { ta += red[w]; tb += red[8 + w]; }
}
__device__ __forceinline__ void p1_samples(Frame& F, KArgs& A) {
    LAS float* red = (LAS float*)(F.lds + 65536);
    const float* MOD = (const float*)(A.ws + WS_MOD);
    const int cb = 128 * F.wave + F.lane;
#pragma unroll 1
    for (int j = 0; F.vcu + j * F.G < M - SEQ; j += 2) {
        const int sra = F.vcu + j * F.G, srb_ = sra + F.G; const bool hasb = srb_ < M - SEQ; const int srb = hasb ? srb_ : sra;
        const int sr[2] = {sra, srb};
        f32x4 v[2][2]; float s0 = 0.f, s1 = 0.f;
#pragma unroll
        for (int r = 0; r < 2; ++r)
#pragma unroll
            for (int q = 0; q < 2; ++q) { v[r][q] = ((const f32x4*)(A.in[I_XS] + (size_t)sr[r] * DM))[cb + 64 * q];
                const float e = (v[r][q].x * v[r][q].x + v[r][q].y * v[r][q].y) + (v[r][q].z * v[r][q].z + v[r][q].w * v[r][q].w); if (r == 0) s0 += e; else s1 += e; }
        float t0, t1; wg_sum2(F, s0, s1, red, t0, t1);
        const float rstd[2] = {1.0f / sqrtf(t0 * (1.0f / DM) + EPS), 1.0f / sqrtf(t1 * (1.0f / DM) + EPS)};
#pragma unroll
        for (int r = 0; r < 2; ++r) { const float* mo = MOD + (size_t)(1 + (sr[r] >> 5)) * NMODC;
#pragma unroll
            for (int q = 0; q < 2; ++q) { const int ci = cb + 64 * q;
                const f32x4 y = v[r][q] * rstd[r] * ((const f32x4*)A.in[I_GPM])[ci] * (1.0f + ((const f32x4*)(mo + DM))[ci]) + ((const f32x4*)mo)[ci];
                if (r == 0 || hasb) { v2u w; w.x = pk2(y.x, y.y); w.y = pk2(y.z, y.w); ((v2u*)((bf16*)(A.ws + WS_ACT) + (size_t)(SEQ + sr[r]) * DM))[ci] = w; } } }
        __syncthreads();
    }
}
__device__ __forceinline__ void p1_h1(Frame& F, KArgs& A) {
    const int gw = F.vcu * NWAVES + F.wave, NGW = F.G * NWAVES;
    const float* MOD = (const float*)(A.ws + WS_MOD);
    LAS f32x4* LA = (LAS f32x4*)F.lds; LAS f32x4* LC = LA + DM / 4;
    for (int i = F.tid; i < DM / 4; i += NWAVES * 64) { const f32x4 g = ((const f32x4*)A.in[I_GPM])[i], sh = ((const f32x4*)MOD)[i], sc = ((const f32x4*)(MOD + DM))[i]; LA[i] = g * (1.0f + sc); LC[i] = sh; }
    __syncthreads();
    { f32x4 va[16], vb[16]; int m = gw;
      if (m < SEQ) p1_load(A, m, F.lane, va);
#pragma unroll 1
      for (; m < SEQ; m += 2 * NGW) {
          if (m + NGW < SEQ) p1_load(A, m + NGW, F.lane, vb);
          p1_proc(F, A, m, va, LA, LC);
          if (m + NGW < SEQ) { if (m + 2 * NGW < SEQ) p1_load(A, m + 2 * NGW, F.lane, va); p1_proc(F, A, m + NGW, vb, LA, LC); }
      } }
    p1_samples(F, A);
}

__device__ __forceinline__ void lru_unit(Frame& F, KArgs& A, int blk, int c, LAS unsigned char* wl, const LAS unsigned char* gw_lds) {
    const int lane = F.lane, r = lane & 31, h = lane >> 5;
    const int row0 = 32 * c;
    const bf16* PROJ = (const bf16*)(A.ws + WS_PROJ);
    {
        const int cg = lane & 31, th = lane >> 5, chg = blk * LBLK + 4 * cg;
        const bf16* xp = PROJ + (size_t)row0 * DIN + 6144 + chg;
        const int t0 = 16 * th;
        v2u cur[16];
#pragma unroll
        for (int i = 0; i < 16; ++i) cur[i] = *(const v2u*)(xp + (size_t)(t0 + i) * DIN);
        f32x4 x3, x2, x1;
        if (th == 1 || (c > 0 && c < 512)) {
            const v2u a = *(const v2u*)(xp + (ptrdiff_t)(t0 - 3) * DIN), b = *(const v2u*)(xp + (ptrdiff_t)(t0 - 2) * DIN), d = *(const v2u*)(xp + (ptrdiff_t)(t0 - 1) * DIN);
            x3 = (f32x4){bf_lo(a.x), bf_hi(a.x), bf_lo(a.y), bf_hi(a.y)}; x2 = (f32x4){bf_lo(b.x), bf_hi(b.x), bf_lo(b.y), bf_hi(b.y)}; x1 = (f32x4){bf_lo(d.x), bf_hi(d.x), bf_lo(d.y), bf_hi(d.y)};
        } else if (c == 0) { x3 = x2 = x1 = (f32x4){0.f, 0.f, 0.f, 0.f}; }
        else { const float* st = A.in[I_SCL] + (size_t)(c - 512) * 3 * DLRU + chg;
            x3 = *(const f32x4*)(st); x2 = *(const f32x4*)(st + DLRU); x1 = *(const f32x4*)(st + 2 * DLRU); }
        const f32x4 w0 = *(const f32x4*)(A.in[I_WCL] + 0 * DLRU + chg), w1 = *(const f32x4*)(A.in[I_WCL] + 1 * DLRU + chg), w2 = *(const f32x4*)(A.in[I_WCL] + 2 * DLRU + chg),
                    w3 = *(const f32x4*)(A.in[I_WCL] + 3 * DLRU + chg), bb = *(const f32x4*)(A.in[I_BCL] + chg);
#pragma unroll
        for (int i = 0; i < 16; ++i) { const int t = t0 + i; const v2u a = cur[i];
            const f32x4 x0 = (f32x4){bf_lo(a.x), bf_hi(a.x), bf_lo(a.y), bf_hi(a.y)};
            const f32x4 y = bb + w3 * x0 + w2 * x1 + w1 * x2 + w0 * x3;
            v2u o; o.x = pk2(y.x, y.y); o.y = pk2(y.z, y.w); *(LAS v2u*)(wl + t * XROW + 8 * cg) = o;
            x3 = x2; x2 = x1; x1 = x0; }
    }
    LDS_WAIT(); asm volatile("" ::: "memory");
    bf16x8 af[8];
#pragma unroll
    for (int kk = 0; kk < 8; ++kk) af[kk] = *(const LAS bf16x8*)(wl + r * XROW + (16 * kk + 8 * h) * 2);
    unsigned* HP = (unsigned*)(A.ws + WS_HP);
#pragma unroll 1
    for (int nt = 0; nt < 4; ++nt) {
        const int dl = 32 * nt + r, ch = blk * LBLK + dl;
        const float bga = A.in[I_BGA][ch], bgx = A.in[I_BGX][ch], lam = A.in[I_LAM][ch];
        f32x16 ga, gx;
#pragma unroll
        for (int i = 0; i < 16; ++i) { ga[i] = 0.f; gx[i] = 0.f; }
#pragma unroll
        for (int kk = 0; kk < 8; ++kk) { const int off = dl * 256 + (((2 * kk + h) ^ (dl & 15)) << 4);
            const bf16x8 fa = *(const LAS bf16x8*)(gw_lds + off), fx = *(const LAS bf16x8*)(gw_lds + 32768 + off);
            ga = __builtin_amdgcn_mfma_f32_32x32x16_bf16(af[kk], fa, ga, 0, 0, 0); gx = __builtin_amdgcn_mfma_f32_32x32x16_bf16(af[kk], fx, gx, 0, 0, 0); }
        const float spl8 = 8.0f * (fmaxf(-lam, 0.f) + 0.6931471805599453f * flog2(1.0f + fexp2(-1.4426950408889634f * fabsf(lam))));
#pragma unroll
        for (int i = 0; i < 16; ++i) { const int t = (i & 3) + 8 * (i >> 2) + 4 * h;
            const float xc = __builtin_bit_cast(float, (unsigned)(*(const LAS unsigned short*)(wl + t * XROW + 2 * dl)) << 16);
            const float rg = sigmoidf_(ga[i] + bga), ig = sigmoidf_(gx[i] + bgx);
            const float la = -rg * spl8, x2 = 2.0f * la, av = fexp2(1.4426950408889634f * la);
            const float om = (x2 > -0.125f) ? -x2 * (1.0f + x2 * (0.5f + x2 * (0.16666667f + x2 * (0.041666668f + x2 * 0.0083333338f)))) : 1.0f - av * av;
            ga[i] = av; gx[i] = fsqrt(om) * (ig * xc); }
        float TH[4], TP[4], OH[4], OP[4];
#pragma unroll
        for (int a = 0; a < 4; ++a) { float hl = 0.f, pl = 1.f;
#pragma unroll
            for (int e = 0; e < 4; ++e) { hl = ga[4 * a + e] * hl + gx[4 * a + e]; pl = pl * ga[4 * a + e]; gx[4 * a + e] = hl; ga[4 * a + e] = pl; }
            TH[a] = hl; TP[a] = pl; }
#pragma unroll
        for (int a = 0; a < 4; ++a) { OH[a] = __shfl_xor(TH[a], 32); OP[a] = __shfl_xor(TP[a], 32); }
        float hs = 0.f, pc = 1.f, cH[4], cP[4];
#pragma unroll
        for (int a = 0; a < 4; ++a) {
            const float eH = h ? OH[a] : TH[a], eP = h ? OP[a] : TP[a], oH = h ? TH[a] : OH[a], oP = h ? TP[a] : OP[a];
            const float h1 = eP * hs + eH, p1 = pc * eP;
            cH[a] = h ? h1 : hs; cP[a] = h ? p1 : pc;
            hs = oP * h1 + oH; pc = p1 * oP; }
#pragma unroll
        for (int a = 0; a < 4; ++a)
#pragma unroll
            for (int e = 0; e < 4; ++e) { gx[4 * a + e] = gx[4 * a + e] + ga[4 * a + e] * cH[a]; ga[4 * a + e] = ga[4 * a + e] * cP[a]; }
#pragma unroll
        for (int i = 0; i < 16; ++i) { const int t = (i & 3) + 8 * (i >> 2) + 4 * h; HP[(size_t)(row0 + t) * DLRU + ch] = pk2(gx[i], ga[i]); }
        if (h == 0) { ((float*)(A.ws + WS_AGGH))[(size_t)c * DLRU + ch] = hs; ((float*)(A.ws + WS_AGGA))[(size_t)c * DLRU + ch] = pc; }
    }
    LDS_WAIT(); asm volatile("" ::: "memory");
}

__device__ __forceinline__ s16x4 vtr(const LAS unsigned char* p) { typedef short v4i16_t __attribute__((ext_vector_type(4))); return __builtin_bit_cast(s16x4, __builtin_amdgcn_ds_read_tr16_b64_v4i16((LAS v4i16_t*)p)); }
__device__ __forceinline__ unsigned cvtpk(float lo, float hi) { return pk2(lo, hi); }
__device__ __forceinline__ f32x16 sb_qk(const bf16x8 (&kf)[8], const bf16x8 (&qf)[8]) {
    f32x16 s;
#pragma unroll
    for (int i = 0; i < 16; ++i) s[i] = 0.f;
#pragma unroll
    for (int kk = 0; kk < 8; ++kk) s = __builtin_amdgcn_mfma_f32_32x32x16_bf16(kf[kk], qf[kk], s, 0, 0, 0);
    return s;
}
template <bool DIAG>
__device__ __forceinline__ void sb_block(const f32x16& s, f32x16 (&o)[4], float& R, const LAS unsigned char* vl, int lane) {
    const int r = lane & 31, h = lane >> 5;
    float lb[16], lk[16];
#pragma unroll
    for (int i = 0; i < 16; ++i) { const float z = s[i] * 0.12751743082459868f;
        const float sp = fmaxf(-z, 0.f) + flog2(1.0f + fexp2(-fabsf(z)));
        lb[i] = -sp; lk[i] = -sp - z;
        if (DIAG) { const int key = (i & 3) + 8 * (i >> 2) + 4 * h; if (!(key < r)) lk[i] = 0.f; } }
    float p[16], tot[4], oth[4];
#pragma unroll
    for (int a = 0; a < 4; ++a) { p[4 * a + 3] = 0.f; p[4 * a + 2] = lk[4 * a + 3]; p[4 * a + 1] = p[4 * a + 2] + lk[4 * a + 2]; p[4 * a] = p[4 * a + 1] + lk[4 * a + 1]; tot[a] = p[4 * a] + lk[4 * a]; }
#pragma unroll
    for (int a = 0; a < 4; ++a) oth[a] = __shfl_xor(tot[a], 32);
    float E[4], Od[4];
#pragma unroll
    for (int a = 0; a < 4; ++a) { E[a] = h ? oth[a] : tot[a]; Od[a] = h ? tot[a] : oth[a]; }
    float suf[8]; suf[7] = 0.f; suf[6] = Od[3]; suf[5] = suf[6] + E[3]; suf[4] = suf[5] + Od[2]; suf[3] = suf[4] + E[2]; suf[2] = suf[3] + Od[1]; suf[1] = suf[2] + E[1]; suf[0] = suf[1] + Od[0];
    const float total = suf[0] + E[0];
    float w[16];
#pragma unroll
    for (int a = 0; a < 4; ++a) { const float off = R + (h ? suf[2 * a + 1] : suf[2 * a]);
#pragma unroll
        for (int e = 0; e < 4; ++e) { const int i = 4 * a + e; float x = fexp2(lb[i] + off + p[i]);
            if (DIAG) { const int key = e + 8 * a + 4 * h; if (!(key < r)) x = 0.f; }
            w[i] = x; } }
    R += total;
    const int i16 = lane & 15, q = i16 >> 2, pp = i16 & 3, rb = (lane >> 4) & 1;
#pragma unroll
    for (int st = 0; st < 2; ++st) {
        v4u pa; pa.x = cvtpk(w[8 * st], w[8 * st + 1]); pa.y = cvtpk(w[8 * st + 2], w[8 * st + 3]); pa.z = cvtpk(w[8 * st + 4], w[8 * st + 5]); pa.w = cvtpk(w[8 * st + 6], w[8 * st + 7]);
        const bf16x8 wa = __builtin_bit_cast(bf16x8, pa);
        const LAS unsigned char* vb = vl + (16 * st + 4 * h + q) * VROW + (16 * rb + 4 * pp) * 2;
#pragma unroll
        for (int d2 = 0; d2 < 2; ++d2) {
            const s16x4 lo0 = vtr(vb + 128 * d2), hi0 = vtr(vb + 8 * VROW + 128 * d2), lo1 = vtr(vb + 128 * d2 + 64), hi1 = vtr(vb + 8 * VROW + 128 * d2 + 64);
            const bf16x8 f0 = __builtin_shufflevector(lo0, hi0, 0, 1, 2, 3, 4, 5, 6, 7), f1 = __builtin_shufflevector(lo1, hi1, 0, 1, 2, 3, 4, 5, 6, 7);
            __builtin_amdgcn_sched_barrier(0);
            o[2 * d2] = __builtin_amdgcn_mfma_f32_32x32x16_bf16(wa, f0, o[2 * d2], 0, 0, 0); o[2 * d2 + 1] = __builtin_amdgcn_mfma_f32_32x32x16_bf16(wa, f1, o[2 * d2 + 1], 0, 0, 0); }
    }
}
__device__ __forceinline__ void attn_load_kv(KArgs& A, const bf16* PROJ, int sb, int head, int qrow0, int j, int lane, v4u (&kr)[8], v4u (&vv)[8]) {
    const int vrow = lane >> 4, vch = lane & 15;
    if (sb < 0 || j == 0) {
        const int krow0 = qrow0 - 32 * j;
        const bf16* kp = PROJ + (size_t)(krow0 + vrow) * DIN + DSB + head * HD + 8 * vch;
#pragma unroll
        for (int i = 0; i < 8; ++i) kr[i] = *(const v4u*)(kp + (size_t)(4 * i) * DIN);
        const bf16* vp = kp + DSB;
#pragma unroll
        for (int i = 0; i < 8; ++i) vv[i] = *(const v4u*)(vp + (size_t)(4 * i) * DIN);
    } else {
        const int pos0 = PAST - 32 * j;
        const size_t off = (((size_t)sb * PAST + pos0 + vrow) * NH + head) * HD + 8 * vch;
        const float* kp = A.in[I_CK] + off;
#pragma unroll
        for (int i = 0; i < 8; ++i) { const float* k = kp + (size_t)(4 * i) * NH * HD; const f32x4 a = *(const f32x4*)k, b = *(const f32x4*)(k + 4);
            v4u t; t.x = pk2(a.x, a.y); t.y = pk2(a.z, a.w); t.z = pk2(b.x, b.y); t.w = pk2(b.z, b.w); kr[i] = t; }
        const float* vp = A.in[I_CV] + off;
#pragma unroll
        for (int i = 0; i < 8; ++i) { const float* v = vp + (size_t)(4 * i) * NH * HD; const f32x4 a = *(const f32x4*)v, b = *(const f32x4*)(v + 4);
            v4u t; t.x = pk2(a.x, a.y); t.y = pk2(a.z, a.w); t.z = pk2(b.x, b.y); t.w = pk2(b.z, b.w); vv[i] = t; }
    }
}
constexpr int KROW = 272;
__device__ __forceinline__ f32x16 attn_stage_qk(LAS unsigned char* wl, int lane, const v4u (&kr)[8], const v4u (&vn)[8], const bf16x8 (&qf)[8]) {
    const int r = lane & 31, h = lane >> 5, vrow = lane >> 4, vch = lane & 15;
#pragma unroll
    for (int i = 0; i < 8; ++i) *(LAS v4u*)(wl + (4 * i + vrow) * KROW + 16 * vch) = kr[i];
    LDS_WAIT(); asm volatile("" ::: "memory");
    f32x16 s;
#pragma unroll
    for (int i = 0; i < 16; ++i) s[i] = 0.f;
    const LAS unsigned char* kb = wl + r * KROW + 16 * h;
#pragma unroll
    for (int hf = 0; hf < 2; ++hf) {
        bf16x8 kf[4];
#pragma unroll
        for (int kk = 0; kk < 4; ++kk) kf[kk] = *(const LAS bf16x8*)(kb + 32 * (4 * hf + kk));
        LDS_WAIT(); asm volatile("" ::: "memory");
#pragma unroll
        for (int kk = 0; kk < 4; ++kk) s = __builtin_amdgcn_mfma_f32_32x32x16_bf16(kf[kk], qf[4 * hf + kk], s, 0, 0, 0);
    }
#pragma unroll
    for (int i = 0; i < 8; ++i) *(LAS v4u*)(wl + (4 * i + vrow) * VROW + 16 * vch) = vn[i];
    return s;
}
__device__ __forceinline__ void attn_unit(Frame& F, KArgs& A, int unit, LAS unsigned char* wl) {
    int lane_ = F.lane; asm volatile("" : "+v"(lane_));
    const int lane = lane_, r = lane & 31, h = lane >> 5;
    const bf16* PROJ = (const bf16*)(A.ws + WS_PROJ);
    int head, qrow0, npast, sb = -1;
    if (unit < 512 * NH) { head = unit >> 9; const int qb = unit & 511; qrow0 = 32 * qb; npast = qb; }
    else { const int us = unit - 512 * NH; sb = us >> 4; head = us & 15; qrow0 = SEQ + 32 * sb; npast = PAST / 32; }
    bf16x8 qf[8]; v4u kr[8], vn[8];
    attn_load_kv(A, PROJ, sb, head, qrow0, 0, lane, kr, vn);
    { const bf16* qp = PROJ + (size_t)(qrow0 + r) * DIN + head * HD + 8 * h;
#pragma unroll
      for (int kk = 0; kk < 8; ++kk) qf[kk] = *(const bf16x8*)(qp + 16 * kk); }
    f32x16 o[4];
#pragma unroll
    for (int dt = 0; dt < 4; ++dt)
#pragma unroll
        for (int i = 0; i < 16; ++i) o[dt][i] = 0.f;
    float R = 0.f;
    { const f32x16 s = attn_stage_qk(wl, lane, kr, vn, qf);
      if (npast > 0) attn_load_kv(A, PROJ, sb, head, qrow0, 1, lane, kr, vn);
      LDS_WAIT(); asm volatile("" ::: "memory");
      sb_block<true>(s, o, R, wl, lane); }
#pragma unroll 1
    for (int j = 1; j <= npast; ++j) {
        if (__all(R < -126.0f)) break;
        LDS_WAIT(); asm volatile("" ::: "memory");
        const f32x16 s = attn_stage_qk(wl, lane, kr, vn, qf);
        if (j < npast) attn_load_kv(A, PROJ, sb, head, qrow0, j + 1, lane, kr, vn);
        LDS_WAIT(); asm volatile("" ::: "memory");
        sb_block<false>(s, o, R, wl, lane);
    }
    LDS_WAIT(); asm volatile("" ::: "memory");
    bf16* OSB = (bf16*)(A.ws + WS_OSB);
#pragma unroll
    for (int dt = 0; dt < 4; ++dt)
#pragma unroll
        for (int i = 0; i < 16; ++i) { const int qq = (i & 3) + 8 * (i >> 2) + 4 * h; OSB[(size_t)(qrow0 + qq) * DSB + head * HD + 32 * dt + r] = (bf16)f2bf(o[dt][i]); }
}
__device__ __forceinline__ void lru_load_weights(LAS unsigned char* lds, const bf16* GT, int blk, int tid) {
    for (int idx = tid; idx < 2 * LBLK * 16; idx += NWAVES * 64) { const int gate = idx >> 11, row = (idx >> 4) & 127, ch = idx & 15;
        const v4u w = *(const v4u*)(GT + ((size_t)(gate * NBLK + blk) * LBLK + row) * LBLK + 8 * ch);
        *(LAS v4u*)(lds + gate * 32768 + row * 256 + ((ch ^ (row & 15)) << 4)) = w; }
}
__device__ __forceinline__ void p3_mixers(Frame& F, KArgs& A) {
    const int gw = F.vcu * NWAVES + F.wave, NGW = F.G * NWAVES;
    LAS unsigned char* wl = F.wave < 7 ? F.lds + 65536 + F.wave * WAVE_LDS : F.lds + EXCH_OFF;
    static_assert(65536 + 7 * WAVE_LDS <= RING_BYTES && EXCH_OFF + WAVE_LDS <= LDS_BYTES, "P3 LDS map");
    bool first = true;
#pragma unroll 1
    for (int p = F.vcu; first || p < NBLK * 16; p += F.G) {
        const bool has_pair = p < NBLK * 16; const int blk = has_pair ? p >> 4 : 0, slot = p & 15;
        if (!first) __syncthreads();
        lru_load_weights(F.lds, (const bf16*)(A.ws + WS_GATET), blk, F.tid);
        __syncthreads();
#pragma unroll 1
        for (int pass = 0; pass < 2; ++pass) {
            if ((pass ^ (F.wave >> 2)) == 0) {
#pragma unroll 1
                for (int k = 0; has_pair; ++k) {
                    int i;
                    if (F.G == 256) { const int w = F.wave; const bool light = (w == 5 || w == 6);
                        if (k < 3 || (k == 3 && !light)) i = w + 8 * k; else if (k == 4 && w >= 1 && w <= 3) i = (w == 1) ? 29 : (w == 2) ? 30 : 32; else break; }
                    else { i = F.wave + NWAVES * k; if (i >= 33) break; }
                    lru_unit(F, A, blk, 33 * slot + i, wl, F.lds); }
            } else if (first) {
#pragma unroll 1
                for (int k = 0;; ++k) {
                    int u;
                    if (F.G == 256) {
                        int kk;
                        if (F.wave < 7) { if (k < 4) kk = F.wave + 8 * k; else if (k == 4 && F.wave >= 5) kk = (F.wave == 5) ? 23 : 31; else break; u = F.vcu * 32 + kk; }
                        else { if (k == 0) u = 512 * NH + F.vcu; else if (k < 3) u = F.vcu * 32 + 7 + 8 * (k - 1); else break; }
                    } else {
                        u = gw + k * NGW;
                        if (u >= 512 * NH) { const int e = F.vcu + ((u - 512 * NH) / NGW) * F.G; if (F.wave != NWAVES - 1 || e >= NDEC * NH) break; u = 512 * NH + e; }
                    }
                    attn_unit(F, A, u, wl); }
            }
        }
        first = false;
    }
}

__device__ __forceinline__ void p4_carry(Frame& F, KArgs& A) {
    const float* AGA = (const float*)(A.ws + WS_AGGA); const float* AGH = (const float*)(A.ws + WS_AGGH); float* CARRY = (float*)(A.ws + WS_CARRY);
    LAS float* LA = (LAS float*)F.lds; LAS float* LH = LA + 512;
    for (int j = F.vcu; j < DLRU / 32; j += F.G) {
        const int g = F.tid >> 5, cl = F.tid & 31, ch = 32 * j + cl;
        float a[32], hh[32]; float ca = 1.f, chh = 0.f;
#pragma unroll
        for (int i = 0; i < 32; ++i) { a[i] = AGA[(size_t)(32 * g + i) * DLRU + ch]; hh[i] = AGH[(size_t)(32 * g + i) * DLRU + ch]; }
#pragma unroll
        for (int i = 0; i < 32; ++i) { chh = a[i] * chh + hh[i]; ca = a[i] * ca; }
        __syncthreads();
        LA[g * 32 + cl] = ca; LH[g * 32 + cl] = chh;
        __syncthreads();
        float cin = 0.f;
        for (int gg = 0; gg < g; ++gg) cin = LA[gg * 32 + cl] * cin + LH[gg * 32 + cl];
#pragma unroll
        for (int i = 0; i < 32; ++i) { CARRY[(size_t)(32 * g + i) * DLRU + ch] = cin; cin = a[i] * cin + hh[i]; }
        if (g == 15) A.out[OUT_LP + ch] = cin;
        { const int b = g, c = 512 + b; const float h0 = A.in[I_SL][(size_t)b * DLRU + ch];
          CARRY[(size_t)c * DLRU + ch] = h0; A.out[OUT_LS + (size_t)b * DLRU + ch] = AGH[(size_t)c * DLRU + ch] + AGA[(size_t)c * DLRU + ch] * h0; }
    }
}

__device__ __forceinline__ void p5_mixnorm(Frame& F, KArgs& A) {
    const int gw = F.vcu * NWAVES + F.wave, NGW = F.G * NWAVES, lane = F.lane;
    const bf16* PROJ = (const bf16*)(A.ws + WS_PROJ); const bf16* OSB = (const bf16*)(A.ws + WS_OSB);
    const unsigned* HP = (const unsigned*)(A.ws + WS_HP); const float* CARRY = (const float*)(A.ws + WS_CARRY);
    bf16* A2 = (bf16*)(A.ws + WS_ACT);
    LAS float* LG = (LAS float*)F.lds;
    for (int i = F.tid; i < DSB; i += NWAVES * 64) { LG[i] = A.in[I_GGA][i]; LG[DSB + i] = A.in[I_GGL][i]; }
    __syncthreads();
    for (int m = gw; m < SEQ; m += NGW) {
        v4u ow[4], hq0[4], hq1[4], glw[4]; f32x4 cr0[4], cr1[4]; const int c = m >> 5;
#pragma unroll
        for (int j = 0; j < 4; ++j) { const int col = 8 * lane + 512 * j; const size_t o = (size_t)m * DLRU + col;
            ow[j] = __builtin_nontemporal_load((const v4u*)(OSB + (size_t)m * DSB + col));
            hq0[j] = __builtin_nontemporal_load((const v4u*)(HP + o)); hq1[j] = __builtin_nontemporal_load((const v4u*)(HP + o + 4));
            cr0[j] = *(const f32x4*)(CARRY + (size_t)c * DLRU + col); cr1[j] = *(const f32x4*)(CARRY + (size_t)c * DLRU + col + 4);
            glw[j] = *(const v4u*)(PROJ + (size_t)m * DIN + 8192 + col); }
        { float v[32]; float ss = 0.f;
#pragma unroll
          for (int j = 0; j < 4; ++j) { const v4u w = ow[j];
              v[8 * j] = bf_lo(w.x); v[8 * j + 1] = bf_hi(w.x); v[8 * j + 2] = bf_lo(w.y); v[8 * j + 3] = bf_hi(w.y); v[8 * j + 4] = bf_lo(w.z); v[8 * j + 5] = bf_hi(w.z); v[8 * j + 6] = bf_lo(w.w); v[8 * j + 7] = bf_hi(w.w); }
#pragma unroll
          for (int i = 0; i < 32; ++i) ss += v[i] * v[i];
          const float rstd = 1.0f / sqrtf(wave_sum(ss) * (1.0f / DSB) + EPS);
#pragma unroll
          for (int j = 0; j < 4; ++j) { const LAS float* g = LG + 8 * lane + 512 * j; const f32x4 g0 = *(const LAS f32x4*)g, g1 = *(const LAS f32x4*)(g + 4);
              v4u w; w.x = pk2(v[8 * j] * rstd * g0.x, v[8 * j + 1] * rstd * g0.y); w.y = pk2(v[8 * j + 2] * rstd * g0.z, v[8 * j + 3] * rstd * g0.w);
              w.z = pk2(v[8 * j + 4] * rstd * g1.x, v[8 * j + 5] * rstd * g1.y); w.w = pk2(v[8 * j + 6] * rstd * g1.z, v[8 * j + 7] * rstd * g1.w);
              __builtin_nontemporal_store(w, (v4u*)(A2 + (size_t)m * DM + 8 * lane + 512 * j)); } }
        { float v[32]; float ss = 0.f;
#pragma unroll
          for (int j = 0; j < 4; ++j) {
              const v4u q0 = hq0[j], q1 = hq1[j];
              const f32x4 h0 = (f32x4){bf_lo(q0.x), bf_lo(q0.y), bf_lo(q0.z), bf_lo(q0.w)}, h1 = (f32x4){bf_lo(q1.x), bf_lo(q1.y), bf_lo(q1.z), bf_lo(q1.w)}, p0 = (f32x4){bf_hi(q0.x), bf_hi(q0.y), bf_hi(q0.z), bf_hi(q0.w)}, p1 = (f32x4){bf_hi(q1.x), bf_hi(q1.y), bf_hi(q1.z), bf_hi(q1.w)};
              const f32x4 c0 = cr0[j], c1 = cr1[j];
              const v4u gw4 = glw[j];
              const f32x4 a0 = h0 + p0 * c0, a1 = h1 + p1 * c1;
              v[8 * j] = a0.x * gelu_tanh(bf_lo(gw4.x)); v[8 * j + 1] = a0.y * gelu_tanh(bf_hi(gw4.x)); v[8 * j + 2] = a0.z * gelu_tanh(bf_lo(gw4.y)); v[8 * j + 3] = a0.w * gelu_tanh(bf_hi(gw4.y));
              v[8 * j + 4] = a1.x * gelu_tanh(bf_lo(gw4.z)); v[8 * j + 5] = a1.y * gelu_tanh(bf_hi(gw4.z)); v[8 * j + 6] = a1.z * gelu_tanh(bf_lo(gw4.w)); v[8 * j + 7] = a1.w * gelu_tanh(bf_hi(gw4.w)); }
#pragma unroll
          for (int i = 0; i < 32; ++i) ss += v[i] * v[i];
          const float rstd = 1.0f / sqrtf(wave_sum(ss) * (1.0f / DLRU) + EPS);
#pragma unroll
          for (int j = 0; j < 4; ++j) { const LAS float* g = LG + DSB + 8 * lane + 512 * j; const f32x4 g0 = *(const LAS f32x4*)g, g1 = *(const LAS f32x4*)(g + 4);
              v4u w; w.x = pk2(v[8 * j] * rstd * g0.x, v[8 * j + 1] * rstd * g0.y); w.y = pk2(v[8 * j + 2] * rstd * g0.z, v[8 * j + 3] * rstd * g0.w);
              w.z = pk2(v[8 * j + 4] * rstd * g1.x, v[8 * j + 5] * rstd * g1.y); w.w = pk2(v[8 * j + 6] * rstd * g1.z, v[8 * j + 7] * rstd * g1.w);
              __builtin_nontemporal_store(w, (v4u*)(A2 + (size_t)m * DM + DSB + 8 * lane + 512 * j)); } }
    }
    { LAS float* red = (LAS float*)(F.lds + 65536); const int c4 = 4 * (64 * F.wave + lane);
#pragma unroll 1
      for (int j = 0; F.vcu + j * F.G < M - SEQ; j += 2) {
          const int sra = F.vcu + j * F.G, srb_ = sra + F.G; const bool hasb = srb_ < M - SEQ; const int srb = hasb ? srb_ : sra;
          const int mr[2] = {SEQ + sra, SEQ + srb};
          f32x4 va[2], vl[2]; float sa0 = 0.f, sa1 = 0.f, sl0 = 0.f, sl1 = 0.f;
#pragma unroll
          for (int r = 0; r < 2; ++r) { const int m = mr[r];
              const v2u ow = *(const v2u*)(OSB + (size_t)m * DSB + c4); va[r] = (f32x4){bf_lo(ow.x), bf_hi(ow.x), bf_lo(ow.y), bf_hi(ow.y)};
              const v4u hq = *(const v4u*)(HP + (size_t)m * DLRU + c4); const f32x4 cr = *(const f32x4*)(CARRY + (size_t)(m >> 5) * DLRU + c4); const v2u gw2 = *(const v2u*)(PROJ + (size_t)m * DIN + 8192 + c4);
              const f32x4 hh = (f32x4){bf_lo(hq.x), bf_lo(hq.y), bf_lo(hq.z), bf_lo(hq.w)} + (f32x4){bf_hi(hq.x), bf_hi(hq.y), bf_hi(hq.z), bf_hi(hq.w)} * cr;
              vl[r] = (f32x4){hh.x * gelu_tanh(bf_lo(gw2.x)), hh.y * gelu_tanh(bf_hi(gw2.x)), hh.z * gelu_tanh(bf_lo(gw2.y)), hh.w * gelu_tanh(bf_hi(gw2.y))};
              const float ea = (va[r].x * va[r].x + va[r].y * va[r].y) + (va[r].z * va[r].z + va[r].w * va[r].w), el = (vl[r].x * vl[r].x + vl[r].y * vl[r].y) + (vl[r].z * vl[r].z + vl[r].w * vl[r].w);
              if (r == 0) { sa0 += ea; sl0 += el; } else { sa1 += ea; sl1 += el; } }
          float ta0, ta1, tl0, tl1; wg_sum2(F, sa0, sa1, red, ta0, ta1); wg_sum2(F, sl0, sl1, red + 16, tl0, tl1);
          const float ra[2] = {1.0f / sqrtf(ta0 * (1.0f / DSB) + EPS), 1.0f / sqrtf(ta1 * (1.0f / DSB) + EPS)}, rl[2] = {1.0f / sqrtf(tl0 * (1.0f / DLRU) + EPS), 1.0f / sqrtf(tl1 * (1.0f / DLRU) + EPS)};
          const f32x4 ga = *(const LAS f32x4*)(LG + c4), gl4 = *(const LAS f32x4*)(LG + DSB + c4);
#pragma unroll
          for (int r = 0; r < 2; ++r) if (r == 0 || hasb) { const f32x4 ya = va[r] * ra[r] * ga, yl = vl[r] * rl[r] * gl4;
              v2u w; w.x = pk2(ya.x, ya.y); w.y = pk2(ya.z, ya.w); *(v2u*)(A2 + (size_t)mr[r] * DM + c4) = w;
              w.x = pk2(yl.x, yl.y); w.y = pk2(yl.z, yl.w); *(v2u*)(A2 + (size_t)mr[r] * DM + DSB + c4) = w; }
          __syncthreads();
      } }
}

template <bool PROMPT>
__device__ __forceinline__ void p7_row(Frame& F, KArgs& A, int m, const LAS f32x4* LA, const LAS f32x4* LB, const LAS f32x4* LC) {
    const int lane = F.lane;
    const float* MOD = (const float*)(A.ws + WS_MOD); const bf16* MIX = (const bf16*)(A.ws + WS_MIX); bf16* H = (bf16*)(A.ws + WS_ACT);
    const f32x4* xr = (const f32x4*)xrow_of(A, m) + lane;
    f32x4 v[16]; float ss = 0.f;
    if (PROMPT) {
#pragma unroll
        for (int j = 0; j < 16; ++j) { const v2u w = __builtin_nontemporal_load((const v2u*)(MIX + (size_t)m * DM) + lane + 64 * j); v[j] = (f32x4){bf_lo(w.x), bf_hi(w.x), bf_lo(w.y), bf_hi(w.y)}; }
    } else {
#pragma unroll
        for (int j = 0; j < 16; ++j) v[j] = (f32x4){0.f, 0.f, 0.f, 0.f};
#pragma unroll 1
        for (int ks = 0; ks < KS_OUT; ++ks) { const f32x4* pr = (const f32x4*)(A.ws + WS_PART) + ((size_t)ks * (M - SEQ) + (m - SEQ)) * (DM / 4) + lane;
#pragma unroll
            for (int j = 0; j < 16; ++j) v[j] += pr[64 * j]; }
    }
#pragma unroll
    for (int j = 0; j < 16; ++j) ss += (v[j].x * v[j].x + v[j].y * v[j].y) + (v[j].z * v[j].z + v[j].w * v[j].w);
    const float rstd = 1.0f / sqrtf(wave_sum(ss) * (1.0f / DM) + EPS);
    v2u* xo = (v2u*)((bf16*)(A.ws + WS_X1) + (size_t)m * DM) + lane; float s2 = 0.f;
    const float* mo = MOD + (size_t)modrow_of(m) * NMODC;
#pragma unroll
    for (int j = 0; j < 16; ++j) { const f32x4 ca = PROMPT ? LA[lane + 64 * j] : ((const f32x4*)(mo + 2 * DM) + lane)[64 * j] * ((const f32x4*)A.in[I_GPOM] + lane)[64 * j];
        const f32x4 x1 = __builtin_nontemporal_load(xr + 64 * j) + ca * (v[j] * rstd); v[j] = x1; { v2u w; w.x = pk2(x1.x, x1.y); w.y = pk2(x1.z, x1.w); __builtin_nontemporal_store(w, xo + 64 * j); }
        s2 += (x1.x * x1.x + x1.y * x1.y) + (x1.z * x1.z + x1.w * x1.w); if ((j & 3) == 3) asm volatile("" ::: "memory"); }
    const float rstd2 = 1.0f / sqrtf(wave_sum(s2) * (1.0f / DM) + EPS);
    v2u* o = (v2u*)(H + (size_t)m * DM) + lane;
#pragma unroll
    for (int j = 0; j < 16; ++j) { const f32x4 cb = PROMPT ? LB[lane + 64 * j] : ((const f32x4*)A.in[I_GPF] + lane)[64 * j] * (1.0f + ((const f32x4*)(mo + 4 * DM) + lane)[64 * j]), cc = PROMPT ? LC[lane + 64 * j] : ((const f32x4*)(mo + 3 * DM) + lane)[64 * j];
        const f32x4 y = v[j] * rstd2 * cb + cc; v2u w; w.x = pk2(y.x, y.y); w.y = pk2(y.z, y.w); __builtin_nontemporal_store(w, o + 64 * j); if ((j & 3) == 3) asm volatile("" ::: "memory"); }
}
__device__ __forceinline__ void p7_load(KArgs& A, int m, int lane, v2u (&mx)[16], f32x4 (&x)[16]) {
    const v2u* mr = (const v2u*)((const bf16*)(A.ws + WS_MIX) + (size_t)m * DM) + lane; const f32x4* xr = (const f32x4*)(A.in[I_XP] + (size_t)m * DM) + lane;
#pragma unroll
    for (int j = 0; j < 16; ++j) { mx[j] = __builtin_nontemporal_load(mr + 64 * j); x[j] = __builtin_nontemporal_load(xr + 64 * j); }
}
__device__ __forceinline__ void p7_proc(Frame& F, KArgs& A, int m, const v2u (&mx)[16], f32x4 (&x)[16], const LAS f32x4* LA, const LAS f32x4* LB, const LAS f32x4* LC) {
    const int lane = F.lane; float ss = 0.f;
#pragma unroll
    for (int j = 0; j < 16; ++j) { const f32x4 v = (f32x4){bf_lo(mx[j].x), bf_hi(mx[j].x), bf_lo(mx[j].y), bf_hi(mx[j].y)}; ss += (v.x * v.x + v.y * v.y) + (v.z * v.z + v.w * v.w); }
    const float rstd = 1.0f / sqrtf(wave_sum(ss) * (1.0f / DM) + EPS);
    v2u* xo = (v2u*)((bf16*)(A.ws + WS_X1) + (size_t)m * DM) + lane; float s2 = 0.f;
#pragma unroll
    for (int j = 0; j < 16; ++j) { const f32x4 v = (f32x4){bf_lo(mx[j].x), bf_hi(mx[j].x), bf_lo(mx[j].y), bf_hi(mx[j].y)};
        const f32x4 x1 = x[j] + LA[lane + 64 * j] * (v * rstd); x[j] = x1; { v2u w; w.x = pk2(x1.x, x1.y); w.y = pk2(x1.z, x1.w); __builtin_nontemporal_store(w, xo + 64 * j); }
        s2 += (x1.x * x1.x + x1.y * x1.y) + (x1.z * x1.z + x1.w * x1.w); if ((j & 3) == 3) asm volatile("" ::: "memory"); }
    const float rstd2 = 1.0f / sqrtf(wave_sum(s2) * (1.0f / DM) + EPS);
    v2u* o = (v2u*)((bf16*)(A.ws + WS_ACT) + (size_t)m * DM) + lane;
#pragma unroll
    for (int j = 0; j < 16; ++j) { const f32x4 y = x[j] * rstd2 * LB[lane + 64 * j] + LC[lane + 64 * j]; v2u w; w.x = pk2(y.x, y.y); w.y = pk2(y.z, y.w); __builtin_nontemporal_store(w, o + 64 * j); if ((j & 3) == 3) asm volatile("" ::: "memory"); }
}
__device__ __forceinline__ void p7_samples(Frame& F, KArgs& A) {
    LAS float* red = (LAS float*)(F.lds + 65536);
    const float* MOD = (const float*)(A.ws + WS_MOD);
    const int cb = 128 * F.wave + F.lane;
#pragma unroll 1
    for (int j = 0; F.vcu + j * F.G < M - SEQ; j += 2) {
        const int sra = F.vcu + j * F.G, srb_ = sra + F.G; const bool hasb = srb_ < M - SEQ; const int srb = hasb ? srb_ : sra;
        const int sr[2] = {sra, srb};
        f32x4 v[2][2];
#pragma unroll
        for (int r = 0; r < 2; ++r)
#pragma unroll
            for (int q = 0; q < 2; ++q) v[r][q] = (f32x4){0.f, 0.f, 0.f, 0.f};
#pragma unroll
        for (int ks = 0; ks < KS_OUT; ++ks)
#pragma unroll
            for (int r = 0; r < 2; ++r)
#pragma unroll
                for (int q = 0; q < 2; ++q) v[r][q] += ((const f32x4*)(A.ws + WS_PART))[((size_t)ks * (M - SEQ) + sr[r]) * (DM / 4) + cb + 64 * q];
        float s0 = 0.f, s1 = 0.f;
#pragma unroll
        for (int q = 0; q < 2; ++q) { s0 += (v[0][q].x * v[0][q].x + v[0][q].y * v[0][q].y) + (v[0][q].z * v[0][q].z + v[0][q].w * v[0][q].w); s1 += (v[1][q].x * v[1][q].x + v[1][q].y * v[1][q].y) + (v[1][q].z * v[1][q].z + v[1][q].w * v[1][q].w); }
        float t0, t1; wg_sum2(F, s0, s1, red, t0, t1);
        const float rstd[2] = {1.0f / sqrtf(t0 * (1.0f / DM) + EPS), 1.0f / sqrtf(t1 * (1.0f / DM) + EPS)};
        float u0 = 0.f, u1 = 0.f;
#pragma unroll
        for (int r = 0; r < 2; ++r) { const float* mo = MOD + (size_t)(1 + (sr[r] >> 5)) * NMODC;
#pragma unroll
            for (int q = 0; q < 2; ++q) { const int ci = cb + 64 * q;
                const f32x4 x1 = ((const f32x4*)(A.in[I_XS] + (size_t)sr[r] * DM))[ci] + ((const f32x4*)(mo + 2 * DM))[ci] * ((const f32x4*)A.in[I_GPOM])[ci] * (v[r][q] * rstd[r]);
                v[r][q] = x1;
                if (r == 0 || hasb) { v2u w; w.x = pk2(x1.x, x1.y); w.y = pk2(x1.z, x1.w); ((v2u*)((bf16*)(A.ws + WS_X1) + (size_t)(SEQ + sr[r]) * DM))[ci] = w; }
                const float e = (x1.x * x1.x + x1.y * x1.y) + (x1.z * x1.z + x1.w * x1.w); if (r == 0) u0 += e; else u1 += e; } }
        wg_sum2(F, u0, u1, red + 16, t0, t1);
        const float rstd2[2] = {1.0f / sqrtf(t0 * (1.0f / DM) + EPS), 1.0f / sqrtf(t1 * (1.0f / DM) + EPS)};
#pragma unroll
        for (int r = 0; r < 2; ++r) { const float* mo = MOD + (size_t)(1 + (sr[r] >> 5)) * NMODC;
#pragma unroll
            for (int q = 0; q < 2; ++q) { const int ci = cb + 64 * q;
                const f32x4 y = v[r][q] * rstd2[r] * ((const f32x4*)A.in[I_GPF])[ci] * (1.0f + ((const f32x4*)(mo + 4 * DM))[ci]) + ((const f32x4*)(mo + 3 * DM))[ci];
                if (r == 0 || hasb) { v2u w; w.x = pk2(y.x, y.y); w.y = pk2(y.z, y.w); ((v2u*)((bf16*)(A.ws + WS_ACT) + (size_t)(SEQ + sr[r]) * DM))[ci] = w; } } }
    }
}
__device__ __forceinline__ void p7_postmix(Frame& F, KArgs& A) {
    const int gw = F.vcu * NWAVES + F.wave, NGW = F.G * NWAVES;
    const float* MOD = (const float*)(A.ws + WS_MOD);
    LAS f32x4* LA = (LAS f32x4*)F.lds; LAS f32x4* LB = LA + DM / 4; LAS f32x4* LC = LB + DM / 4;
    for (int i = F.tid; i < DM / 4; i += NWAVES * 64) { const f32x4* m4 = (const f32x4*)MOD + i;
        LA[i] = m4[2 * DM / 4] * ((const f32x4*)A.in[I_GPOM])[i]; LB[i] = ((const f32x4*)A.in[I_GPF])[i] * (1.0f + m4[4 * DM / 4]); LC[i] = m4[3 * DM / 4]; }
    __syncthreads();
#pragma unroll 1
    for (int m = gw; m < SEQ; m += NGW) { v2u mx[16]; f32x4 xx[16]; p7_load(A, m, F.lane, mx, xx); p7_proc(F, A, m, mx, xx, LA, LB, LC); }
    p7_samples(F, A);
}

__device__ __forceinline__ void up8(const v4u w, float (&f)[8]) { f[0] = bf_lo(w.x); f[1] = bf_hi(w.x); f[2] = bf_lo(w.y); f[3] = bf_hi(w.y); f[4] = bf_lo(w.z); f[5] = bf_hi(w.z); f[6] = bf_lo(w.w); f[7] = bf_hi(w.w); }
__device__ __forceinline__ void ld8(const float* p, float (&f)[8]) { const f32x4 a = *(const f32x4*)p, b = *(const f32x4*)(p + 4); f[0] = a.x; f[1] = a.y; f[2] = a.z; f[3] = a.w; f[4] = b.x; f[5] = b.y; f[6] = b.z; f[7] = b.w; }
__device__ __forceinline__ void p9_fix(Frame& F, KArgs& A) {
    const int gw = F.vcu * NWAVES + F.wave, NGW = F.G * NWAVES, lane = F.lane;
    const float* RAWP = (const float*)(A.ws + WS_RAWP); const float* RAWS = (const float*)(A.ws + WS_RAWS); bf16* ACTF = (bf16*)(A.ws + WS_ACTF);
    constexpr int NCC = (DFF + 511) / 512;
#pragma unroll 1
    for (int u = gw; u < 160 * NCC; u += NGW) {
        const int cc = u % NCC, fi = u / NCC, col = 512 * cc + 8 * lane;
        if (col >= DFF) continue;
        float wg[3][8], wv[3][8], bg[8], bv[8], g2[8], g1[8], g0[8], v2[8], v1[8], v0[8];
#pragma unroll
        for (int j = 0; j < 3; ++j) { ld8(A.in[I_WCF] + (size_t)j * DFF2 + col, wg[j]); ld8(A.in[I_WCF] + (size_t)j * DFF2 + DFF + col, wv[j]); }
        ld8(A.in[I_BCF] + col, bg); ld8(A.in[I_BCF] + DFF + col, bv);
        int row; const float *p0, *p1, *p2;
        if (fi < 128) { const int j = fi >> 1, d = fi & 1; row = 256 * j + d; const float* b = RAWP + (size_t)j * 4 * DFF2;
            p0 = b + (size_t)(2 + d) * DFF2; p1 = d ? b + (size_t)2 * DFF2 : (j ? b + (size_t)1 * DFF2 : nullptr); p2 = j ? (d ? b + (size_t)1 * DFF2 : b) : nullptr; }
        else { const int s = (fi - 128) >> 1, d = fi & 1; row = SEQ + 32 * s + d; const float* b = RAWS + (size_t)s * 2 * DFF2; const float* st = A.in[I_SCF] + (size_t)s * 2 * DFF2;
            p0 = b + (size_t)d * DFF2; p1 = d ? b : st + DFF2; p2 = d ? st + DFF2 : st; }
        ld8(p0 + col, g0); ld8(p0 + DFF + col, v0);
        if (p1) { ld8(p1 + col, g1); ld8(p1 + DFF + col, v1); } else {
#pragma unroll
            for (int e = 0; e < 8; ++e) { g1[e] = 0.f; v1[e] = 0.f; } }
        if (p2) { ld8(p2 + col, g2); ld8(p2 + DFF + col, v2); } else {
#pragma unroll
            for (int e = 0; e < 8; ++e) { g2[e] = 0.f; v2[e] = 0.f; } }
        float y[8];
#pragma unroll
        for (int e = 0; e < 8; ++e) { const float gc = bg[e] + wg[0][e] * g2[e] + wg[1][e] * g1[e] + wg[2][e] * g0[e]; const float vc = bv[e] + wv[0][e] * v2[e] + wv[1][e] * v1[e] + wv[2][e] * v0[e]; y[e] = gelu_tanh(gc) * vc; }
        v4u w; w.x = pk2(y[0], y[1]); w.y = pk2(y[2], y[3]); w.z = pk2(y[4], y[5]); w.w = pk2(y[6], y[7]);
        *(v4u*)(ACTF + (size_t)row * DFF + col) = w;
    }
}

template <bool PROMPT>
__device__ __forceinline__ void p11_row(Frame& F, KArgs& A, int m, const LAS f32x4* LA) {
    const int lane = F.lane;
    const float* MOD = (const float*)(A.ws + WS_MOD); const bf16* YD = (const bf16*)(A.ws + WS_MIX);
    f32x4 v[16]; float ss = 0.f;
    if (PROMPT) {
#pragma unroll
        for (int j = 0; j < 16; ++j) { const v2u w = __builtin_nontemporal_load((const v2u*)(YD + (size_t)m * DM) + lane + 64 * j); v[j] = (f32x4){bf_lo(w.x), bf_hi(w.x), bf_lo(w.y), bf_hi(w.y)}; }
    } else {
#pragma unroll
        for (int j = 0; j < 16; ++j) v[j] = (f32x4){0.f, 0.f, 0.f, 0.f};
#pragma unroll 1
        for (int ks = 0; ks < KS_DOWN; ++ks) { const f32x4* pr = (const f32x4*)(A.ws + WS_PART) + ((size_t)ks * (M - SEQ) + (m - SEQ)) * (DM / 4) + lane;
#pragma unroll
            for (int j = 0; j < 16; ++j) v[j] += pr[64 * j]; }
    }
#pragma unroll
    for (int j = 0; j < 16; ++j) ss += (v[j].x * v[j].x + v[j].y * v[j].y) + (v[j].z * v[j].z + v[j].w * v[j].w);
    const float rstd = 1.0f / sqrtf(wave_sum(ss) * (1.0f / DM) + EPS);
    f32x4* yo = (f32x4*)(A.out + OUT_Y + (size_t)m * DM) + lane;
    const v2u* xi = (const v2u*)((const bf16*)(A.ws + WS_X1) + (size_t)m * DM) + lane;
#pragma unroll
    for (int j = 0; j < 16; ++j) { const v2u w = __builtin_nontemporal_load(xi + 64 * j); const f32x4 x1 = (f32x4){bf_lo(w.x), bf_hi(w.x), bf_lo(w.y), bf_hi(w.y)};
        const f32x4 ca = PROMPT ? LA[lane + 64 * j] : ((const f32x4*)(MOD + (size_t)modrow_of(m) * NMODC + 5 * DM) + lane)[64 * j] * ((const f32x4*)A.in[I_GPOF] + lane)[64 * j];
        const f32x4 y = x1 + ca * (v[j] * rstd); __builtin_nontemporal_store(y, yo + 64 * j); if ((j & 3) == 3) asm volatile("" ::: "memory"); }
}
__device__ __forceinline__ void p11_load(KArgs& A, int m, int lane, v2u (&y)[16], v2u (&x)[16]) {
    const v2u* yr = (const v2u*)((const bf16*)(A.ws + WS_MIX) + (size_t)m * DM) + lane; const v2u* xr = (const v2u*)((const bf16*)(A.ws + WS_X1) + (size_t)m * DM) + lane;
#pragma unroll
    for (int j = 0; j < 16; ++j) { y[j] = __builtin_nontemporal_load(yr + 64 * j); x[j] = __builtin_nontemporal_load(xr + 64 * j); }
}
__device__ __forceinline__ void p11_proc(Frame& F, KArgs& A, int m, const v2u (&y)[16], const v2u (&x)[16], const LAS f32x4* LA) {
    const int lane = F.lane; float ss = 0.f;
#pragma unroll
    for (int j = 0; j < 16; ++j) { const f32x4 v = (f32x4){bf_lo(y[j].x), bf_hi(y[j].x), bf_lo(y[j].y), bf_hi(y[j].y)}; ss += (v.x * v.x + v.y * v.y) + (v.z * v.z + v.w * v.w); }
    const float rstd = 1.0f / sqrtf(wave_sum(ss) * (1.0f / DM) + EPS);
    f32x4* yo = (f32x4*)(A.out + OUT_Y + (size_t)m * DM) + lane;
#pragma unroll
    for (int j = 0; j < 16; ++j) { const f32x4 v = (f32x4){bf_lo(y[j].x), bf_hi(y[j].x), bf_lo(y[j].y), bf_hi(y[j].y)}, x1 = (f32x4){bf_lo(x[j].x), bf_hi(x[j].x), bf_lo(x[j].y), bf_hi(x[j].y)};
        const f32x4 o = x1 + LA[lane + 64 * j] * (v * rstd); __builtin_nontemporal_store(o, yo + 64 * j); if ((j & 3) == 3) asm volatile("" ::: "memory"); }
}
__device__ __forceinline__ void p11_samples(Frame& F, KArgs& A) {
    LAS float* red = (LAS float*)(F.lds + 65536);
    const float* MOD = (const float*)(A.ws + WS_MOD);
    const int cb = 128 * F.wave + F.lane;
#pragma unroll 1
    for (int j = 0; F.vcu + j * F.G < M - SEQ; j += 2) {
        const int sra = F.vcu + j * F.G, srb_ = sra + F.G; const bool hasb = srb_ < M - SEQ; const int srb = hasb ? srb_ : sra;
        const int sr[2] = {sra, srb};
        f32x4 v[2][2];
#pragma unroll
        for (int r = 0; r < 2; ++r)
#pragma unroll
            for (int q = 0; q < 2; ++q) v[r][q] = (f32x4){0.f, 0.f, 0.f, 0.f};
#pragma unroll
        for (int ks = 0; ks < KS_DOWN; ++ks)
#pragma unroll
            for (int r = 0; r < 2; ++r)
#pragma unroll
                for (int q = 0; q < 2; ++q) v[r][q] += ((const f32x4*)(A.ws + WS_PART))[((size_t)ks * (M - SEQ) + sr[r]) * (DM / 4) + cb + 64 * q];
        float s0 = 0.f, s1 = 0.f;
#pragma unroll
        for (int q = 0; q < 2; ++q) { s0 += (v[0][q].x * v[0][q].x + v[0][q].y * v[0][q].y) + (v[0][q].z * v[0][q].z + v[0][q].w * v[0][q].w); s1 += (v[1][q].x * v[1][q].x + v[1][q].y * v[1][q].y) + (v[1][q].z * v[1][q].z + v[1][q].w * v[1][q].w); }
        float t0, t1; wg_sum2(F, s0, s1, red, t0, t1);
        const float rstd[2] = {1.0f / sqrtf(t0 * (1.0f / DM) + EPS), 1.0f / sqrtf(t1 * (1.0f / DM) + EPS)};
#pragma unroll
        for (int r = 0; r < 2; ++r) { const float* mo = MOD + (size_t)(1 + (sr[r] >> 5)) * NMODC;
#pragma unroll
            for (int q = 0; q < 2; ++q) { const int ci = cb + 64 * q;
                const v2u w = ((const v2u*)((const bf16*)(A.ws + WS_X1) + (size_t)(SEQ + sr[r]) * DM))[ci]; const f32x4 x1 = (f32x4){bf_lo(w.x), bf_hi(w.x), bf_lo(w.y), bf_hi(w.y)};
                const f32x4 y = x1 + ((const f32x4*)(mo + 5 * DM))[ci] * ((const f32x4*)A.in[I_GPOF])[ci] * (v[r][q] * rstd[r]);
                if (r == 0 || hasb) ((f32x4*)(A.out + OUT_Y + (size_t)(SEQ + sr[r]) * DM))[ci] = y; } }
        __syncthreads();
    }
}
__device__ __forceinline__ void p11_final(Frame& F, KArgs& A) {
    const int gw = F.vcu * NWAVES + F.wave, NGW = F.G * NWAVES;
    const float* MOD = (const float*)(A.ws + WS_MOD);
    LAS f32x4* LA = (LAS f32x4*)F.lds;
    for (int i = F.tid; i < DM / 4; i += NWAVES * 64) LA[i] = ((const f32x4*)(MOD + 5 * DM))[i] * ((const f32x4*)A.in[I_GPOF])[i];
    __syncthreads();
    { v2u ya[16], xa[16], yb[16], xb[16]; int m = gw;
      if (m < SEQ) p11_load(A, m, F.lane, ya, xa);
#pragma unroll 1
      for (; m < SEQ; m += 2 * NGW) {
          if (m + NGW < SEQ) p11_load(A, m + NGW, F.lane, yb, xb);
          p11_proc(F, A, m, ya, xa, LA);
          if (m + NGW < SEQ) { if (m + 2 * NGW < SEQ) p11_load(A, m + 2 * NGW, F.lane, ya, xa); p11_proc(F, A, m + NGW, yb, xb, LA); }
      } }
    p11_samples(F, A);
}

__global__ void __launch_bounds__(NWAVES * 64, 2) mk_fwd(Args args_by_value) {
    extern __shared__ __attribute__((aligned(16))) unsigned char lds[];
    KArgs& args = *(KArgs*)__builtin_amdgcn_kernarg_segment_ptr();
    Frame F;
    F.lds = (LAS unsigned char*)lds;
    F.MISC = (volatile LAS unsigned*)(F.lds + MISC_OFF);
    F.tid = threadIdx.x; F.lane = F.tid & 63; F.wave = __builtin_amdgcn_readfirstlane(F.tid >> 6);
    F.G = gridDim.x; { const int bx = blockIdx.x; F.vcu = (F.G % 8 == 0) ? (bx % 8) * (F.G / 8) + bx / 8 : bx; }
    F.ctl = (gu32*)(args.ws + WS_CTL);
    for (int u = F.tid; u < (LDS_BYTES - LDSCTL_OFF) / 4; u += NWAVES * 64) ((LAS unsigned*)(F.lds + LDSCTL_OFF))[u] = 0u;
    __syncthreads();
    XcdBarrier bar = xcd_barrier_post((unsigned*)(F.ctl + CW_BAR) + args.li * XCD_BAR_WORDS, F.MISC + 8);
    const int lo = args.ph_lo, hi = args.ph_hi;
#define IN(k) (lo <= (k) && (k) < hi)
#define SEAM(k) do { if (IN(k) && IN((k) + 1)) xcd_barrier(bar); } while (0)
    unsigned char* ws = args.ws;

    if (IN(0)) { p0_prologue(F, args); } SEAM(0);
    if (IN(1)) { p1_h1(F, args); } SEAM(1);
    if (IN(2)) {
        pg8::Gemm g{(const pg8::bf16_t*)(ws + WS_ACT), (const pg8::bf16_t*)(ws + WS_WIN), M, DIN, DM}; pg8::StaticOrder S; S.init(M, DIN, F.G, (int)blockIdx.x);
        pg8::EpiInProj E{(pg8::bf16_t*)(ws + WS_PROJ), args.out + OUT_KP, args.out + OUT_VP, args.out + OUT_KS, args.out + OUT_VS, args.out + OUT_CLP, args.out + OUT_CLS};
        pg8::gemm_phase<pg8::EpiInProj, pg8::StaticOrder, true, true>(F.lds, g, S, E);
        tail_convert<true>(F, args.in[I_WUP], DM, DFF2, (bf16*)(ws + WS_WUP), IT_UP_TAIL, (M / 256) * (DIN / 256));
    } SEAM(2);
    if (IN(3)) { p3_mixers(F, args); } SEAM(3);
    if (IN(4)) { p4_carry(F, args); } SEAM(4);
    if (IN(5)) { p5_mixnorm(F, args); } SEAM(5);
    if (IN(6)) {
        pg8::Gemm g{(const pg8::bf16_t*)(ws + WS_ACT), (const pg8::bf16_t*)(ws + WS_WOUT), M, DM, DM}; pg8::SplitOrder S; S.init(SEQ, M - SEQ, DM, KS_OUT, DM / 64 / KS_OUT, KS_OUT, F.G, (int)blockIdx.x);
        pg8::EpiMixS E{(pg8::bf16_t*)(ws + WS_MIX), DM, (float*)(ws + WS_PART), SEQ, M - SEQ};
        pg8::gemm_phase<pg8::EpiMixS, pg8::SplitOrder, true, true>(F.lds, g, S, E);
    } SEAM(6);
    if (IN(7)) { p7_postmix(F, args); } SEAM(7);
    if (IN(8)) {
        pg8::Gemm g{(const pg8::bf16_t*)(ws + WS_ACT), (const pg8::bf16_t*)(ws + WS_WUP), M, DFF2, DM}; pg8::StaticOrder S; S.init(M, DFF2, F.G, (int)blockIdx.x);
        pg8::EpiUpAct E{(pg8::bf16_t*)(ws + WS_ACTF), args.in[I_WCF], args.in[I_BCF], (float*)(ws + WS_RAWP), (float*)(ws + WS_RAWS), args.out + OUT_CFP, args.out + OUT_CFS, (LAS float*)(F.lds + EXCH_OFF)};
        pg8::gemm_phase<pg8::EpiUpAct, pg8::StaticOrder, true, true>(F.lds, g, S, E);
        tail_convert<false>(F, args.in[I_WDOWN], DFF, DM, (bf16*)(ws + WS_WDOWN), IT_DOWN_TAIL, (M / 256) * (DFF2 / 256));
    } SEAM(8);
    if (IN(9)) { p9_fix(F, args); } SEAM(9);
    if (IN(10)) {
        pg8::Gemm g{(const pg8::bf16_t*)(ws + WS_ACTF), (const pg8::bf16_t*)(ws + WS_WDOWN), M, DM, DFF}; pg8::SplitOrder S; S.init(SEQ, M - SEQ, DM, KS_DOWN, 44, 2, F.G, (int)blockIdx.x);
        pg8::EpiMixS E{(pg8::bf16_t*)(ws + WS_MIX), DM, (float*)(ws + WS_PART), SEQ, M - SEQ};
        pg8::gemm_phase<pg8::EpiMixS, pg8::SplitOrder, true, true>(F.lds, g, S, E);
    } SEAM(10);
    if (IN(11)) { p11_final(F, args); }
#undef IN
#undef SEAM
}

#ifndef MK_N_LAUNCHES
#define MK_N_LAUNCHES 1
#endif
extern "C" void kernel_launch(void* const* d_in, const int* in_sizes, int n_in, void* d_out, int out_size, void* d_ws, size_t ws_size, hipStream_t stream) {
    static int grid = 0;
    if (grid == 0) {
        if (n_in != N_IN || (size_t)out_size != OUT_END || ws_size < WS_END) { fprintf(stderr, "kernel_launch: unexpected shapes (n_in %d, out %d, ws %zu); nothing launched\n", n_in, out_size, ws_size); grid = -1; return; }
        int dev = 0, cus = 0, per_cu = 0;
        if (hipGetDevice(&dev) != hipSuccess || hipDeviceGetAttribute(&cus, hipDeviceAttributeMultiprocessorCount, dev) != hipSuccess) { grid = -1; return; }
        if (hipFuncSetAttribute((const void*)mk_fwd, hipFuncAttributeMaxDynamicSharedMemorySize, LDS_BYTES) != hipSuccess) { fprintf(stderr, "kernel_launch: hipFuncSetAttribute failed\n"); grid = -1; return; }
        if (hipOccupancyMaxActiveBlocksPerMultiprocessor(&per_cu, (const void*)mk_fwd, NWAVES * 64, LDS_BYTES) != hipSuccess || per_cu < 1) { fprintf(stderr, "kernel_launch: occupancy query says %d blocks per CU\n", per_cu); }
        (void)hipGetLastError();
        grid = cus;
    }
    if (grid < 0) return;
    if (hipMemsetAsync((char*)d_ws + WS_CTL, 0, CTL_ZERO_BYTES, stream) != hipSuccess) return;
    Args a{};
    for (int i = 0; i < N_IN; ++i) a.in[i] = (const float*)d_in[i];
    a.out = (float*)d_out; a.ws = (unsigned char*)d_ws; a.pad = 0;
#if defined(MK_PROBE_DUP)
    { static const int kDup[NPH] = MK_PROBE_DUP;
      for (int li = 0; li < NPH; ++li) for (int rep = 0; rep < kDup[li]; ++rep) { a.ph_lo = li; a.ph_hi = li + 1; a.li = li; hipLaunchKernelGGL(mk_fwd, dim3(grid), dim3(NWAVES * 64), LDS_BYTES, stream, a); } }
#elif MK_N_LAUNCHES == 1
    a.ph_lo = 0; a.ph_hi = NPH; a.li = 0;
    hipLaunchKernelGGL(mk_fwd, dim3(grid), dim3(NWAVES * 64), LDS_BYTES, stream, a);
#else
    for (int li = 0; li < NPH; ++li) { a.ph_lo = li; a.ph_hi = li + 1; a.li = li; hipLaunchKernelGGL(mk_fwd, dim3(grid), dim3(NWAVES * 64), LDS_BYTES, stream, a); }
#endif
}
```

```cpp
#include <hip/hip_runtime.h>
#include <cstdio>
#include <cstdint>
namespace pg8 {
#define PG8_LAS __attribute__((address_space(3)))
typedef unsigned short bf16_t;
typedef short bf16x8 __attribute__((ext_vector_type(8)));
typedef float f32x4 __attribute__((ext_vector_type(4)));
typedef unsigned u32x4 __attribute__((ext_vector_type(4)));
constexpr int BM = 256, BK = 64, HALF = 128, HTB = HALF * BK * 2  , STAGE_BYTES = 8 * HTB, NXCD = 8, WGM = 8;

__host__ __device__ __forceinline__ int lds_byte(int r, int c) { const int st = (r >> 4) * 2 + (c >> 5), rr = r & 15, cc = c & 31, ob = rr * 64 + cc * 2; return st * 1024 + (ob ^ (((ob >> 9) & 1) << 5)); }
__host__ __device__ __forceinline__ void stage_rc(int b, int& R, int& C) { const int st = b / 1024, sb = b % 1024, swz = sb ^ (((sb >> 9) & 1) << 5); R = (st >> 1) * 16 + swz / 64; C = (st & 1) * 32 + (swz % 64) / 2; }
__host__ __device__ __forceinline__ int perm32(int rho) { const int n = rho >> 4, i = rho & 15; return 8 * (i >> 2) + 4 * n + (i & 3); }

struct Unit { int pm, pn; };
struct Gemm { const bf16_t* A; const bf16_t* Bt; int M, N, K; };

struct StaticOrder {
    int nM, nN, nwg, G, c;
    __host__ __device__ void init(int M, int N, int G_, int c_) { nM = M / BM; nN = N / BM; nwg = nM * nN; G = G_; c = c_; }
    __host__ __device__ __forceinline__ bool next(int i, Unit& u) const {
        const long L = (long)i * G + c; if (L >= nwg) return false;
        int wgid = (int)L; { const int q = nwg / NXCD, r = nwg % NXCD, xcd = wgid % NXCD, off = wgid / NXCD; wgid = (xcd < r ? xcd * (q + 1) : r * (q + 1) + (xcd - r) * q) + off; }
        const int nig = WGM * nN, gid = wgid / nig, fm = gid * WGM, gsz = (nM - fm) < WGM ? (nM - fm) : WGM;
        u.pm = fm + ((wgid % nig) % gsz); u.pn = (wgid % nig) / gsz; return true;
    }
    __device__ __forceinline__ void a_ready(const Unit&) const {}
    __device__ __forceinline__ void done(const Unit&) const {}
    __device__ __forceinline__ void kslice(const Unit&, int ntf, int& kt0, int& nt) const { kt0 = 0; nt = ntf; }
};
struct SplitOrder {
    StaticOrder main; int pm0, npan, nN, nks, nt_hi, n_hi, G, c, nmine;
    __host__ __device__ void init(int Mmain, int Msplit, int N, int nks_, int nt_hi_, int n_hi_, int G_, int c_) {
        main.init(Mmain, N, G_, c_); pm0 = Mmain / BM; npan = Msplit / BM; nN = N / BM; nks = nks_; nt_hi = nt_hi_; n_hi = n_hi_; G = G_; c = c_;
        nmine = (main.nwg > c_) ? (main.nwg - c_ + G_ - 1) / G_ : 0; }
    __host__ __device__ __forceinline__ bool next(int i, Unit& u) const {
        const bool is_main = i < nmine; Unit m; m.pm = 0; m.pn = 0; const bool okm = main.next(is_main ? i : 0, m);
        const int j = (i - nmine) * G + c, ks = j % nks, rest = j / nks;
        u.pm = is_main ? m.pm : pm0 + rest / nN; u.pn = is_main ? m.pn : ((rest % nN) | ((ks + 1) << 8));
        return is_main ? okm : (j < npan * nN * nks);
    }
    __device__ __forceinline__ void a_ready(const Unit&) const {}
    __device__ __forceinline__ void done(const Unit&) const {}
    __device__ __forceinline__ void kslice(const Unit& u, int ntf, int& kt0, int& nt) const { const int ksp = u.pn >> 8, ks = ksp - 1;
        nt = ksp == 0 ? ntf : (ks < n_hi ? nt_hi : nt_hi - 2); kt0 = ksp == 0 ? 0 : (ks < n_hi ? ks * nt_hi : n_hi * nt_hi + (ks - n_hi) * (nt_hi - 2)); }
};
__device__ __forceinline__ unsigned cvt_pk_bf16(float lo, float hi) { unsigned r; asm volatile("v_cvt_pk_bf16_f32 %0, %1, %2" : "=v"(r) : "v"(lo), "v"(hi)); return r; }
typedef float f32x2 __attribute__((ext_vector_type(2)));
struct EpiF32 {
    static constexpr bool PERM = false, AFTER_DRAIN = false;
    float* C; int ldc; const float* bias;
    __device__ __forceinline__ void operator()(const f32x4 (&acc)[2][2][4][2], const Unit& u, int wr, int wc, int fr, int fq) const {
        const int row0 = u.pm * BM + wr * 64 + fr, col0 = u.pn * BM + wc * 32 + 4 * fq;
        f32x4 bv[2][2];
#pragma unroll
        for (int bj = 0; bj < 2; ++bj)
#pragma unroll
            for (int n = 0; n < 2; ++n) bv[bj][n] = bias ? *(const f32x4*)(bias + col0 + bj * HALF + n * 16) : (f32x4){0.f, 0.f, 0.f, 0.f};
#pragma unroll
        for (int ai = 0; ai < 2; ++ai)
#pragma unroll
            for (int m = 0; m < 4; ++m) { float* rowp = C + (size_t)(row0 + ai * HALF + m * 16) * ldc + col0;
#pragma unroll
                for (int bj = 0; bj < 2; ++bj)
#pragma unroll
                    for (int n = 0; n < 2; ++n) *(f32x4*)(rowp + bj * HALF + n * 16) = acc[ai][bj][m][n] + bv[bj][n]; }
    }
};
struct EpiInProj {
    static constexpr bool PERM = true, AFTER_DRAIN = false;
    bf16_t* P; float* kp; float* vp; float* ks; float* vs; float* clp; float* cls;
    __device__ __forceinline__ void operator()(const f32x4 (&acc)[2][2][4][2], const Unit& u, int wr, int wc, int fr, int fq) const {
        const int row0 = u.pm * BM + wr * 64 + fr, col0 = u.pn * BM + wc * 32 + 8 * fq;
        const int seg = u.pn >> 3;
#pragma unroll
        for (int ai = 0; ai < 2; ++ai)
#pragma unroll
            for (int m = 0; m < 4; ++m) { const int row = row0 + ai * HALF + m * 16; bf16_t* rowp = P + (size_t)row * 10240 + col0;
#pragma unroll
                for (int bj = 0; bj < 2; ++bj) { const f32x4 v0 = acc[ai][bj][m][0], v1 = acc[ai][bj][m][1];
                    u32x4 w; w.x = cvt_pk_bf16(v0[0], v0[1]); w.y = cvt_pk_bf16(v0[2], v0[3]); w.z = cvt_pk_bf16(v1[0], v1[1]); w.w = cvt_pk_bf16(v1[2], v1[3]);
                    *(u32x4*)(rowp + bj * HALF) = w; }
                if (seg == 1 || seg == 2) {
                    const int c = col0 - seg * 2048;
                    float* o = (row < 16384) ? ((seg == 1 ? kp : vp) + (size_t)row * 2048 + c) : ((seg == 1 ? ks : vs) + (size_t)(row - 16384) * 2048 + c);
#pragma unroll
                    for (int bj = 0; bj < 2; ++bj) { *(f32x4*)(o + bj * HALF) = acc[ai][bj][m][0]; *(f32x4*)(o + bj * HALF + 4) = acc[ai][bj][m][1]; }
                }
                if (seg == 3 && u.pm >= 63) {
                    const int c = col0 - 6144; float* o = nullptr;
                    if (row < 16384) { if (row >= 16381) o = clp + (size_t)(row - 16381) * 2048 + c; }
                    else { const int rs = row - 16384, j = (rs & 31) - 29; if (j >= 0) o = cls + (size_t)((rs >> 5) * 3 + j) * 2048 + c; }
                    if (o) {
#pragma unroll
                        for (int bj = 0; bj < 2; ++bj) { *(f32x4*)(o + bj * HALF) = acc[ai][bj][m][0]; *(f32x4*)(o + bj * HALF + 4) = acc[ai][bj][m][1]; } }
                }
            }
    }
};
struct EpiUp {
    static constexpr bool PERM = true, AFTER_DRAIN = false;
    bf16_t* U; float* cfp; float* cfs;
    __device__ __forceinline__ void operator()(const f32x4 (&acc)[2][2][4][2], const Unit& u, int wr, int wc, int fr, int fq) const {
        const int row0 = u.pm * BM + wr * 64 + fr, col0 = u.pn * BM + wc * 32 + 8 * fq;
#pragma unroll
        for (int ai = 0; ai < 2; ++ai)
#pragma unroll
            for (int m = 0; m < 4; ++m) { const int row = row0 + ai * HALF + m * 16; bf16_t* rowp = U + (size_t)row * 22016 + col0;
#pragma unroll
                for (int bj = 0; bj < 2; ++bj) { const f32x4 v0 = acc[ai][bj][m][0], v1 = acc[ai][bj][m][1];
                    u32x4 w; w.x = cvt_pk_bf16(v0[0], v0[1]); w.y = cvt_pk_bf16(v0[2], v0[3]); w.z = cvt_pk_bf16(v1[0], v1[1]); w.w = cvt_pk_bf16(v1[2], v1[3]);
                    *(u32x4*)(rowp + bj * HALF) = w; }
                if (u.pm >= 63) {
                    float* o = nullptr;
                    if (row < 16384) { if (row >= 16382) o = cfp + (size_t)(row - 16382) * 22016 + col0; }
                    else { const int rs = row - 16384, j = (rs & 31) - 30; if (j >= 0) o = cfs + (size_t)((rs >> 5) * 2 + j) * 22016 + col0; }
                    if (o) {
#pragma unroll
                        for (int bj = 0; bj < 2; ++bj) { *(f32x4*)(o + bj * HALF) = acc[ai][bj][m][0]; *(f32x4*)(o + bj * HALF + 4) = acc[ai][bj][m][1]; } }
                }
            }
    }
};
struct EpiMixS {
    static constexpr bool PERM = true, AFTER_DRAIN = false;
    bf16_t* C; int ldc; float* part; int row_split0, rows_split;
    __device__ __forceinline__ void operator()(const f32x4 (&acc)[2][2][4][2], const Unit& u, int wr, int wc, int fr, int fq) const {
        const int ksp = u.pn >> 8, row0 = u.pm * BM + wr * 64 + fr, col0 = (u.pn & 255) * BM + wc * 32 + 8 * fq;
        if (ksp == 0) {
#pragma unroll
            for (int ai = 0; ai < 2; ++ai)
#pragma unroll
                for (int m = 0; m < 4; ++m) { bf16_t* rowp = C + (size_t)(row0 + ai * HALF + m * 16) * ldc + col0;
#pragma unroll
                    for (int bj = 0; bj < 2; ++bj) { const f32x4 v0 = acc[ai][bj][m][0], v1 = acc[ai][bj][m][1];
                        u32x4 w; w.x = cvt_pk_bf16(v0[0], v0[1]); w.y = cvt_pk_bf16(v0[2], v0[3]); w.z = cvt_pk_bf16(v1[0], v1[1]); w.w = cvt_pk_bf16(v1[2], v1[3]);
                        *(u32x4*)(rowp + bj * HALF) = w; } }
        } else {
            float* base = part + ((size_t)(ksp - 1) * rows_split - (size_t)row_split0) * ldc;
#pragma unroll
            for (int ai = 0; ai < 2; ++ai)
#pragma unroll
                for (int m = 0; m < 4; ++m) { float* rowp = base + (size_t)(row0 + ai * HALF + m * 16) * ldc + col0;
#pragma unroll
                    for (int bj = 0; bj < 2; ++bj) { *(f32x4*)(rowp + bj * HALF) = acc[ai][bj][m][0]; *(f32x4*)(rowp + bj * HALF + 4) = acc[ai][bj][m][1]; } }
        }
    }
};
__device__ __forceinline__ float dpp_ror1(float v) { return __builtin_bit_cast(float, __builtin_amdgcn_mov_dpp(__builtin_bit_cast(int, v), 0x121, 0xf, 0xf, false)); }
__device__ __forceinline__ float dpp_shr1(float old, float v) { return __builtin_bit_cast(float, __builtin_amdgcn_update_dpp(__builtin_bit_cast(int, old), __builtin_bit_cast(int, v), 0x111, 0xf, 0xf, false)); }
__device__ __forceinline__ float dpp_ror2(float v) { return __builtin_bit_cast(float, __builtin_amdgcn_mov_dpp(__builtin_bit_cast(int, v), 0x122, 0xf, 0xf, false)); }
__device__ __forceinline__ float dpp_shr2(float old, float v) { return __builtin_bit_cast(float, __builtin_amdgcn_update_dpp(__builtin_bit_cast(int, old), __builtin_bit_cast(int, v), 0x112, 0xf, 0xf, false)); }
struct EpiUpAct {
    static constexpr bool PERM = true, AFTER_DRAIN = false;
    bf16_t* ACT; const float* wcv; const float* bcv; float* rawp; float* raws; float* cfp; float* cfs; PG8_LAS float* X;
    __device__ __forceinline__ void operator()(const f32x4 (&acc)[2][2][4][2], const Unit& u, int wr, int wc, int fr, int fq) const {
        const int x0 = wc * 32 + 8 * fq, gcol = u.pn * 128 + x0;
        if (fr >= 14) {
#pragma unroll
            for (int ai = 0; ai < 2; ++ai)
#pragma unroll
                for (int bj = 0; bj < 2; ++bj)
#pragma unroll
                    for (int n = 0; n < 2; ++n) *(PG8_LAS f32x4*)(X + (((2 * ai + wr) * 2 + (fr - 14)) * 256 + bj * 128 + x0 + 4 * n)) = acc[ai][bj][3][n];
        }
        asm volatile("s_waitcnt lgkmcnt(0)" ::: "memory"); __builtin_amdgcn_s_barrier(); asm volatile("" ::: "memory");
#pragma unroll
        for (int n = 0; n < 2; ++n) {
            f32x4 w0[2], w1[2], w2[2], bb[2];
#pragma unroll
            for (int bj = 0; bj < 2; ++bj) { const float* p = wcv + bj * 11008 + gcol + 4 * n; w0[bj] = *(const f32x4*)p; w1[bj] = *(const f32x4*)(p + 22016); w2[bj] = *(const f32x4*)(p + 44032);
                bb[bj] = *(const f32x4*)(bcv + bj * 11008 + gcol + 4 * n); }
#pragma unroll
            for (int ai = 0; ai < 2; ++ai) {
                const int ps = (2 * ai + wr + 3) & 3;
                f32x4 P14[2], P15[2];
#pragma unroll
                for (int bj = 0; bj < 2; ++bj) { P14[bj] = *(const PG8_LAS f32x4*)(X + ((ps * 2 + 0) * 256 + bj * 128 + x0 + 4 * n)); P15[bj] = *(const PG8_LAS f32x4*)(X + ((ps * 2 + 1) * 256 + bj * 128 + x0 + 4 * n)); }
                float outv[4][4];
#pragma unroll
                for (int ep = 0; ep < 2; ++ep) {
                    const int e0 = 2 * ep, e1 = 2 * ep + 1;
                    f32x2 cv[2][4];
#pragma unroll
                    for (int bj = 0; bj < 2; ++bj) {
                        const f32x2 W0 = {w0[bj][e0], w0[bj][e1]}, W1 = {w1[bj][e0], w1[bj][e1]}, W2 = {w2[bj][e0], w2[bj][e1]}, BB = {bb[bj][e0], bb[bj][e1]};
                        float pr1a = P15[bj][e0], pr1b = P15[bj][e1], pr2a = (fr == 0) ? P14[bj][e0] : P15[bj][e0], pr2b = (fr == 0) ? P14[bj][e1] : P15[bj][e1];
#pragma unroll
                        for (int m = 0; m < 4; ++m) { const float ca = acc[ai][bj][m][n][e0], cb = acc[ai][bj][m][n][e1];
                            const f32x2 C = {ca, cb}, U1 = {dpp_shr1(pr1a, ca), dpp_shr1(pr1b, cb)}, U2 = {dpp_shr2(pr2a, ca), dpp_shr2(pr2b, cb)};
                            cv[bj][m] = BB + W0 * U2 + W1 * U1 + W2 * C;
                            if (m < 3) { pr1a = dpp_ror1(ca); pr1b = dpp_ror1(cb); pr2a = dpp_ror2(ca); pr2b = dpp_ror2(cb); } }
                    }
#pragma unroll
                    for (int m = 0; m < 4; ++m) { const f32x2 g = cv[0][m]; const f32x2 k1 = {-2.3022082f, -2.3022082f}, k2 = {-0.10294324f, -0.10294324f}, one = {1.0f, 1.0f};
                        const f32x2 t = g * (k1 + k2 * g * g);
                        const f32x2 ex = {__builtin_amdgcn_exp2f(t.x), __builtin_amdgcn_exp2f(t.y)}; const f32x2 den = one + ex;
                        const f32x2 rc = {__builtin_amdgcn_rcpf(den.x), __builtin_amdgcn_rcpf(den.y)};
                        const f32x2 o2 = g * rc * cv[1][m];
                        outv[m][e0] = o2.x; outv[m][e1] = o2.y; }
                }
#pragma unroll
                for (int m = 0; m < 4; ++m) { const int row = u.pm * BM + ai * HALF + wr * 64 + m * 16 + fr;
                    unsigned lo = cvt_pk_bf16(outv[m][0], outv[m][1]), hi = cvt_pk_bf16(outv[m][2], outv[m][3]);
                    *(unsigned long long*)(ACT + (size_t)row * 11008 + gcol + 4 * n) = (unsigned long long)lo | ((unsigned long long)hi << 32); }
            }
        }
        if (u.pm < 64) {
            if (wr == 0 && fr < 2) { float* d = rawp + (size_t)(u.pm * 4 + 2 + fr) * 22016 + gcol;
#pragma unroll
                for (int bj = 0; bj < 2; ++bj) { *(f32x4*)(d + bj * 11008) = acc[0][bj][0][0]; *(f32x4*)(d + bj * 11008 + 4) = acc[0][bj][0][1]; } }
            if (wr == 1 && fr >= 14) { float* d = (u.pm < 63 ? rawp + (size_t)((u.pm + 1) * 4 + (fr - 14)) * 22016 : cfp + (size_t)(fr - 14) * 22016) + gcol;
#pragma unroll
                for (int bj = 0; bj < 2; ++bj) { *(f32x4*)(d + bj * 11008) = acc[1][bj][3][0]; *(f32x4*)(d + bj * 11008 + 4) = acc[1][bj][3][1]; } }
        } else {
#pragma unroll
            for (int ai = 0; ai < 2; ++ai)
#pragma unroll
                for (int m = 0; m < 4; ++m) { const int rt = ai * HALF + wr * 64 + m * 16 + fr, q = rt & 31, s = ((u.pm - 64) * BM + rt) >> 5; float* d = nullptr;
                    if (q < 2) d = raws + (size_t)(s * 2 + q) * 22016 + gcol; else if (q >= 30) d = cfs + (size_t)(s * 2 + q - 30) * 22016 + gcol;
                    if (d) {
#pragma unroll
                        for (int bj = 0; bj < 2; ++bj) { *(f32x4*)(d + bj * 11008) = acc[ai][bj][m][0]; *(f32x4*)(d + bj * 11008 + 4) = acc[ai][bj][m][1]; } } }
        }
    }
};
template <class Epi, class Sched, bool ALIGN_EPI = false, bool SP2 = false>
__device__ __forceinline__ void gemm_phase(PG8_LAS unsigned char* lds, const Gemm g, const Sched& S, const Epi& E) {
    const int tid = threadIdx.x, wid = __builtin_amdgcn_readfirstlane(tid >> 6), lane = tid & 63, wr = wid >> 2, wc = wid & 3, fr = lane & 15, fq = lane >> 4;
    const int K = g.K, ntf = K / BK;
    unsigned voffA[2], voffB[2];
#pragma unroll
    for (int i = 0; i < 2; ++i) { int R, C; stage_rc(tid * 16 + i * 8192, R, C); const int Rb = Epi::PERM ? ((R & ~31) + perm32(R & 31)) : R;
        voffA[i] = (unsigned)(R * K + C) * 2u; voffB[i] = (unsigned)(Rb * K + C) * 2u; }
    const size_t kstep = (size_t)(BK * 2);
    const size_t hstep = (size_t)HALF * K * 2;
    const size_t tstep = 2 * hstep;
    const unsigned ldsw = (unsigned)wid * 1024u;
    const int aoff = lds_byte(wr * 64 + fr, fq * 8), boff = lds_byte(wc * 32 + fr, fq * 8);
#define PG8_SA(b, h) (((b) * 2 + (h)) * HTB)
#define PG8_SB(b, h) ((4 + (b) * 2 + (h)) * HTB)
#define PG8_STAGE(bufoff, gbase, voff) do { _Pragma("unroll") for (int _i = 0; _i < 2; ++_i) \
        __builtin_amdgcn_global_load_lds((const unsigned*)((const char*)(gbase) + (voff)[_i]), (PG8_LAS unsigned*)(lds + (bufoff) + ldsw + _i * 8192), 16, 0, 0); } while (0)
#define PG8_LDA(dst, b, h) do { _Pragma("unroll") for (int m = 0; m < 4; ++m) _Pragma("unroll") for (int k = 0; k < 2; ++k) dst[m][k] = *(const PG8_LAS bf16x8*)(lds + PG8_SA(b, h) + aoff + m * 2048 + k * 1024); } while (0)
#define PG8_LDB(dst, b, h) do { _Pragma("unroll") for (int n = 0; n < 2; ++n) _Pragma("unroll") for (int k = 0; k < 2; ++k) dst[n][k] = *(const PG8_LAS bf16x8*)(lds + PG8_SB(b, h) + boff + n * 2048 + k * 1024); } while (0)
#define PG8_MMA(ai, bj, At, Bt) do { __builtin_amdgcn_s_setprio(1); _Pragma("unroll") for (int m = 0; m < 4; ++m) _Pragma("unroll") for (int n = 0; n < 2; ++n) _Pragma("unroll") for (int k = 0; k < 2; ++k) \
        acc[ai][bj][m][n] = __builtin_amdgcn_mfma_f32_16x16x32_bf16(Bt[n][k], At[m][k], acc[ai][bj][m][n], 0, 0, 0); __builtin_amdgcn_s_setprio(0); } while (0)
#define PG8_WAIT_V(n) asm volatile("s_waitcnt vmcnt(" #n ")" ::: "memory")
#define PG8_WAIT_L(n) asm volatile("s_waitcnt lgkmcnt(" #n ")" ::: "memory")
#define PG8_BAR __builtin_amdgcn_s_barrier()
#define PG8_SCHED __builtin_amdgcn_sched_barrier(0)
    Unit cur, nxt; int ui = 0;
    if (!S.next(0, cur)) return;
    f32x4 acc[2][2][4][2];
#pragma unroll
    for (int a = 0; a < 2; ++a)
#pragma unroll
        for (int b = 0; b < 2; ++b)
#pragma unroll
            for (int m = 0; m < 4; ++m)
#pragma unroll
                for (int n = 0; n < 2; ++n) acc[a][b][m][n] = (f32x4){0.f, 0.f, 0.f, 0.f};
    bf16x8 At[4][2], B0[2][2], B1[2][2];
    int kt0, nt; S.kslice(cur, ntf, kt0, nt);
    const char* cA = (const char*)g.A + (size_t)cur.pm * tstep + (size_t)kt0 * kstep; const char* cB = (const char*)g.Bt + (size_t)(cur.pn & 255) * tstep + (size_t)kt0 * kstep;
    S.a_ready(cur);
    if constexpr (SP2) {
        PG8_STAGE(PG8_SB(0, 0), cB, voffB); PG8_STAGE(PG8_SB(0, 1), cB + hstep, voffB); PG8_STAGE(PG8_SA(0, 0), cA, voffA); PG8_STAGE(PG8_SA(0, 1), cA + hstep, voffA);
        if (wr == 1) PG8_BAR;
        PG8_WAIT_V(2); PG8_BAR;
        PG8_STAGE(PG8_SB(1, 0), cB + kstep, voffB); PG8_STAGE(PG8_SA(1, 0), cA + kstep, voffA); PG8_STAGE(PG8_SB(1, 1), cB + hstep + kstep, voffB);
        PG8_WAIT_V(6); PG8_BAR;
    } else {
        PG8_STAGE(PG8_SB(0, 0), cB, voffB); PG8_STAGE(PG8_SA(0, 0), cA, voffA); PG8_STAGE(PG8_SB(0, 1), cB + hstep, voffB); PG8_STAGE(PG8_SA(0, 1), cA + hstep, voffA);
        if (wr == 1) PG8_BAR;
        PG8_WAIT_V(4); PG8_BAR;
        PG8_STAGE(PG8_SB(1, 0), cB + kstep, voffB); PG8_STAGE(PG8_SA(1, 0), cA + kstep, voffA); PG8_STAGE(PG8_SB(1, 1), cB + hstep + kstep, voffB);
        PG8_WAIT_V(6); PG8_BAR;
    }
    for (;;) {
        const bool has_next = S.next(ui + 1, nxt);
        int nkt0 = 0, nnt = ntf; if (has_next) S.kslice(nxt, ntf, nkt0, nnt);
        const char* nA = has_next ? (const char*)g.A + (size_t)nxt.pm * tstep + (size_t)nkt0 * kstep : cA; const char* nB = has_next ? (const char*)g.Bt + (size_t)(nxt.pn & 255) * tstep + (size_t)nkt0 * kstep : cB;
        for (int t = 0; t < nt; t += 2) {
            const bool last = (t == nt - 2);
            const char* a1 = cA + (size_t)(t + 1) * kstep;
            const char* a2 = last ? nA : cA + (size_t)(t + 2) * kstep; const char* b2 = last ? nB : cB + (size_t)(t + 2) * kstep;
            const char* a3 = a2 + kstep; const char* b3 = b2 + kstep;
            if (last && has_next) S.a_ready(nxt);
            if constexpr (SP2) {
            PG8_LDB(B0, 0, 0); PG8_LDB(B1, 0, 1); PG8_SCHED; PG8_LDA(At, 0, 0); PG8_STAGE(PG8_SA(1, 1), a1 + hstep, voffA);
            PG8_WAIT_V(8); PG8_WAIT_L(0); PG8_BAR; PG8_MMA(0, 0, At, B0); PG8_MMA(0, 1, At, B1); PG8_BAR; PG8_SCHED;
            PG8_LDA(At, 0, 1); PG8_STAGE(PG8_SB(0, 0), b2, voffB); PG8_STAGE(PG8_SB(0, 1), b2 + hstep, voffB); PG8_STAGE(PG8_SA(0, 0), a2, voffA);
            PG8_WAIT_V(8); PG8_WAIT_L(0); PG8_BAR; PG8_MMA(1, 0, At, B0); PG8_MMA(1, 1, At, B1); PG8_BAR; PG8_SCHED;
            PG8_LDB(B0, 1, 0); PG8_LDB(B1, 1, 1); PG8_SCHED; PG8_LDA(At, 1, 0); PG8_STAGE(PG8_SA(0, 1), a2 + hstep, voffA);
            PG8_WAIT_V(8); PG8_WAIT_L(0); PG8_BAR; PG8_MMA(0, 0, At, B0); PG8_MMA(0, 1, At, B1); PG8_BAR; PG8_SCHED;
            PG8_LDA(At, 1, 1); PG8_STAGE(PG8_SB(1, 0), b3, voffB); PG8_STAGE(PG8_SB(1, 1), b3 + hstep, voffB); PG8_STAGE(PG8_SA(1, 0), a3, voffA);
            PG8_WAIT_V(8); PG8_WAIT_L(0); PG8_BAR; PG8_MMA(1, 0, At, B0); PG8_MMA(1, 1, At, B1); PG8_BAR; PG8_SCHED;
            } else {
            PG8_LDB(B0, 0, 0); PG8_SCHED; PG8_LDA(At, 0, 0); PG8_STAGE(PG8_SA(1, 1), a1 + hstep, voffA);
            PG8_WAIT_L(8); PG8_BAR; PG8_WAIT_L(0); PG8_MMA(0, 0, At, B0); PG8_BAR; PG8_SCHED;
            PG8_LDB(B1, 0, 1); PG8_STAGE(PG8_SB(0, 0), b2, voffB);
            PG8_BAR; PG8_WAIT_L(0); PG8_MMA(0, 1, At, B1); PG8_BAR;
            PG8_LDA(At, 0, 1); PG8_STAGE(PG8_SA(0, 0), a2, voffA);
            PG8_BAR; PG8_WAIT_L(0); PG8_MMA(1, 0, At, B0); PG8_BAR; PG8_SCHED;
            PG8_STAGE(PG8_SB(0, 1), b2 + hstep, voffB);
            PG8_WAIT_V(6); PG8_BAR; PG8_MMA(1, 1, At, B1); PG8_BAR;
            PG8_LDB(B0, 1, 0); PG8_SCHED; PG8_LDA(At, 1, 0); PG8_STAGE(PG8_SA(0, 1), a2 + hstep, voffA);
            PG8_WAIT_L(8); PG8_BAR; PG8_WAIT_L(0); PG8_MMA(0, 0, At, B0); PG8_BAR; PG8_SCHED;
            PG8_LDB(B1, 1, 1); PG8_STAGE(PG8_SB(1, 0), b3, voffB);
            PG8_BAR; PG8_WAIT_L(0); PG8_MMA(0, 1, At, B1); PG8_BAR;
            PG8_LDA(At, 1, 1); PG8_STAGE(PG8_SA(1, 0), a3, voffA);
            PG8_BAR; PG8_WAIT_L(0); PG8_MMA(1, 0, At, B0); PG8_BAR; PG8_SCHED;
            PG8_STAGE(PG8_SB(1, 1), b3 + hstep, voffB);
            PG8_WAIT_V(6); PG8_BAR; PG8_MMA(1, 1, At, B1); PG8_BAR;
            }
        }
        if constexpr (ALIGN_EPI) { if (wr == 0) PG8_BAR; }
        if constexpr (!Epi::AFTER_DRAIN) { E(acc, cur, wr, wc, fr, fq); S.done(cur); }
        if (!has_next) break;
#pragma unroll
        for (int a = 0; a < 2; ++a)
#pragma unroll
            for (int b = 0; b < 2; ++b)
#pragma unroll
                for (int m = 0; m < 4; ++m)
#pragma unroll
                    for (int n = 0; n < 2; ++n) acc[a][b][m][n] = (f32x4){0.f, 0.f, 0.f, 0.f};
        cur = nxt; cA = nA; cB = nB; nt = nnt; ++ui;
        if constexpr (ALIGN_EPI) { if (wr == 1) PG8_BAR; }
    }
    PG8_WAIT_V(0);
    if constexpr (!ALIGN_EPI) { if (wr == 0) PG8_BAR; }
    PG8_BAR;
    if constexpr (Epi::AFTER_DRAIN) { E.fused(acc, cur, wr, wc, fr, fq, lds, wid, lane); S.done(cur); }
#undef PG8_SA
#undef PG8_SB
#undef PG8_STAGE
#undef PG8_LDA
#undef PG8_LDB
#undef PG8_MMA
#undef PG8_WAIT_V
#undef PG8_WAIT_L
#undef PG8_BAR
#undef PG8_SCHED
}
}

constexpr int DM = 4096, SEQ = 16384, NDEC = 16, DSEQ = 32, PAST = 2048, HD = 128, DSB = 2048, NH = 16, DLRU = 2048, NBLK = 16, LBLK = 128;
constexpr int DIN = 10240, DFF = 11008, DFF2 = 22016, NMODC = 6 * DM, NB = 1 + NDEC;
constexpr int M = SEQ + NDEC * DSEQ;
constexpr int NCHUNK = M / 32;
constexpr float EPS = 1e-6f;
constexpr int NWAVES = 8;
constexpr int NPH = 12;

constexpr size_t OUT_Y = 0, OUT_KP = (size_t)M * DM, OUT_VP = OUT_KP + (size_t)SEQ * DSB, OUT_CLP = OUT_VP + (size_t)SEQ * DSB, OUT_LP = OUT_CLP + 3 * DLRU, OUT_CFP = OUT_LP + DLRU,
                 OUT_KS = OUT_CFP + 2 * DFF2, OUT_VS = OUT_KS + (size_t)512 * DSB, OUT_CLS = OUT_VS + (size_t)512 * DSB, OUT_LS = OUT_CLS + NDEC * 3 * DLRU, OUT_CFS = OUT_LS + NDEC * DLRU,
                 OUT_END = OUT_CFS + (size_t)NDEC * 2 * DFF2;
static_assert(OUT_END == 139299840ull, "output size");

constexpr size_t MiB = 1u << 20;
constexpr size_t WS_CTL = 0, CTL_ZERO_BYTES = 1 * MiB;
constexpr size_t WS_GATET = 1 * MiB;
constexpr size_t WS_MOD = 2 * MiB;
constexpr size_t WS_AGGA = 4 * MiB, WS_AGGH = 9 * MiB, WS_CARRY = 14 * MiB;
constexpr size_t WS_WDOWN = 20 * MiB;
constexpr size_t WS_WUP = 106 * MiB;
constexpr size_t WS_WOUT = 278 * MiB;
constexpr size_t WS_ACT = 310 * MiB;
constexpr size_t WS_MIX = 442 * MiB;
constexpr size_t WS_X1 = 574 * MiB;
constexpr size_t WS_R = 706 * MiB;
constexpr size_t WS_WIN = WS_R;
constexpr size_t WS_PROJ = WS_R + 80 * MiB;
constexpr size_t WS_OSB = WS_PROJ + 330 * MiB;
constexpr size_t WS_HP = WS_OSB + 66 * MiB;
constexpr size_t WS_PART = WS_R;
constexpr int KS_OUT = 8, KS_DOWN = 4;
constexpr size_t WS_RAWP = WS_R + 64 * MiB;
constexpr size_t WS_RAWS = WS_R + 88 * MiB;
constexpr size_t WS_ACTF = WS_R + 710 * MiB;
constexpr size_t WS_END = WS_ACTF + 355 * MiB;
static_assert(WS_HP + 132 * MiB <= WS_END && (size_t)M * DFF * 2 <= 355 * MiB && (size_t)M * DIN * 2 <= 330 * MiB, "ws map");
constexpr int CW_BAR = 4096;

constexpr int RING_BYTES = 131072;
constexpr int LDSCTL_OFF = RING_BYTES, MISC_OFF = LDSCTL_OFF + 320;
constexpr int LDS_BYTES = 147456;
constexpr int EXCH_OFF = LDSCTL_OFF + 2048;
static_assert(EXCH_OFF + 8192 <= LDS_BYTES, "lds map");
constexpr int WAVE_LDS = 9216;
constexpr int VROW = 288;
constexpr int XROW = 272;

#define GAS __attribute__((address_space(1)))
#define LAS __attribute__((address_space(3)))
typedef unsigned short bf16;
typedef unsigned v4u __attribute__((ext_vector_type(4)));
typedef unsigned v2u __attribute__((ext_vector_type(2)));
typedef float f32x4 __attribute__((ext_vector_type(4)));
typedef float f32x16 __attribute__((ext_vector_type(16)));
typedef short bf16x8 __attribute__((ext_vector_type(8)));
typedef short s16x4 __attribute__((ext_vector_type(4)));
typedef GAS unsigned gu32;
#define RLX_AGENT __ATOMIC_RELAXED, __HIP_MEMORY_SCOPE_AGENT
#define LDS_WAIT() asm volatile("s_waitcnt lgkmcnt(0)" ::: "memory")
__device__ __forceinline__ unsigned f2bf(float f) { unsigned u = __builtin_bit_cast(unsigned, f); return (u + 0x7fffu + ((u >> 16) & 1u)) >> 16; }
__device__ __forceinline__ unsigned pk2(float lo, float hi) { typedef float f2_t __attribute__((ext_vector_type(2))); typedef __bf16 b2_t __attribute__((ext_vector_type(2))); f2_t v = {lo, hi}; b2_t b = __builtin_convertvector(v, b2_t); return __builtin_bit_cast(unsigned, b); }
__device__ __forceinline__ float bf_lo(unsigned w) { return __builtin_bit_cast(float, w << 16); }
__device__ __forceinline__ float bf_hi(unsigned w) { return __builtin_bit_cast(float, w & 0xffff0000u); }
__device__ __forceinline__ float fexp2(float x) { return __builtin_amdgcn_exp2f(x); }
__device__ __forceinline__ float flog2(float x) { return __builtin_amdgcn_logf(x); }
__device__ __forceinline__ float frcp(float x) { return __builtin_amdgcn_rcpf(x); }
__device__ __forceinline__ float fsqrt(float x) { return __builtin_amdgcn_sqrtf(x); }
__device__ __forceinline__ float sigmoidf_(float x) { return frcp(1.0f + fexp2(-1.4426950408889634f * x)); }
__device__ __forceinline__ float gelu_tanh(float x) { return x * frcp(1.0f + fexp2(x * (-2.3022082f - 0.10294324f * x * x))); }
__device__ __forceinline__ float wave_sum(float v) {
#pragma unroll
    for (int o = 1; o < 64; o <<= 1) v += __shfl_xor(v, o);
    return v;
}
#define XB_TMO      128
#define XB_XCNT(j)  (256  + 64 * (j))
#define XB_XSUB(j)  (1280 + 64 * (j))
#define XB_XGEN(j)  (2304 + 64 * (j))
#define XB_TOP      3328
#define XB_TOPGEN   3392
#define XCD_BAR_WORDS 3456
#define XB_SPIN_CAP (1u << 18)

__device__ __forceinline__ unsigned xb_ld(unsigned* p)              { return __hip_atomic_load(p, __ATOMIC_RELAXED, __HIP_MEMORY_SCOPE_AGENT); }
__device__ __forceinline__ unsigned xb_add(unsigned* p, unsigned v) { return __hip_atomic_fetch_add(p, v, __ATOMIC_RELAXED, __HIP_MEMORY_SCOPE_AGENT); }
__device__ __forceinline__ unsigned xb_xcc_id() { return (unsigned)__builtin_amdgcn_s_getreg((3 << 11) | 20) & 0xFu; }
#define XB_SPIN(cond, bar) do { unsigned _sp = 0; while (cond) { __builtin_amdgcn_s_sleep(1); \
    if ((++_sp & 255u) == 0u) { if (xb_ld(&(bar)[XB_TMO])) break; if (_sp > XB_SPIN_CAP) { atomicAdd(&(bar)[XB_TMO], 1u); break; } } } } while (0)

struct XcdBarrier {
    unsigned* bar; unsigned x;
    volatile LAS unsigned* st;
};

__device__ __forceinline__ XcdBarrier xcd_barrier_post(unsigned* bar, volatile LAS unsigned* st) {
    XcdBarrier b; b.bar = bar; b.x = xb_xcc_id(); b.st = st;
    if (threadIdx.x == 0) (void)xb_add(&bar[XB_XCNT(b.x)], 1u);
    return b;
}
__device__ __forceinline__ void xcd_barrier_complete(unsigned* bar, unsigned x, unsigned& nloc, unsigned& nx) {
    const unsigned G = gridDim.x * gridDim.y * gridDim.z;
    unsigned sum, cnt, mine, sp = 0u;
    for (;;) {
        sum = 0u; cnt = 0u; mine = 0u;
#pragma unroll
        for (unsigned j = 0; j < 16; ++j) { const unsigned c = xb_ld(&bar[XB_XCNT(j)]); sum += c; cnt += (c > 0u) ? 1u : 0u; mine = (j == x) ? c : mine; }
        if (sum == G) break;
        __builtin_amdgcn_s_sleep(1);
        if ((++sp & 255u) == 0u) { if (xb_ld(&bar[XB_TMO])) break; if (sp > XB_SPIN_CAP) { atomicAdd(&bar[XB_TMO], 1u); break; } }
    }
    nloc = mine > 0u ? mine : 1u; nx = cnt > 0u ? cnt : 1u;
}

__device__ __forceinline__ void xcd_barrier(const XcdBarrier& b) {
    asm volatile("s_waitcnt vmcnt(0)" ::: "memory");
    __syncthreads();
    if (threadIdx.x == 0) {
        unsigned* bar = b.bar;
        __builtin_amdgcn_s_waitcnt(0);
        unsigned nloc = b.st[0], nx = b.st[1];
        if (nloc == 0u) { xcd_barrier_complete(bar, b.x, nloc, nx); b.st[0] = nloc; b.st[1] = nx; }
        const unsigned old = xb_add(&bar[XB_XSUB(b.x)], 1u);
        const unsigned gen = old / nloc;
        if (old + 1u == (gen + 1u) * nloc) {
            __builtin_amdgcn_fence(__ATOMIC_RELEASE, "agent");
            asm volatile("s_waitcnt vmcnt(0)" ::: "memory");
            const unsigned og = xb_add(&bar[XB_TOP], 1u);
            const unsigned tg = og / nx;
            if (og + 1u == (tg + 1u) * nx) xb_add(&bar[XB_TOPGEN], 1u);
            else XB_SPIN(xb_ld(&bar[XB_TOPGEN]) == tg, bar);
            __builtin_amdgcn_fence(__ATOMIC_ACQUIRE, "agent");
            xb_add(&bar[XB_XGEN(b.x)], 1u);
            asm volatile("s_waitcnt vmcnt(0)" ::: "memory");
        } else {
            XB_SPIN(xb_ld(&bar[XB_XGEN(b.x)]) == gen, bar);
            __builtin_amdgcn_fence(__ATOMIC_ACQUIRE, "agent");
            asm volatile("s_waitcnt vmcnt(0)" ::: "memory");
        }
    }
    __syncthreads();
}

enum InIdx { I_XP = 0, I_XS, I_CP, I_CS, I_CK, I_CV, I_SCL, I_SL, I_SCF, I_WADA, I_BADA, I_GPM, I_WIN, I_WCL, I_BCL, I_WGA, I_BGA, I_WGX, I_BGX, I_LAM, I_GGA, I_GGL,
             I_WOUT, I_GPOM, I_GPF, I_WUP, I_WCF, I_BCF, I_WDOWN, I_GPOF, N_IN };
struct Args { const float* in[N_IN]; float* out; unsigned char* ws; int ph_lo, ph_hi, li, pad; };
typedef const __attribute__((address_space(4))) Args KArgs;
struct Frame {
    LAS unsigned char* lds;
    volatile LAS unsigned* MISC;
    gu32* ctl;
    int tid, lane, wave, vcu, G;
};
__device__ __forceinline__ const float* xrow_of(KArgs& A, int m) { return m < SEQ ? A.in[I_XP] + (size_t)m * DM : A.in[I_XS] + (size_t)(m - SEQ) * DM; }
__device__ __forceinline__ int modrow_of(int m) { return m < SEQ ? 0 : 1 + ((m - SEQ) >> 5); }

template <bool UPMAP = false>
__device__ __forceinline__ void p0_transpose_item(const float* W, int K, int N, bf16* WT, LAS float* scr, int item, int lane) {
    const int nblk = N / 32, kb = item / nblk, nb = item % nblk, k0 = 64 * kb, n0 = 32 * nb;
    const int d0 = UPMAP ? (n0 < DFF ? (n0 >> 7) * 256 + (n0 & 127) : ((n0 - DFF) >> 7) * 256 + 128 + ((n0 - DFF) & 127)) : n0;
    float t[32];
    const float* wp = W + (size_t)(k0 + (lane >> 5)) * N + n0 + (lane & 31);
#pragma unroll
    for (int i = 0; i < 32; ++i) t[i] = wp[(size_t)(2 * i) * N];
#pragma unroll
    for (int i = 0; i < 32; ++i) scr[(2 * i + (lane >> 5)) * 33 + (lane & 31)] = t[i];
    LDS_WAIT(); asm volatile("" ::: "memory");
    const int c = lane & 7;
#pragma unroll
    for (int j = 0; j < 4; ++j) { const int n = (lane >> 3) + 8 * j; const LAS float* s = scr + (8 * c) * 33 + n;
        v4u o; o.x = pk2(s[0 * 33], s[1 * 33]); o.y = pk2(s[2 * 33], s[3 * 33]); o.z = pk2(s[4 * 33], s[5 * 33]); o.w = pk2(s[6 * 33], s[7 * 33]);
        *(GAS v4u*)(WT + (size_t)(d0 + n) * K + k0 + 8 * c) = o; }
    LDS_WAIT(); asm volatile("" ::: "memory");
}
constexpr int IT_UP = (DM / 64) * (DFF2 / 32), IT_DOWN = (DFF / 64) * (DM / 32);
constexpr int IT_DOWN_TAIL = 22016;
constexpr int IT_UP_TAIL = 44032;
template <bool UPMAP>
__device__ __forceinline__ void tail_convert(Frame& F, const float* W, int K, int N, bf16* WT, int nitems, int nunits) {
    const int G = F.G, c = (int)blockIdx.x, rounds = (nunits + G - 1) / G, nlast = nunits - (rounds - 1) * G;
    const bool all = (nlast == G); if (!all && c < nlast) return;
    const int nidle = all ? G : G - nlast, ii = (all ? c : c - nlast) * NWAVES + F.wave;
    LAS float* scr = (LAS float*)(F.lds + F.wave * 16384);
    for (int it = ii; it < nitems; it += nidle * NWAVES) p0_transpose_item<UPMAP>(W, K, N, WT, scr, it, F.lane);
}
__device__ __forceinline__ void p0_prologue(Frame& F, KArgs& A) {
    unsigned char* ws = A.ws;
    LAS float* scr = (LAS float*)(F.lds + F.wave * 16384);
    const int gw = F.vcu * NWAVES + F.wave, NGW = F.G * NWAVES;
    constexpr int IT_IN = (DM / 64) * (DIN / 32), IT_OUT = (DM / 64) * (DM / 32), IT_G = 2 * NBLK * 8;
    constexpr int NITEMS = IT_IN + IT_OUT + IT_G + (IT_UP - IT_UP_TAIL) + (IT_DOWN - IT_DOWN_TAIL);
    for (int it = gw; it < NITEMS; it += NGW) {
        int r = it;
        if (r < IT_IN) { p0_transpose_item(A.in[I_WIN], DM, DIN, (bf16*)(ws + WS_WIN), scr, r, F.lane); continue; } r -= IT_IN;
        if (r < IT_OUT) { p0_transpose_item(A.in[I_WOUT], DM, DM, (bf16*)(ws + WS_WOUT), scr, r, F.lane); continue; } r -= IT_OUT;
        if (r < IT_G) { const int gb = r >> 3, sub = r & 7;
          const float* Wg = (gb < NBLK ? A.in[I_WGA] : A.in[I_WGX]) + (size_t)(gb & 15) * LBLK * LBLK;
          p0_transpose_item(Wg, LBLK, LBLK, (bf16*)(ws + WS_GATET) + (size_t)gb * LBLK * LBLK, scr, sub, F.lane); continue; } r -= IT_G;
        if (r < IT_UP - IT_UP_TAIL) { p0_transpose_item<true>(A.in[I_WUP], DM, DFF2, (bf16*)(ws + WS_WUP), scr, IT_UP_TAIL + r, F.lane); continue; } r -= IT_UP - IT_UP_TAIL;
        p0_transpose_item(A.in[I_WDOWN], DFF, DM, (bf16*)(ws + WS_WDOWN), scr, IT_DOWN_TAIL + r, F.lane);
    }
    __syncthreads();
    float* MOD = (float*)(ws + WS_MOD);
    LAS float* RED = (LAS float*)F.lds;
    const int jj = F.lane & 15, kh = F.lane >> 4;
    typedef float f32x2v __attribute__((ext_vector_type(2)));
    for (int strip = F.vcu; strip < NMODC / 96; strip += F.G) {
        const int col0 = strip * 96;
        const float* wp = A.in[I_WADA] + (size_t)(512 * F.wave + kh) * NMODC + col0 + 6 * jj;
        const float* cs = A.in[I_CS] + (size_t)jj * DM + 512 * F.wave + kh;
        const float* cp = A.in[I_CP] + 512 * F.wave + kh;
        f32x4 acc[6]; float a0[6];
#pragma unroll
        for (int g = 0; g < 6; ++g) { acc[g] = (f32x4){0.f, 0.f, 0.f, 0.f}; a0[g] = 0.f; }
#pragma unroll 4
        for (int st = 0; st < 128; ++st) {
            const float* wr = wp + (size_t)(4 * st) * NMODC;
            const f32x2v w01 = *(const f32x2v*)wr, w23 = *(const f32x2v*)(wr + 2), wb = *(const f32x2v*)(wr + 4); const f32x4 wa = (f32x4){w01.x, w01.y, w23.x, w23.y};
            const float cv = cs[4 * st], c0 = cp[4 * st];
            const float sv = cv * sigmoidf_(cv), s0 = c0 * sigmoidf_(c0);
            acc[0] = __builtin_amdgcn_mfma_f32_16x16x4f32(sv, wa.x, acc[0], 0, 0, 0); acc[1] = __builtin_amdgcn_mfma_f32_16x16x4f32(sv, wa.y, acc[1], 0, 0, 0);
            acc[2] = __builtin_amdgcn_mfma_f32_16x16x4f32(sv, wa.z, acc[2], 0, 0, 0); acc[3] = __builtin_amdgcn_mfma_f32_16x16x4f32(sv, wa.w, acc[3], 0, 0, 0);
            acc[4] = __builtin_amdgcn_mfma_f32_16x16x4f32(sv, wb.x, acc[4], 0, 0, 0); acc[5] = __builtin_amdgcn_mfma_f32_16x16x4f32(sv, wb.y, acc[5], 0, 0, 0);
            a0[0] += s0 * wa.x; a0[1] += s0 * wa.y; a0[2] += s0 * wa.z; a0[3] += s0 * wa.w; a0[4] += s0 * wb.x; a0[5] += s0 * wb.y;
        }
#pragma unroll
        for (int g = 0; g < 6; ++g) { a0[g] += __shfl_xor(a0[g], 16); a0[g] += __shfl_xor(a0[g], 32); }
        LAS float* rw = RED + (size_t)F.wave * NB * 96;
#pragma unroll
        for (int g = 0; g < 6; ++g) {
#pragma unroll
            for (int rg = 0; rg < 4; ++rg) rw[(1 + 4 * kh + rg) * 96 + 6 * jj + g] = acc[g][rg];
            if (kh == 0) rw[6 * jj + g] = a0[g]; }
        __syncthreads();
        for (int idx = F.tid; idx < NB * 96; idx += 512) { float t = 0.f;
#pragma unroll
            for (int w = 0; w < NWAVES; ++w) t += RED[w * NB * 96 + idx];
            const int bb = idx / 96, c = idx % 96; MOD[(size_t)bb * NMODC + col0 + c] = t + A.in[I_BADA][col0 + c]; }
        __syncthreads();
    }
}

template <bool PROMPT>
__device__ __forceinline__ void p1_row(Frame& F, KArgs& A, int m, const LAS f32x4* LA, const LAS f32x4* LC) {
    const float* MOD = (const float*)(A.ws + WS_MOD); bf16* H = (bf16*)(A.ws + WS_ACT);
    const f32x4* xr = (const f32x4*)xrow_of(A, m) + F.lane;
    f32x4 v[16]; float ss = 0.f;
#pragma unroll
    for (int j = 0; j < 16; ++j) { v[j] = __builtin_nontemporal_load(xr + 64 * j); ss += (v[j].x * v[j].x + v[j].y * v[j].y) + (v[j].z * v[j].z + v[j].w * v[j].w); }
    const float rstd = 1.0f / sqrtf(wave_sum(ss) * (1.0f / DM) + EPS);
    v2u* o = (v2u*)(H + (size_t)m * DM) + F.lane;
    if (PROMPT) {
#pragma unroll
        for (int j = 0; j < 16; ++j) { const f32x4 y = v[j] * rstd * LA[F.lane + 64 * j] + LC[F.lane + 64 * j]; v2u w; w.x = pk2(y.x, y.y); w.y = pk2(y.z, y.w); __builtin_nontemporal_store(w, o + 64 * j); if ((j & 3) == 3) asm volatile("" ::: "memory"); }
    } else {
        const f32x4* g4 = (const f32x4*)A.in[I_GPM] + F.lane;
        const float* mr = MOD + (size_t)modrow_of(m) * NMODC; const f32x4* sh4 = (const f32x4*)mr + F.lane; const f32x4* sc4 = (const f32x4*)(mr + DM) + F.lane;
#pragma unroll
        for (int j = 0; j < 16; ++j) { const f32x4 g = g4[64 * j], sc = sc4[64 * j], sh = sh4[64 * j];
            const f32x4 y = v[j] * rstd * g * (1.0f + sc) + sh; v2u w; w.x = pk2(y.x, y.y); w.y = pk2(y.z, y.w); __builtin_nontemporal_store(w, o + 64 * j); }
    }
}
__device__ __forceinline__ void p1_load(KArgs& A, int m, int lane, f32x4 (&v)[16]) {
    const f32x4* xr = (const f32x4*)xrow_of(A, m) + lane;
#pragma unroll
    for (int j = 0; j < 16; ++j) v[j] = __builtin_nontemporal_load(xr + 64 * j);
}
__device__ __forceinline__ void p1_proc(Frame& F, KArgs& A, int m, const f32x4 (&v)[16], const LAS f32x4* LA, const LAS f32x4* LC) {
    float ss = 0.f;
#pragma unroll
    for (int j = 0; j < 16; ++j) ss += (v[j].x * v[j].x + v[j].y * v[j].y) + (v[j].z * v[j].z + v[j].w * v[j].w);
    const float rstd = 1.0f / sqrtf(wave_sum(ss) * (1.0f / DM) + EPS);
    v2u* o = (v2u*)((bf16*)(A.ws + WS_ACT) + (size_t)m * DM) + F.lane;
#pragma unroll
    for (int j = 0; j < 16; ++j) { const f32x4 y = v[j] * rstd * LA[F.lane + 64 * j] + LC[F.lane + 64 * j]; v2u w; w.x = pk2(y.x, y.y); w.y = pk2(y.z, y.w); __builtin_nontemporal_store(w, o + 64 * j); if ((j & 3) == 3) asm volatile("" ::: "memory"); }
}
__device__ __forceinline__ void wg_sum2(Frame& F, float a, float b, LAS float* red, float& ta, float& tb) {
    a = wave_sum(a); b = wave_sum(b);
    if (F.lane == 0) { red[F.wave] = a; red[8 + F.wave] = b; }
    __syncthreads();
    ta = 0.f; tb = 0.f;
#pragma unroll
    for (int w = 0; w < NWAVES; ++w) { ta += red[w]; tb += red[8 + w]; }
}
__device__ __forceinline__ void p1_samples(Frame& F, KArgs& A) {
    LAS float* red = (LAS float*)(F.lds + 65536);
    const float* MOD = (const float*)(A.ws + WS_MOD);
    const int cb = 128 * F.wave + F.lane;
#pragma unroll 1
    for (int j = 0; F.vcu + j * F.G < M - SEQ; j += 2) {
        const int sra = F.vcu + j * F.G, srb_ = sra + F.G; const bool hasb = srb_ < M - SEQ; const int srb = hasb ? srb_ : sra;
        const int sr[2] = {sra, srb};
        f32x4 v[2][2]; float s0 = 0.f, s1 = 0.f;
#pragma unroll
        for (int r = 0; r < 2; ++r)
#pragma unroll
            for (int q = 0; q < 2; ++q) { v[r][q] = ((const f32x4*)(A.in[I_XS] + (size_t)sr[r] * DM))[cb + 64 * q];
                const float e = (v[r][q].x * v[r][q].x + v[r][q].y * v[r][q].y) + (v[r][q].z * v[r][q].z + v[r][q].w * v[r][q].w); if (r == 0) s0 += e; else s1 += e; }
        float t0, t1; wg_sum2(F, s0, s1, red, t0, t1);
        const float rstd[2] = {1.0f / sqrtf(t0 * (1.0f / DM) + EPS), 1.0f / sqrtf(t1 * (1.0f / DM) + EPS)};
#pragma unroll
        for (int r = 0; r < 2; ++r) { const float* mo = MOD + (size_t)(1 + (sr[r] >> 5)) * NMODC;
#pragma unroll
            for (int q = 0; q < 2; ++q) { const int ci = cb + 64 * q;
                const f32x4 y = v[r][q] * rstd[r] * ((const f32x4*)A.in[I_GPM])[ci] * (1.0f + ((const f32x4*)(mo + DM))[ci]) + ((const f32x4*)mo)[ci];
                if (r == 0 || hasb) { v2u w; w.x = pk2(y.x, y.y); w.y = pk2(y.z, y.w); ((v2u*)((bf16*)(A.ws + WS_ACT) + (size_t)(SEQ + sr[r]) * DM))[ci] = w; } } }
        __syncthreads();
    }
}
__device__ __forceinline__ void p1_h1(Frame& F, KArgs& A) {
    const int gw = F.vcu * NWAVES + F.wave, NGW = F.G * NWAVES;
    const float* MOD = (const float*)(A.ws + WS_MOD);
    LAS f32x4* LA = (LAS f32x4*)F.lds; LAS f32x4* LC = LA + DM / 4;
    for (int i = F.tid; i < DM / 4; i += NWAVES * 64) { const f32x4 g = ((const f32x4*)A.in[I_GPM])[i], sh = ((const f32x4*)MOD)[i], sc = ((const f32x4*)(MOD + DM))[i]; LA[i] = g * (1.0f + sc); LC[i] = sh; }
    __syncthreads();
    { f32x4 va[16], vb[16]; int m = gw;
      if (m < SEQ) p1_load(A, m, F.lane, va);
#pragma unroll 1
      for (; m < SEQ; m += 2 * NGW) {
          if (m + NGW < SEQ) p1_load(A, m + NGW, F.lane, vb);
          p1_proc(F, A, m, va, LA, LC);
          if (m + NGW < SEQ) { if (m + 2 * NGW < SEQ) p1_load(A, m + 2 * NGW, F.lane, va); p1_proc(F, A, m + NGW, vb, LA, LC); }
      } }
    p1_samples(F, A);
}

__device__ __forceinline__ void lru_unit(Frame& F, KArgs& A, int blk, int c, LAS unsigned char* wl, const LAS unsigned char* gw_lds) {
    const int lane = F.lane, r = lane & 31, h = lane >> 5;
    const int row0 = 32 * c;
    const bf16* PROJ = (const bf16*)(A.ws + WS_PROJ);
    {
        const int cg = lane & 31, th = lane >> 5, chg = blk * LBLK + 4 * cg;
        const bf16* xp = PROJ + (size_t)row0 * DIN + 6144 + chg;
        const int t0 = 16 * th;
        v2u cur[16];
#pragma unroll
        for (int i = 0; i < 16; ++i) cur[i] = *(const v2u*)(xp + (size_t)(t0 + i) * DIN);
        f32x4 x3, x2, x1;
        if (th == 1 || (c > 0 && c < 512)) {
            const v2u a = *(const v2u*)(xp + (ptrdiff_t)(t0 - 3) * DIN), b = *(const v2u*)(xp + (ptrdiff_t)(t0 - 2) * DIN), d = *(const v2u*)(xp + (ptrdiff_t)(t0 - 1) * DIN);
            x3 = (f32x4){bf_lo(a.x), bf_hi(a.x), bf_lo(a.y), bf_hi(a.y)}; x2 = (f32x4){bf_lo(b.x), bf_hi(b.x), bf_lo(b.y), bf_hi(b.y)}; x1 = (f32x4){bf_lo(d.x), bf_hi(d.x), bf_lo(d.y), bf_hi(d.y)};
        } else if (c == 0) { x3 = x2 = x1 = (f32x4){0.f, 0.f, 0.f, 0.f}; }
        else { const float* st = A.in[I_SCL] + (size_t)(c - 512) * 3 * DLRU + chg;
            x3 = *(const f32x4*)(st); x2 = *(const f32x4*)(st + DLRU); x1 = *(const f32x4*)(st + 2 * DLRU); }
        const f32x4 w0 = *(const f32x4*)(A.in[I_WCL] + 0 * DLRU + chg), w1 = *(const f32x4*)(A.in[I_WCL] + 1 * DLRU + chg), w2 = *(const f32x4*)(A.in[I_WCL] + 2 * DLRU + chg),
                    w3 = *(const f32x4*)(A.in[I_WCL] + 3 * DLRU + chg), bb = *(const f32x4*)(A.in[I_BCL] + chg);
#pragma unroll
        for (int i = 0; i < 16; ++i) { const int t = t0 + i; const v2u a = cur[i];
            const f32x4 x0 = (f32x4){bf_lo(a.x), bf_hi(a.x), bf_lo(a.y), bf_hi(a.y)};
            const f32x4 y = bb + w3 * x0 + w2 * x1 + w1 * x2 + w0 * x3;
            v2u o; o.x = pk2(y.x, y.y); o.y = pk2(y.z, y.w); *(LAS v2u*)(wl + t * XROW + 8 * cg) = o;
            x3 = x2; x2 = x1; x1 = x0; }
    }
    LDS_WAIT(); asm volatile("" ::: "memory");
    bf16x8 af[8];
#pragma unroll
    for (int kk = 0; kk < 8; ++kk) af[kk] = *(const LAS bf16x8*)(wl + r * XROW + (16 * kk + 8 * h) * 2);
    unsigned* HP = (unsigned*)(A.ws + WS_HP);
#pragma unroll 1
    for (int nt = 0; nt < 4; ++nt) {
        const int dl = 32 * nt + r, ch = blk * LBLK + dl;
        const float bga = A.in[I_BGA][ch], bgx = A.in[I_BGX][ch], lam = A.in[I_LAM][ch];
        f32x16 ga, gx;
#pragma unroll
        for (int i = 0; i < 16; ++i) { ga[i] = 0.f; gx[i] = 0.f; }
#pragma unroll
        for (int kk = 0; kk < 8; ++kk) { const int off = dl * 256 + (((2 * kk + h) ^ (dl & 15)) << 4);
            const bf16x8 fa = *(const LAS bf16x8*)(gw_lds + off), fx = *(const LAS bf16x8*)(gw_lds + 32768 + off);
            ga = __builtin_amdgcn_mfma_f32_32x32x16_bf16(af[kk], fa, ga, 0, 0, 0); gx = __builtin_amdgcn_mfma_f32_32x32x16_bf16(af[kk], fx, gx, 0, 0, 0); }
        const float spl8 = 8.0f * (fmaxf(-lam, 0.f) + 0.6931471805599453f * flog2(1.0f + fexp2(-1.4426950408889634f * fabsf(lam))));
#pragma unroll
        for (int i = 0; i < 16; ++i) { const int t = (i & 3) + 8 * (i >> 2) + 4 * h;
            const float xc = __builtin_bit_cast(float, (unsigned)(*(const LAS unsigned short*)(wl + t * XROW + 2 * dl)) << 16);
            const float rg = sigmoidf_(ga[i] + bga), ig = sigmoidf_(gx[i] + bgx);
            const float la = -rg * spl8, x2 = 2.0f * la, av = fexp2(1.4426950408889634f * la);
            const float om = (x2 > -0.125f) ? -x2 * (1.0f + x2 * (0.5f + x2 * (0.16666667f + x2 * (0.041666668f + x2 * 0.0083333338f)))) : 1.0f - av * av;
            ga[i] = av; gx[i] = fsqrt(om) * (ig * xc); }
        float TH[4], TP[4], OH[4], OP[4];
#pragma unroll
        for (int a = 0; a < 4; ++a) { float hl = 0.f, pl = 1.f;
#pragma unroll
            for (int e = 0; e < 4; ++e) { hl = ga[4 * a + e] * hl + gx[4 * a + e]; pl = pl * ga[4 * a + e]; gx[4 * a + e] = hl; ga[4 * a + e] = pl; }
            TH[a] = hl; TP[a] = pl; }
#pragma unroll
        for (int a = 0; a < 4; ++a) { OH[a] = __shfl_xor(TH[a], 32); OP[a] = __shfl_xor(TP[a], 32); }
        float hs = 0.f, pc = 1.f, cH[4], cP[4];
#pragma unroll
        for (int a = 0; a < 4; ++a) {
            const float eH = h ? OH[a] : TH[a], eP = h ? OP[a] : TP[a], oH = h ? TH[a] : OH[a], oP = h ? TP[a] : OP[a];
            const float h1 = eP * hs + eH, p1 = pc * eP;
            cH[a] = h ? h1 : hs; cP[a] = h ? p1 : pc;
            hs = oP * h1 + oH; pc = p1 * oP; }
#pragma unroll
        for (int a = 0; a < 4; ++a)
#pragma unroll
            for (int e = 0; e < 4; ++e) { gx[4 * a + e] = gx[4 * a + e] + ga[4 * a + e] * cH[a]; ga[4 * a + e] = ga[4 * a + e] * cP[a]; }
#pragma unroll
        for (int i = 0; i < 16; ++i) { const int t = (i & 3) + 8 * (i >> 2) + 4 * h; HP[(size_t)(row0 + t) * DLRU + ch] = pk2(gx[i], ga[i]); }
        if (h == 0) { ((float*)(A.ws + WS_AGGH))[(size_t)c * DLRU + ch] = hs; ((float*)(A.ws + WS_AGGA))[(size_t)c * DLRU + ch] = pc; }
    }
    LDS_WAIT(); asm volatile("" ::: "memory");
}

__device__ __forceinline__ s16x4 vtr(const LAS unsigned char* p) { typedef short v4i16_t __attribute__((ext_vector_type(4))); return __builtin_bit_cast(s16x4, __builtin_amdgcn_ds_read_tr16_b64_v4i16((LAS v4i16_t*)p)); }
__device__ __forceinline__ unsigned cvtpk(float lo, float hi) { return pk2(lo, hi); }
__device__ __forceinline__ f32x16 sb_qk(const bf16x8 (&kf)[8], const bf16x8 (&qf)[8]) {
    f32x16 s;
#pragma unroll
    for (int i = 0; i < 16; ++i) s[i] = 0.f;
#pragma unroll
    for (int kk = 0; kk < 8; ++kk) s = __builtin_amdgcn_mfma_f32_32x32x16_bf16(kf[kk], qf[kk], s, 0, 0, 0);
    return s;
}
template <bool DIAG>
__device__ __forceinline__ void sb_block(const f32x16& s, f32x16 (&o)[4], float& R, const LAS unsigned char* vl, int lane) {
    const int r = lane & 31, h = lane >> 5;
    float lb[16], lk[16];
#pragma unroll
    for (int i = 0; i < 16; ++i) { const float z = s[i] * 0.12751743082459868f;
        const float sp = fmaxf(-z, 0.f) + flog2(1.0f + fexp2(-fabsf(z)));
        lb[i] = -sp; lk[i] = -sp - z;
        if (DIAG) { const int key = (i & 3) + 8 * (i >> 2) + 4 * h; if (!(key < r)) lk[i] = 0.f; } }
    float p[16], tot[4], oth[4];
#pragma unroll
    for (int a = 0; a < 4; ++a) { p[4 * a + 3] = 0.f; p[4 * a + 2] = lk[4 * a + 3]; p[4 * a + 1] = p[4 * a + 2] + lk[4 * a + 2]; p[4 * a] = p[4 * a + 1] + lk[4 * a + 1]; tot[a] = p[4 * a] + lk[4 * a]; }
#pragma unroll
    for (int a = 0; a < 4; ++a) oth[a] = __shfl_xor(tot[a], 32);
    float E[4], Od[4];
#pragma unroll
    for (int a = 0; a < 4; ++a) { E[a] = h ? oth[a] : tot[a]; Od[a] = h ? tot[a] : oth[a]; }
    float suf[8]; suf[7] = 0.f; suf[6] = Od[3]; suf[5] = suf[6] + E[3]; suf[4] = suf[5] + Od[2]; suf[3] = suf[4] + E[2]; suf[2] = suf[3] + Od[1]; suf[1] = suf[2] + E[1]; suf[0] = suf[1] + Od[0];
    const float total = suf[0] + E[0];
    float w[16];
#pragma unroll
    for (int a = 0; a < 4; ++a) { const float off = R + (h ? suf[2 * a + 1] : suf[2 * a]);
#pragma unroll
        for (int e = 0; e < 4; ++e) { const int i = 4 * a + e; float x = fexp2(lb[i] + off + p[i]);
            if (DIAG) { const int key = e + 8 * a + 4 * h; if (!(key < r)) x = 0.f; }
            w[i] = x; } }
    R += total;
    const int i16 = lane & 15, q = i16 >> 2, pp = i16 & 3, rb = (lane >> 4) & 1;
#pragma unroll
    for (int st = 0; st < 2; ++st) {
        v4u pa; pa.x = cvtpk(w[8 * st], w[8 * st + 1]); pa.y = cvtpk(w[8 * st + 2], w[8 * st + 3]); pa.z = cvtpk(w[8 * st + 4], w[8 * st + 5]); pa.w = cvtpk(w[8 * st + 6], w[8 * st + 7]);
        const bf16x8 wa = __builtin_bit_cast(bf16x8, pa);
        const LAS unsigned char* vb = vl + (16 * st + 4 * h + q) * VROW + (16 * rb + 4 * pp) * 2;
#pragma unroll
        for (int d2 = 0; d2 < 2; ++d2) {
            const s16x4 lo0 = vtr(vb + 128 * d2), hi0 = vtr(vb + 8 * VROW + 128 * d2), lo1 = vtr(vb + 128 * d2 + 64), hi1 = vtr(vb + 8 * VROW + 128 * d2 + 64);
            const bf16x8 f0 = __builtin_shufflevector(lo0, hi0, 0, 1, 2, 3, 4, 5, 6, 7), f1 = __builtin_shufflevector(lo1, hi1, 0, 1, 2, 3, 4, 5, 6, 7);
            __builtin_amdgcn_sched_barrier(0);
            o[2 * d2] = __builtin_amdgcn_mfma_f32_32x32x16_bf16(wa, f0, o[2 * d2], 0, 0, 0); o[2 * d2 + 1] = __builtin_amdgcn_mfma_f32_32x32x16_bf16(wa, f1, o[2 * d2 + 1], 0, 0, 0); }
    }
}
__device__ __forceinline__ void attn_load_kv(KArgs& A, const bf16* PROJ, int sb, int head, int qrow0, int j, int lane, v4u (&kr)[8], v4u (&vv)[8]) {
    const int vrow = lane >> 4, vch = lane & 15;
    if (sb < 0 || j == 0) {
        const int krow0 = qrow0 - 32 * j;
        const bf16* kp = PROJ + (size_t)(krow0 + vrow) * DIN + DSB + head * HD + 8 * vch;
#pragma unroll
        for (int i = 0; i < 8; ++i) kr[i] = *(const v4u*)(kp + (size_t)(4 * i) * DIN);
        const bf16* vp = kp + DSB;
#pragma unroll
        for (int i = 0; i < 8; ++i) vv[i] = *(const v4u*)(vp + (size_t)(4 * i) * DIN);
    } else {
        const int pos0 = PAST - 32 * j;
        const size_t off = (((size_t)sb * PAST + pos0 + vrow) * NH + head) * HD + 8 * vch;
        const float* kp = A.in[I_CK] + off;
#pragma unroll
        for (int i = 0; i < 8; ++i) { const float* k = kp + (size_t)(4 * i) * NH * HD; const f32x4 a = *(const f32x4*)k, b = *(const f32x4*)(k + 4);
            v4u t; t.x = pk2(a.x, a.y); t.y = pk2(a.z, a.w); t.z = pk2(b.x, b.y); t.w = pk2(b.z, b.w); kr[i] = t; }
        const float* vp = A.in[I_CV] + off;
#pragma unroll
        for (int i = 0; i < 8; ++i) { const float* v = vp + (size_t)(4 * i) * NH * HD; const f32x4 a = *(const f32x4*)v, b = *(const f32x4*)(v + 4);
            v4u t; t.x = pk2(a.x, a.y); t.y = pk2(a.z, a.w); t.z = pk2(b.x, b.y); t.w = pk2(b.z, b.w); vv[i] = t; }
    }
}
constexpr int KROW = 272;
__device__ __forceinline__ f32x16 attn_stage_qk(LAS unsigned char* wl, int lane, const v4u (&kr)[8], const v4u (&vn)[8], const bf16x8 (&qf)[8]) {
    const int r = lane & 31, h = lane >> 5, vrow = lane >> 4, vch = lane & 15;
#pragma unroll
    for (int i = 0; i < 8; ++i) *(LAS v4u*)(wl + (4 * i + vrow) * KROW + 16 * vch) = kr[i];
    LDS_WAIT(); asm volatile("" ::: "memory");
    f32x16 s;
#pragma unroll
    for (int i = 0; i < 16; ++i) s[i] = 0.f;
    const LAS unsigned char* kb = wl + r * KROW + 16 * h;
#pragma unroll
    for (int hf = 0; hf < 2; ++hf) {
        bf16x8 kf[4];
#pragma unroll
        for (int kk = 0; kk < 4; ++kk) kf[kk] = *(const LAS bf16x8*)(kb + 32 * (4 * hf + kk));
        LDS_WAIT(); asm volatile("" ::: "memory");
#pragma unroll
        for (int kk = 0; kk < 4; ++kk) s = __builtin_amdgcn_mfma_f32_32x32x16_bf16(kf[kk], qf[4 * hf + kk], s, 0, 0, 0);
    }
#pragma unroll
    for (int i = 0; i < 8; ++i) *(LAS v4u*)(wl + (4 * i + vrow) * VROW + 16 * vch) = vn[i];
    return s;
}
__device__ __forceinline__ void attn_unit(Frame& F, KArgs& A, int unit, LAS unsigned char* wl) {
    int lane_ = F.lane; asm volatile("" : "+v"(lane_));
    const int lane = lane_, r = lane & 31, h = lane >> 5;
    const bf16* PROJ = (const bf16*)(A.ws + WS_PROJ);
    int head, qrow0, npast, sb = -1;
    if (unit < 512 * NH) { head = unit >> 9; const int qb = unit & 511; qrow0 = 32 * qb; npast = qb; }
    else { const int us = unit - 512 * NH; sb = us >> 4; head = us & 15; qrow0 = SEQ + 32 * sb; npast = PAST / 32; }
    bf16x8 qf[8]; v4u kr[8], vn[8];
    attn_load_kv(A, PROJ, sb, head, qrow0, 0, lane, kr, vn);
    { const bf16* qp = PROJ + (size_t)(qrow0 + r) * DIN + head * HD + 8 * h;
#pragma unroll
      for (int kk = 0; kk < 8; ++kk) qf[kk] = *(const bf16x8*)(qp + 16 * kk); }
    f32x16 o[4];
#pragma unroll
    for (int dt = 0; dt < 4; ++dt)
#pragma unroll
        for (int i = 0; i < 16; ++i) o[dt][i] = 0.f;
    float R = 0.f;
    { const f32x16 s = attn_stage_qk(wl, lane, kr, vn, qf);
      if (npast > 0) attn_load_kv(A, PROJ, sb, head, qrow0, 1, lane, kr, vn);
      LDS_WAIT(); asm volatile("" ::: "memory");
      sb_block<true>(s, o, R, wl, lane); }
#pragma unroll 1
    for (int j = 1; j <= npast; ++j) {
        if (__all(R < -126.0f)) break;
        LDS_WAIT(); asm volatile("" ::: "memory");
        const f32x16 s = attn_stage_qk(wl, lane, kr, vn, qf);
        if (j < npast) attn_load_kv(A, PROJ, sb, head, qrow0, j + 1, lane, kr, vn);
        LDS_WAIT(); asm volatile("" ::: "memory");
        sb_block<false>(s, o, R, wl, lane);
    }
    LDS_WAIT(); asm volatile("" ::: "memory");
    bf16* OSB = (bf16*)(A.ws + WS_OSB);
#pragma unroll
    for (int dt = 0; dt < 4; ++dt)
#pragma unroll
        for (int i = 0; i < 16; ++i) { const int qq = (i & 3) + 8 * (i >> 2) + 4 * h; OSB[(size_t)(qrow0 + qq) * DSB + head * HD + 32 * dt + r] = (bf16)f2bf(o[dt][i]); }
}
__device__ __forceinline__ void lru_load_weights(LAS unsigned char* lds, const bf16* GT, int blk, int tid) {
    for (int idx = tid; idx < 2 * LBLK * 16; idx += NWAVES * 64) { const int gate = idx >> 11, row = (idx >> 4) & 127, ch = idx & 15;
        const v4u w = *(const v4u*)(GT + ((size_t)(gate * NBLK + blk) * LBLK + row) * LBLK + 8 * ch);
        *(LAS v4u*)(lds + gate * 32768 + row * 256 + ((ch ^ (row & 15)) << 4)) = w; }
}
__device__ __forceinline__ void p3_mixers(Frame& F, KArgs& A) {
    const int gw = F.vcu * NWAVES + F.wave, NGW = F.G * NWAVES;
    LAS unsigned char* wl = F.wave < 7 ? F.lds + 65536 + F.wave * WAVE_LDS : F.lds + EXCH_OFF;
    static_assert(65536 + 7 * WAVE_LDS <= RING_BYTES && EXCH_OFF + WAVE_LDS <= LDS_BYTES, "P3 LDS map");
    bool first = true;
#pragma unroll 1
    for (int p = F.vcu; first || p < NBLK * 16; p += F.G) {
        const bool has_pair = p < NBLK * 16; const int blk = has_pair ? p >> 4 : 0, slot = p & 15;
        if (!first) __syncthreads();
        lru_load_weights(F.lds, (const bf16*)(A.ws + WS_GATET), blk, F.tid);
        __syncthreads();
#pragma unroll 1
        for (int pass = 0; pass < 2; ++pass) {
            if ((pass ^ (F.wave >> 2)) == 0) {
#pragma unroll 1
                for (int k = 0; has_pair; ++k) {
                    int i;
                    if (F.G == 256) { const int w = F.wave; const bool light = (w == 5 || w == 6);
                        if (k < 3 || (k == 3 && !light)) i = w + 8 * k; else if (k == 4 && w >= 1 && w <= 3) i = (w == 1) ? 29 : (w == 2) ? 30 : 32; else break; }
                    else { i = F.wave + NWAVES * k; if (i >= 33) break; }
                    lru_unit(F, A, blk, 33 * slot + i, wl, F.lds); }
            } else if (first) {
#pragma unroll 1
                for (int k = 0;; ++k) {
                    int u;
                    if (F.G == 256) {
                        int kk;
                        if (F.wave < 7) { if (k < 4) kk = F.wave + 8 * k; else if (k == 4 && F.wave >= 5) kk = (F.wave == 5) ? 23 : 31; else break; u = F.vcu * 32 + kk; }
                        else { if (k == 0) u = 512 * NH + F.vcu; else if (k < 3) u = F.vcu * 32 + 7 + 8 * (k - 1); else break; }
                    } else {
                        u = gw + k * NGW;
                        if (u >= 512 * NH) { const int e = F.vcu + ((u - 512 * NH) / NGW) * F.G; if (F.wave != NWAVES - 1 || e >= NDEC * NH) break; u = 512 * NH + e; }
                    }
                    attn_unit(F, A, u, wl); }
            }
        }
        first = false;
    }
}

__device__ __forceinline__ void p4_carry(Frame& F, KArgs& A) {
    const float* AGA = (const float*)(A.ws + WS_AGGA); const float* AGH = (const float*)(A.ws + WS_AGGH); float* CARRY = (float*)(A.ws + WS_CARRY);
    LAS float* LA = (LAS float*)F.lds; LAS float* LH = LA + 512;
    for (int j = F.vcu; j < DLRU / 32; j += F.G) {
        const int g = F.tid >> 5, cl = F.tid & 31, ch = 32 * j + cl;
        float a[32], hh[32]; float ca = 1.f, chh = 0.f;
#pragma unroll
        for (int i = 0; i < 32; ++i) { a[i] = AGA[(size_t)(32 * g + i) * DLRU + ch]; hh[i] = AGH[(size_t)(32 * g + i) * DLRU + ch]; }
#pragma unroll
        for (int i = 0; i < 32; ++i) { chh = a[i] * chh + hh[i]; ca = a[i] * ca; }
        __syncthreads();
        LA[g * 32 + cl] = ca; LH[g * 32 + cl] = chh;
        __syncthreads();
        float cin = 0.f;
        for (int gg = 0; gg < g; ++gg) cin = LA[gg * 32 + cl] * cin + LH[gg * 32 + cl];
#pragma unroll
        for (int i = 0; i < 32; ++i) { CARRY[(size_t)(32 * g + i) * DLRU + ch] = cin; cin = a[i] * cin + hh[i]; }
        if (g == 15) A.out[OUT_LP + ch] = cin;
        { const int b = g, c = 512 + b; const float h0 = A.in[I_SL][(size_t)b * DLRU + ch];
          CARRY[(size_t)c * DLRU + ch] = h0; A.out[OUT_LS + (size_t)b * DLRU + ch] = AGH[(size_t)c * DLRU + ch] + AGA[(size_t)c * DLRU + ch] * h0; }
    }
}

__device__ __forceinline__ void p5_mixnorm(Frame& F, KArgs& A) {
    const int gw = F.vcu * NWAVES + F.wave, NGW = F.G * NWAVES, lane = F.lane;
    const bf16* PROJ = (const bf16*)(A.ws + WS_PROJ); const bf16* OSB = (const bf16*)(A.ws + WS_OSB);
    const unsigned* HP = (const unsigned*)(A.ws + WS_HP); const float* CARRY = (const float*)(A.ws + WS_CARRY);
    bf16* A2 = (bf16*)(A.ws + WS_ACT);
    LAS float* LG = (LAS float*)F.lds;
    for (int i = F.tid; i < DSB; i += NWAVES * 64) { LG[i] = A.in[I_GGA][i]; LG[DSB + i] = A.in[I_GGL][i]; }
    __syncthreads();
    for (int m = gw; m < SEQ; m += NGW) {
        v4u ow[4], hq0[4], hq1[4], glw[4]; f32x4 cr0[4], cr1[4]; const int c = m >> 5;
#pragma unroll
        for (int j = 0; j < 4; ++j) { const int col = 8 * lane + 512 * j; const size_t o = (size_t)m * DLRU + col;
            ow[j] = __builtin_nontemporal_load((const v4u*)(OSB + (size_t)m * DSB + col));
            hq0[j] = __builtin_nontemporal_load((const v4u*)(HP + o)); hq1[j] = __builtin_nontemporal_load((const v4u*)(HP + o + 4));
            cr0[j] = *(const f32x4*)(CARRY + (size_t)c * DLRU + col); cr1[j] = *(const f32x4*)(CARRY + (size_t)c * DLRU + col + 4);
            glw[j] = *(const v4u*)(PROJ + (size_t)m * DIN + 8192 + col); }
        { float v[32]; float ss = 0.f;
#pragma unroll
          for (int j = 0; j < 4; ++j) { const v4u w = ow[j];
              v[8 * j] = bf_lo(w.x); v[8 * j + 1] = bf_hi(w.x); v[8 * j + 2] = bf_lo(w.y); v[8 * j + 3] = bf_hi(w.y); v[8 * j + 4] = bf_lo(w.z); v[8 * j + 5] = bf_hi(w.z); v[8 * j + 6] = bf_lo(w.w); v[8 * j + 7] = bf_hi(w.w); }
#pragma unroll
          for (int i = 0; i < 32; ++i) ss += v[i] * v[i];
          const float rstd = 1.0f / sqrtf(wave_sum(ss) * (1.0f / DSB) + EPS);
#pragma unroll
          for (int j = 0; j < 4; ++j) { const LAS float* g = LG + 8 * lane + 512 * j; const f32x4 g0 = *(const LAS f32x4*)g, g1 = *(const LAS f32x4*)(g + 4);
              v4u w; w.x = pk2(v[8 * j] * rstd * g0.x, v[8 * j + 1] * rstd * g0.y); w.y = pk2(v[8 * j + 2] * rstd * g0.z, v[8 * j + 3] * rstd * g0.w);
              w.z = pk2(v[8 * j + 4] * rstd * g1.x, v[8 * j + 5] * rstd * g1.y); w.w = pk2(v[8 * j + 6] * rstd * g1.z, v[8 * j + 7] * rstd * g1.w);
              __builtin_nontemporal_store(w, (v4u*)(A2 + (size_t)m * DM + 8 * lane + 512 * j)); } }
        { float v[32]; float ss = 0.f;
#pragma unroll
          for (int j = 0; j < 4; ++j) {
              const v4u q0 = hq0[j], q1 = hq1[j];
              const f32x4 h0 = (f32x4){bf_lo(q0.x), bf_lo(q0.y), bf_lo(q0.z), bf_lo(q0.w)}, h1 = (f32x4){bf_lo(q1.x), bf_lo(q1.y), bf_lo(q1.z), bf_lo(q1.w)}, p0 = (f32x4){bf_hi(q0.x), bf_hi(q0.y), bf_hi(q0.z), bf_hi(q0.w)}, p1 = (f32x4){bf_hi(q1.x), bf_hi(q1.y), bf_hi(q1.z), bf_hi(q1.w)};
              const f32x4 c0 = cr0[j], c1 = cr1[j];
              const v4u gw4 = glw[j];
              const f32x4 a0 = h0 + p0 * c0, a1 = h1 + p1 * c1;
              v[8 * j] = a0.x * gelu_tanh(bf_lo(gw4.x)); v[8 * j + 1] = a0.y * gelu_tanh(bf_hi(gw4.x)); v[8 * j + 2] = a0.z * gelu_tanh(bf_lo(gw4.y)); v[8 * j + 3] = a0.w * gelu_tanh(bf_hi(gw4.y));
              v[8 * j + 4] = a1.x * gelu_tanh(bf_lo(gw4.z)); v[8 * j + 5] = a1.y * gelu_tanh(bf_hi(gw4.z)); v[8 * j + 6] = a1.z * gelu_tanh(bf_lo(gw4.w)); v[8 * j + 7] = a1.w * gelu_tanh(bf_hi(gw4.w)); }
#pragma unroll
          for (int i = 0; i < 32; ++i) ss += v[i] * v[i];
          const float rstd = 1.0f / sqrtf(wave_sum(ss) * (1.0f / DLRU) + EPS);
#pragma unroll
          for (int j = 0; j < 4; ++j) { const LAS float* g = LG + DSB + 8 * lane + 512 * j; const f32x4 g0 = *(const LAS f32x4*)g, g1 = *(const LAS f32x4*)(g + 4);
              v4u w; w.x = pk2(v[8 * j] * rstd * g0.x, v[8 * j + 1] * rstd * g0.y); w.y = pk2(v[8 * j + 2] * rstd * g0.z, v[8 * j + 3] * rstd * g0.w);
              w.z = pk2(v[8 * j + 4] * rstd * g1.x, v[8 * j + 5] * rstd * g1.y); w.w = pk2(v[8 * j + 6] * rstd * g1.z, v[8 * j + 7] * rstd * g1.w);
              __builtin_nontemporal_store(w, (v4u*)(A2 + (size_t)m * DM + DSB + 8 * lane + 512 * j)); } }
    }
    { LAS float* red = (LAS float*)(F.lds + 65536); const int c4 = 4 * (64 * F.wave + lane);
#pragma unroll 1
      for (int j = 0; F.vcu + j * F.G < M - SEQ; j += 2) {
          const int sra = F.vcu + j * F.G, srb_ = sra + F.G; const bool hasb = srb_ < M - SEQ; const int srb = hasb ? srb_ : sra;
          const int mr[2] = {SEQ + sra, SEQ + srb};
          f32x4 va[2], vl[2]; float sa0 = 0.f, sa1 = 0.f, sl0 = 0.f, sl1 = 0.f;
#pragma unroll
          for (int r = 0; r < 2; ++r) { const int m = mr[r];
              const v2u ow = *(const v2u*)(OSB + (size_t)m * DSB + c4); va[r] = (f32x4){bf_lo(ow.x), bf_hi(ow.x), bf_lo(ow.y), bf_hi(ow.y)};
              const v4u hq = *(const v4u*)(HP + (size_t)m * DLRU + c4); const f32x4 cr = *(const f32x4*)(CARRY + (size_t)(m >> 5) * DLRU + c4); const v2u gw2 = *(const v2u*)(PROJ + (size_t)m * DIN + 8192 + c4);
              const f32x4 hh = (f32x4){bf_lo(hq.x), bf_lo(hq.y), bf_lo(hq.z), bf_lo(hq.w)} + (f32x4){bf_hi(hq.x), bf_hi(hq.y), bf_hi(hq.z), bf_hi(hq.w)} * cr;
              vl[r] = (f32x4){hh.x * gelu_tanh(bf_lo(gw2.x)), hh.y * gelu_tanh(bf_hi(gw2.x)), hh.z * gelu_tanh(bf_lo(gw2.y)), hh.w * gelu_tanh(bf_hi(gw2.y))};
              const float ea = (va[r].x * va[r].x + va[r].y * va[r].y) + (va[r].z * va[r].z + va[r].w * va[r].w), el = (vl[r].x * vl[r].x + vl[r].y * vl[r].y) + (vl[r].z * vl[r].z + vl[r].w * vl[r].w);
              if (r == 0) { sa0 += ea; sl0 += el; } else { sa1 += ea; sl1 += el; } }
          float ta0, ta1, tl0, tl1; wg_sum2(F, sa0, sa1, red, ta0, ta1); wg_sum2(F, sl0, sl1, red + 16, tl0, tl1);
          const float ra[2] = {1.0f / sqrtf(ta0 * (1.0f / DSB) + EPS), 1.0f / sqrtf(ta1 * (1.0f / DSB) + EPS)}, rl[2] = {1.0f / sqrtf(tl0 * (1.0f / DLRU) + EPS), 1.0f / sqrtf(tl1 * (1.0f / DLRU) + EPS)};
          const f32x4 ga = *(const LAS f32x4*)(LG + c4), gl4 = *(const LAS f32x4*)(LG + DSB + c4);
#pragma unroll
          for (int r = 0; r < 2; ++r) if (r == 0 || hasb) { const f32x4 ya = va[r] * ra[r] * ga, yl = vl[r] * rl[r] * gl4;
              v2u w; w.x = pk2(ya.x, ya.y); w.y = pk2(ya.z, ya.w); *(v2u*)(A2 + (size_t)mr[r] * DM + c4) = w;
              w.x = pk2(yl.x, yl.y); w.y = pk2(yl.z, yl.w); *(v2u*)(A2 + (size_t)mr[r] * DM + DSB + c4) = w; }
          __syncthreads();
      } }
}

template <bool PROMPT>
__device__ __forceinline__ void p7_row(Frame& F, KArgs& A, int m, const LAS f32x4* LA, const LAS f32x4* LB, const LAS f32x4* LC) {
    const int lane = F.lane;
    const float* MOD = (const float*)(A.ws + WS_MOD); const bf16* MIX = (const bf16*)(A.ws + WS_MIX); bf16* H = (bf16*)(A.ws + WS_ACT);
    const f32x4* xr = (const f32x4*)xrow_of(A, m) + lane;
    f32x4 v[16]; float ss = 0.f;
    if (PROMPT) {
#pragma unroll
        for (int j = 0; j < 16; ++j) { const v2u w = __builtin_nontemporal_load((const v2u*)(MIX + (size_t)m * DM) + lane + 64 * j); v[j] = (f32x4){bf_lo(w.x), bf_hi(w.x), bf_lo(w.y), bf_hi(w.y)}; }
    } else {
#pragma unroll
        for (int j = 0; j < 16; ++j) v[j] = (f32x4){0.f, 0.f, 0.f, 0.f};
#pragma unroll 1
        for (int ks = 0; ks < KS_OUT; ++ks) { const f32x4* pr = (const f32x4*)(A.ws + WS_PART) + ((size_t)ks * (M - SEQ) + (m - SEQ)) * (DM / 4) + lane;
#pragma unroll
            for (int j = 0; j < 16; ++j) v[j] += pr[64 * j]; }
    }
#pragma unroll
    for (int j = 0; j < 16; ++j) ss += (v[j].x * v[j].x + v[j].y * v[j].y) + (v[j].z * v[j].z + v[j].w * v[j].w);
    const float rstd = 1.0f / sqrtf(wave_sum(ss) * (1.0f / DM) + EPS);
    v2u* xo = (v2u*)((bf16*)(A.ws + WS_X1) + (size_t)m * DM) + lane; float s2 = 0.f;
    const float* mo = MOD + (size_t)modrow_of(m) * NMODC;
#pragma unroll
    for (int j = 0; j < 16; ++j) { const f32x4 ca = PROMPT ? LA[lane + 64 * j] : ((const f32x4*)(mo + 2 * DM) + lane)[64 * j] * ((const f32x4*)A.in[I_GPOM] + lane)[64 * j];
        const f32x4 x1 = __builtin_nontemporal_load(xr + 64 * j) + ca * (v[j] * rstd); v[j] = x1; { v2u w; w.x = pk2(x1.x, x1.y); w.y = pk2(x1.z, x1.w); __builtin_nontemporal_store(w, xo + 64 * j); }
        s2 += (x1.x * x1.x + x1.y * x1.y) + (x1.z * x1.z + x1.w * x1.w); if ((j & 3) == 3) asm volatile("" ::: "memory"); }
    const float rstd2 = 1.0f / sqrtf(wave_sum(s2) * (1.0f / DM) + EPS);
    v2u* o = (v2u*)(H + (size_t)m * DM) + lane;
#pragma unroll
    for (int j = 0; j < 16; ++j) { const f32x4 cb = PROMPT ? LB[lane + 64 * j] : ((const f32x4*)A.in[I_GPF] + lane)[64 * j] * (1.0f + ((const f32x4*)(mo + 4 * DM) + lane)[64 * j]), cc = PROMPT ? LC[lane + 64 * j] : ((const f32x4*)(mo + 3 * DM) + lane)[64 * j];
        const f32x4 y = v[j] * rstd2 * cb + cc; v2u w; w.x = pk2(y.x, y.y); w.y = pk2(y.z, y.w); __builtin_nontemporal_store(w, o + 64 * j); if ((j & 3) == 3) asm volatile("" ::: "memory"); }
}
__device__ __forceinline__ void p7_load(KArgs& A, int m, int lane, v2u (&mx)[16], f32x4 (&x)[16]) {
    const v2u* mr = (const v2u*)((const bf16*)(A.ws + WS_MIX) + (size_t)m * DM) + lane; const f32x4* xr = (const f32x4*)(A.in[I_XP] + (size_t)m * DM) + lane;
#pragma unroll
    for (int j = 0; j < 16; ++j) { mx[j] = __builtin_nontemporal_load(mr + 64 * j); x[j] = __builtin_nontemporal_load(xr + 64 * j); }
}
__device__ __forceinline__ void p7_proc(Frame& F, KArgs& A, int m, const v2u (&mx)[16], f32x4 (&x)[16], const LAS f32x4* LA, const LAS f32x4* LB, const LAS f32x4* LC) {
    const int lane = F.lane; float ss = 0.f;
#pragma unroll
    for (int j = 0; j < 16; ++j) { const f32x4 v = (f32x4){bf_lo(mx[j].x), bf_hi(mx[j].x), bf_lo(mx[j].y), bf_hi(mx[j].y)}; ss += (v.x * v.x + v.y * v.y) + (v.z * v.z + v.w * v.w); }
    const float rstd = 1.0f / sqrtf(wave_sum(ss) * (1.0f / DM) + EPS);
    v2u* xo = (v2u*)((bf16*)(A.ws + WS_X1) + (size_t)m * DM) + lane; float s2 = 0.f;
#pragma unroll
    for (int j = 0; j < 16; ++j) { const f32x4 v = (f32x4){bf_lo(mx[j].x), bf_hi(mx[j].x), bf_lo(mx[j].y), bf_hi(mx[j].y)};
        const f32x4 x1 = x[j] + LA[lane + 64 * j] * (v * rstd); x[j] = x1; { v2u w; w.x = pk2(x1.x, x1.y); w.y = pk2(x1.z, x1.w); __builtin_nontemporal_store(w, xo + 64 * j); }
        s2 += (x1.x * x1.x + x1.y * x1.y) + (x1.z * x1.z + x1.w * x1.w); if ((j & 3) == 3) asm volatile("" ::: "memory"); }
    const float rstd2 = 1.0f / sqrtf(wave_sum(s2) * (1.0f / DM) + EPS);
    v2u* o = (v2u*)((bf16*)(A.ws + WS_ACT) + (size_t)m * DM) + lane;
#pragma unroll
    for (int j = 0; j < 16; ++j) { const f32x4 y = x[j] * rstd2 * LB[lane + 64 * j] + LC[lane + 64 * j]; v2u w; w.x = pk2(y.x, y.y); w.y = pk2(y.z, y.w); __builtin_nontemporal_store(w, o + 64 * j); if ((j & 3) == 3) asm volatile("" ::: "memory"); }
}
__device__ __forceinline__ void p7_samples(Frame& F, KArgs& A) {
    LAS float* red = (LAS float*)(F.lds + 65536);
    const float* MOD = (const float*)(A.ws + WS_MOD);
    const int cb = 128 * F.wave + F.lane;
#pragma unroll 1
    for (int j = 0; F.vcu + j * F.G < M - SEQ; j += 2) {
        const int sra = F.vcu + j * F.G, srb_ = sra + F.G; const bool hasb = srb_ < M - SEQ; const int srb = hasb ? srb_ : sra;
        const int sr[2] = {sra, srb};
        f32x4 v[2][2];
#pragma unroll
        for (int r = 0; r < 2; ++r)
#pragma unroll
            for (int q = 0; q < 2; ++q) v[r][q] = (f32x4){0.f, 0.f, 0.f, 0.f};
#pragma unroll
        for (int ks = 0; ks < KS_OUT; ++ks)
#pragma unroll
            for (int r = 0; r < 2; ++r)
#pragma unroll
                for (int q = 0; q < 2; ++q) v[r][q] += ((const f32x4*)(A.ws + WS_PART))[((size_t)ks * (M - SEQ) + sr[r]) * (DM / 4) + cb + 64 * q];
        float s0 = 0.f, s1 = 0.f;
#pragma unroll
        for (int q = 0; q < 2; ++q) { s0 += (v[0][q].x * v[0][q].x + v[0][q].y * v[0][q].y) + (v[0][q].z * v[0][q].z + v[0][q].w * v[0][q].w); s1 += (v[1][q].x * v[1][q].x + v[1][q].y * v[1][q].y) + (v[1][q].z * v[1][q].z + v[1][q].w * v[1][q].w); }
        float t0, t1; wg_sum2(F, s0, s1, red, t0, t1);
        const float rstd[2] = {1.0f / sqrtf(t0 * (1.0f / DM) + EPS), 1.0f / sqrtf(t1 * (1.0f / DM) + EPS)};
        float u0 = 0.f, u1 = 0.f;
#pragma unroll
        for (int r = 0; r < 2; ++r) { const float* mo = MOD + (size_t)(1 + (sr[r] >> 5)) * NMODC;
#pragma unroll
            for (int q = 0; q < 2; ++q) { const int ci = cb + 64 * q;
                const f32x4 x1 = ((const f32x4*)(A.in[I_XS] + (size_t)sr[r] * DM))[ci] + ((const f32x4*)(mo + 2 * DM))[ci] * ((const f32x4*)A.in[I_GPOM])[ci] * (v[r][q] * rstd[r]);
                v[r][q] = x1;
                if (r == 0 || hasb) { v2u w; w.x = pk2(x1.x, x1.y); w.y = pk2(x1.z, x1.w); ((v2u*)((bf16*)(A.ws + WS_X1) + (size_t)(SEQ + sr[r]) * DM))[ci] = w; }
                const float e = (x1.x * x1.x + x1.y * x1.y) + (x1.z * x1.z + x1.w * x1.w); if (r == 0) u0 += e; else u1 += e; } }
        wg_sum2(F, u0, u1, red + 16, t0, t1);
        const float rstd2[2] = {1.0f / sqrtf(t0 * (1.0f / DM) + EPS), 1.0f / sqrtf(t1 * (1.0f / DM) + EPS)};
#pragma unroll
        for (int r = 0; r < 2; ++r) { const float* mo = MOD + (size_t)(1 + (sr[r] >> 5)) * NMODC;
#pragma unroll
            for (int q = 0; q < 2; ++q) { const int ci = cb + 64 * q;
                const f32x4 y = v[r][q] * rstd2[r] * ((const f32x4*)A.in[I_GPF])[ci] * (1.0f + ((const f32x4*)(mo + 4 * DM))[ci]) + ((const f32x4*)(mo + 3 * DM))[ci];
                if (r == 0 || hasb) { v2u w; w.x = pk2(y.x, y.y); w.y = pk2(y.z, y.w); ((v2u*)((bf16*)(A.ws + WS_ACT) + (size_t)(SEQ + sr[r]) * DM))[ci] = w; } } }
    }
}
__device__ __forceinline__ void p7_postmix(Frame& F, KArgs& A) {
    const int gw = F.vcu * NWAVES + F.wave, NGW = F.G * NWAVES;
    const float* MOD = (const float*)(A.ws + WS_MOD);
    LAS f32x4* LA = (LAS f32x4*)F.lds; LAS f32x4* LB = LA + DM / 4; LAS f32x4* LC = LB + DM / 4;
    for (int i = F.tid; i < DM / 4; i += NWAVES * 64) { const f32x4* m4 = (const f32x4*)MOD + i;
        LA[i] = m4[2 * DM / 4] * ((const f32x4*)A.in[I_GPOM])[i]; LB[i] = ((const f32x4*)A.in[I_GPF])[i] * (1.0f + m4[4 * DM / 4]); LC[i] = m4[3 * DM / 4]; }
    __syncthreads();
#pragma unroll 1
    for (int m = gw; m < SEQ; m += NGW) { v2u mx[16]; f32x4 xx[16]; p7_load(A, m, F.lane, mx, xx); p7_proc(F, A, m, mx, xx, LA, LB, LC); }
    p7_samples(F, A);
}

__device__ __forceinline__ void up8(const v4u w, float (&f)[8]) { f[0] = bf_lo(w.x); f[1] = bf_hi(w.x); f[2] = bf_lo(w.y); f[3] = bf_hi(w.y); f[4] = bf_lo(w.z); f[5] = bf_hi(w.z); f[6] = bf_lo(w.w); f[7] = bf_hi(w.w); }
__device__ __forceinline__ void ld8(const float* p, float (&f)[8]) { const f32x4 a = *(const f32x4*)p, b = *(const f32x4*)(p + 4); f[0] = a.x; f[1] = a.y; f[2] = a.z; f[3] = a.w; f[4] = b.x; f[5] = b.y; f[6] = b.z; f[7] = b.w; }
__device__ __forceinline__ void p9_fix(Frame& F, KArgs& A) {
    const int gw = F.vcu * NWAVES + F.wave, NGW = F.G * NWAVES, lane = F.lane;
    const float* RAWP = (const float*)(A.ws + WS_RAWP); const float* RAWS = (const float*)(A.ws + WS_RAWS); bf16* ACTF = (bf16*)(A.ws + WS_ACTF);
    constexpr int NCC = (DFF + 511) / 512;
#pragma unroll 1
    for (int u = gw; u < 160 * NCC; u += NGW) {
        const int cc = u % NCC, fi = u / NCC, col = 512 * cc + 8 * lane;
        if (col >= DFF) continue;
        float wg[3][8], wv[3][8], bg[8], bv[8], g2[8], g1[8], g0[8], v2[8], v1[8], v0[8];
#pragma unroll
        for (int j = 0; j < 3; ++j) { ld8(A.in[I_WCF] + (size_t)j * DFF2 + col, wg[j]); ld8(A.in[I_WCF] + (size_t)j * DFF2 + DFF + col, wv[j]); }
        ld8(A.in[I_BCF] + col, bg); ld8(A.in[I_BCF] + DFF + col, bv);
        int row; const float *p0, *p1, *p2;
        if (fi < 128) { const int j = fi >> 1, d = fi & 1; row = 256 * j + d; const float* b = RAWP + (size_t)j * 4 * DFF2;
            p0 = b + (size_t)(2 + d) * DFF2; p1 = d ? b + (size_t)2 * DFF2 : (j ? b + (size_t)1 * DFF2 : nullptr); p2 = j ? (d ? b + (size_t)1 * DFF2 : b) : nullptr; }
        else { const int s = (fi - 128) >> 1, d = fi & 1; row = SEQ + 32 * s + d; const float* b = RAWS + (size_t)s * 2 * DFF2; const float* st = A.in[I_SCF] + (size_t)s * 2 * DFF2;
            p0 = b + (size_t)d * DFF2; p1 = d ? b : st + DFF2; p2 = d ? st + DFF2 : st; }
        ld8(p0 + col, g0); ld8(p0 + DFF + col, v0);
        if (p1) { ld8(p1 + col, g1); ld8(p1 + DFF + col, v1); } else {
#pragma unroll
            for (int e = 0; e < 8; ++e) { g1[e] = 0.f; v1[e] = 0.f; } }
        if (p2) { ld8(p2 + col, g2); ld8(p2 + DFF + col, v2); } else {
#pragma unroll
            for (int e = 0; e < 8; ++e) { g2[e] = 0.f; v2[e] = 0.f; } }
        float y[8];
#pragma unroll
        for (int e = 0; e < 8; ++e) { const float gc = bg[e] + wg[0][e] * g2[e] + wg[1][e] * g1[e] + wg[2][e] * g0[e]; const float vc = bv[e] + wv[0][e] * v2[e] + wv[1][e] * v1[e] + wv[2][e] * v0[e]; y[e] = gelu_tanh(gc) * vc; }
        v4u w; w.x = pk2(y[0], y[1]); w.y = pk2(y[2], y[3]); w.z = pk2(y[4], y[5]); w.w = pk2(y[6], y[7]);
        *(v4u*)(ACTF + (size_t)row * DFF + col) = w;
    }
}

template <bool PROMPT>
__device__ __forceinline__ void p11_row(Frame& F, KArgs& A, int m, const LAS f32x4* LA) {
    const int lane = F.lane;
    const float* MOD = (const float*)(A.ws + WS_MOD); const bf16* YD = (const bf16*)(A.ws + WS_MIX);
    f32x4 v[16]; float ss = 0.f;
    if (PROMPT) {
#pragma unroll
        for (int j = 0; j < 16; ++j) { const v2u w = __builtin_nontemporal_load((const v2u*)(YD + (size_t)m * DM) + lane + 64 * j); v[j] = (f32x4){bf_lo(w.x), bf_hi(w.x), bf_lo(w.y), bf_hi(w.y)}; }
    } else {
#pragma unroll
        for (int j = 0; j < 16; ++j) v[j] = (f32x4){0.f, 0.f, 0.f, 0.f};
#pragma unroll 1
        for (int ks = 0; ks < KS_DOWN; ++ks) { const f32x4* pr = (const f32x4*)(A.ws + WS_PART) + ((size_t)ks * (M - SEQ) + (m - SEQ)) * (DM / 4) + lane;
#pragma unroll
            for (int j = 0; j < 16; ++j) v[j] += pr[64 * j]; }
    }
#pragma unroll
    for (int j = 0; j < 16; ++j) ss += (v[j].x * v[j].x + v[j].y * v[j].y) + (v[j].z * v[j].z + v[j].w * v[j].w);
    const float rstd = 1.0f / sqrtf(wave_sum(ss) * (1.0f / DM) + EPS);
    f32x4* yo = (f32x4*)(A.out + OUT_Y + (size_t)m * DM) + lane;
    const v2u* xi = (const v2u*)((const bf16*)(A.ws + WS_X1) + (size_t)m * DM) + lane;
#pragma unroll
    for (int j = 0; j < 16; ++j) { const v2u w = __builtin_nontemporal_load(xi + 64 * j); const f32x4 x1 = (f32x4){bf_lo(w.x), bf_hi(w.x), bf_lo(w.y), bf_hi(w.y)};
        const f32x4 ca = PROMPT ? LA[lane + 64 * j] : ((const f32x4*)(MOD + (size_t)modrow_of(m) * NMODC + 5 * DM) + lane)[64 * j] * ((const f32x4*)A.in[I_GPOF] + lane)[64 * j];
        const f32x4 y = x1 + ca * (v[j] * rstd); __builtin_nontemporal_store(y, yo + 64 * j); if ((j & 3) == 3) asm volatile("" ::: "memory"); }
}
__device__ __forceinline__ void p11_load(KArgs& A, int m, int lane, v2u (&y)[16], v2u (&x)[16]) {
    const v2u* yr = (const v2u*)((const bf16*)(A.ws + WS_MIX) + (size_t)m * DM) + lane; const v2u* xr = (const v2u*)((const bf16*)(A.ws + WS_X1) + (size_t)m * DM) + lane;
#pragma unroll
    for (int j = 0; j < 16; ++j) { y[j] = __builtin_nontemporal_load(yr + 64 * j); x[j] = __builtin_nontemporal_load(xr + 64 * j); }
}
__device__ __forceinline__ void p11_proc(Frame& F, KArgs& A, int m, const v2u (&y)[16], const v2u (&x)[16], const LAS f32x4* LA) {
    const int lane = F.lane; float ss = 0.f;
#pragma unroll
    for (int j = 0; j < 16; ++j) { const f32x4 v = (f32x4){bf_lo(y[j].x), bf_hi(y[j].x), bf_lo(y[j].y), bf_hi(y[j].y)}; ss += (v.x * v.x + v.y * v.y) + (v.z * v.z + v.w * v.w); }
    const float rstd = 1.0f / sqrtf(wave_sum(ss) * (1.0f / DM) + EPS);
    f32x4* yo = (f32x4*)(A.out + OUT_Y + (size_t)m * DM) + lane;
#pragma unroll
    for (int j = 0; j < 16; ++j) { const f32x4 v = (f32x4){bf_lo(y[j].x), bf_hi(y[j].x), bf_lo(y[j].y), bf_hi(y[j].y)}, x1 = (f32x4){bf_lo(x[j].x), bf_hi(x[j].x), bf_lo(x[j].y), bf_hi(x[j].y)};
        const f32x4 o = x1 + LA[lane + 64 * j] * (v * rstd); __builtin_nontemporal_store(o, yo + 64 * j); if ((j & 3) == 3) asm volatile("" ::: "memory"); }
}
__device__ __forceinline__ void p11_samples(Frame& F, KArgs& A) {
    LAS float* red = (LAS float*)(F.lds + 65536);
    const float* MOD = (const float*)(A.ws + WS_MOD);
    const int cb = 128 * F.wave + F.lane;
#pragma unroll 1
    for (int j = 0; F.vcu + j * F.G < M - SEQ; j += 2) {
        const int sra = F.vcu + j * F.G, srb_ = sra + F.G; const bool hasb = srb_ < M - SEQ; const int srb = hasb ? srb_ : sra;
        const int sr[2] = {sra, srb};
        f32x4 v[2][2];
#pragma unroll
        for (int r = 0; r < 2; ++r)
#pragma unroll
            for (int q = 0; q < 2; ++q) v[r][q] = (f32x4){0.f, 0.f, 0.f, 0.f};
#pragma unroll
        for (int ks = 0; ks < KS_DOWN; ++ks)
#pragma unroll
            for (int r = 0; r < 2; ++r)
#pragma unroll
                for (int q = 0; q < 2; ++q) v[r][q] += ((const f32x4*)(A.ws + WS_PART))[((size_t)ks * (M - SEQ) + sr[r]) * (DM / 4) + cb + 64 * q];
        float s0 = 0.f, s1 = 0.f;
#pragma unroll
        for (int q = 0; q < 2; ++q) { s0 += (v[0][q].x * v[0][q].x + v[0][q].y * v[0][q].y) + (v[0][q].z * v[0][q].z + v[0][q].w * v[0][q].w); s1 += (v[1][q].x * v[1][q].x + v[1][q].y * v[1][q].y) + (v[1][q].z * v[1][q].z + v[1][q].w * v[1][q].w); }
        float t0, t1; wg_sum2(F, s0, s1, red, t0, t1);
        const float rstd[2] = {1.0f / sqrtf(t0 * (1.0f / DM) + EPS), 1.0f / sqrtf(t1 * (1.0f / DM) + EPS)};
#pragma unroll
        for (int r = 0; r < 2; ++r) { const float* mo = MOD + (size_t)(1 + (sr[r] >> 5)) * NMODC;
#pragma unroll
            for (int q = 0; q < 2; ++q) { const int ci = cb + 64 * q;
                const v2u w = ((const v2u*)((const bf16*)(A.ws + WS_X1) + (size_t)(SEQ + sr[r]) * DM))[ci]; const f32x4 x1 = (f32x4){bf_lo(w.x), bf_hi(w.x), bf_lo(w.y), bf_hi(w.y)};
                const f32x4 y = x1 + ((const f32x4*)(mo + 5 * DM))[ci] * ((const f32x4*)A.in[I_GPOF])[ci] * (v[r][q] * rstd[r]);
                if (r == 0 || hasb) ((f32x4*)(A.out + OUT_Y + (size_t)(SEQ + sr[r]) * DM))[ci] = y; } }
        __syncthreads();
    }
}
__device__ __forceinline__ void p11_final(Frame& F, KArgs& A) {
    const int gw = F.vcu * NWAVES + F.wave, NGW = F.G * NWAVES;
    const float* MOD = (const float*)(A.ws + WS_MOD);
    LAS f32x4* LA = (LAS f32x4*)F.lds;
    for (int i = F.tid; i < DM / 4; i += NWAVES * 64) LA[i] = ((const f32x4*)(MOD + 5 * DM))[i] * ((const f32x4*)A.in[I_GPOF])[i];
    __syncthreads();
    { v2u ya[16], xa[16], yb[16], xb[16]; int m = gw;
      if (m < SEQ) p11_load(A, m, F.lane, ya, xa);
#pragma unroll 1
      for (; m < SEQ; m += 2 * NGW) {
          if (m + NGW < SEQ) p11_load(A, m + NGW, F.lane, yb, xb);
          p11_proc(F, A, m, ya, xa, LA);
          if (m + NGW < SEQ) { if (m + 2 * NGW < SEQ) p11_load(A, m + 2 * NGW, F.lane, ya, xa); p11_proc(F, A, m + NGW, yb, xb, LA); }
      } }
    p11_samples(F, A);
}

__global__ void __launch_bounds__(NWAVES * 64, 2) mk_fwd(Args args_by_value) {
    extern __shared__ __attribute__((aligned(16))) unsigned char lds[];
    KArgs& args = *(KArgs*)__builtin_amdgcn_kernarg_segment_ptr();
    Frame F;
    F.lds = (LAS unsigned char*)lds;
    F.MISC = (volatile LAS unsigned*)(F.lds + MISC_OFF);
    F.tid = threadIdx.x; F.lane = F.tid & 63; F.wave = __builtin_amdgcn_readfirstlane(F.tid >> 6);
    F.G = gridDim.x; { const int bx = blockIdx.x; F.vcu = (F.G % 8 == 0) ? (bx % 8) * (F.G / 8) + bx / 8 : bx; }
    F.ctl = (gu32*)(args.ws + WS_CTL);
    for (int u = F.tid; u < (LDS_BYTES - LDSCTL_OFF) / 4; u += NWAVES * 64) ((LAS unsigned*)(F.lds + LDSCTL_OFF))[u] = 0u;
    __syncthreads();
    XcdBarrier bar = xcd_barrier_post((unsigned*)(F.ctl + CW_BAR) + args.li * XCD_BAR_WORDS, F.MISC + 8);
    const int lo = args.ph_lo, hi = args.ph_hi;
#define IN(k) (lo <= (k) && (k) < hi)
#define SEAM(k) do { if (IN(k) && IN((k) + 1)) xcd_barrier(bar); } while (0)
    unsigned char* ws = args.ws;

    if (IN(0)) { p0_prologue(F, args); } SEAM(0);
    if (IN(1)) { p1_h1(F, args); } SEAM(1);
    if (IN(2)) {
        pg8::Gemm g{(const pg8::bf16_t*)(ws + WS_ACT), (const pg8::bf16_t*)(ws + WS_WIN), M, DIN, DM}; pg8::StaticOrder S; S.init(M, DIN, F.G, (int)blockIdx.x);
        pg8::EpiInProj E{(pg8::bf16_t*)(ws + WS_PROJ), args.out + OUT_KP, args.out + OUT_VP, args.out + OUT_KS, args.out + OUT_VS, args.out + OUT_CLP, args.out + OUT_CLS};
        pg8::gemm_phase<pg8::EpiInProj, pg8::StaticOrder, true, true>(F.lds, g, S, E);
        tail_convert<true>(F, args.in[I_WUP], DM, DFF2, (bf16*)(ws + WS_WUP), IT_UP_TAIL, (M / 256) * (DIN / 256));
    } SEAM(2);
    if (IN(3)) { p3_mixers(F, args); } SEAM(3);
    if (IN(4)) { p4_carry(F, args); } SEAM(4);
    if (IN(5)) { p5_mixnorm(F, args); } SEAM(5);
    if (IN(6)) {
        pg8::Gemm g{(const pg8::bf16_t*)(ws + WS_ACT), (const pg8::bf16_t*)(ws + WS_WOUT), M, DM, DM}; pg8::SplitOrder S; S.init(SEQ, M - SEQ, DM, KS_OUT, DM / 64 / KS_OUT, KS_OUT, F.G, (int)blockIdx.x);
        pg8::EpiMixS E{(pg8::bf16_t*)(ws + WS_MIX), DM, (float*)(ws + WS_PART), SEQ, M - SEQ};
        pg8::gemm_phase<pg8::EpiMixS, pg8::SplitOrder, true, true>(F.lds, g, S, E);
    } SEAM(6);
    if (IN(7)) { p7_postmix(F, args); } SEAM(7);
    if (IN(8)) {
        pg8::Gemm g{(const pg8::bf16_t*)(ws + WS_ACT), (const pg8::bf16_t*)(ws + WS_WUP), M, DFF2, DM}; pg8::StaticOrder S; S.init(M, DFF2, F.G, (int)blockIdx.x);
        pg8::EpiUpAct E{(pg8::bf16_t*)(ws + WS_ACTF), args.in[I_WCF], args.in[I_BCF], (float*)(ws + WS_RAWP), (float*)(ws + WS_RAWS), args.out + OUT_CFP, args.out + OUT_CFS, (LAS float*)(F.lds + EXCH_OFF)};
        pg8::gemm_phase<pg8::EpiUpAct, pg8::StaticOrder, true, true>(F.lds, g, S, E);
        tail_convert<false>(F, args.in[I_WDOWN], DFF, DM, (bf16*)(ws + WS_WDOWN), IT_DOWN_TAIL, (M / 256) * (DFF2 / 256));
    } SEAM(8);
    if (IN(9)) { p9_fix(F, args); } SEAM(9);
    if (IN(10)) {
        pg8::Gemm g{(const pg8::bf16_t*)(ws + WS_ACTF), (const pg8::bf16_t*)(ws + WS_WDOWN), M, DM, DFF}; pg8::SplitOrder S; S.init(SEQ, M - SEQ, DM, KS_DOWN, 44, 2, F.G, (int)blockIdx.x);
        pg8::EpiMixS E{(pg8::bf16_t*)(ws + WS_MIX), DM, (float*)(ws + WS_PART), SEQ, M - SEQ};
        pg8::gemm_phase<pg8::EpiMixS, pg8::SplitOrder, true, true>(F.lds, g, S, E);
    } SEAM(10);
    if (IN(11)) { p11_final(F, args); }
#undef IN
#undef SEAM
}

#ifndef MK_N_LAUNCHES
#define MK_N_LAUNCHES 1
#endif
extern "C" void kernel_launch(void* const* d_in, const int* in_sizes, int n_in, void* d_out, int out_size, void* d_ws, size_t ws_size, hipStream_t stream) {
    static int grid = 0;
    if (grid == 0) {
        if (n_in != N_IN || (size_t)out_size != OUT_END || ws_size < WS_END) { fprintf(stderr, "kernel_launch: unexpected shapes (n_in %d, out %d, ws %zu); nothing launched\n", n_in, out_size, ws_size); grid = -1; return; }
        int dev = 0, cus = 0, per_cu = 0;
        if (hipGetDevice(&dev) != hipSuccess || hipDeviceGetAttribute(&cus, hipDeviceAttributeMultiprocessorCount, dev) != hipSuccess) { grid = -1; return; }
        if (hipFuncSetAttribute((const void*)mk_fwd, hipFuncAttributeMaxDynamicSharedMemorySize, LDS_BYTES) != hipSuccess) { fprintf(stderr, "kernel_launch: hipFuncSetAttribute failed\n"); grid = -1; return; }
        if (hipOccupancyMaxActiveBlocksPerMultiprocessor(&per_cu, (const void*)mk_fwd, NWAVES * 64, LDS_BYTES) != hipSuccess || per_cu < 1) { fprintf(stderr, "kernel_launch: occupancy query says %d blocks per CU\n", per_cu); }
        (void)hipGetLastError();
        grid = cus;
    }
    if (grid < 0) return;
    if (hipMemsetAsync((char*)d_ws + WS_CTL, 0, CTL_ZERO_BYTES, stream) != hipSuccess) return;
    Args a{};
    for (int i = 0; i < N_IN; ++i) a.in[i] = (const float*)d_in[i];
    a.out = (float*)d_out; a.ws = (unsigned char*)d_ws; a.pad = 0;
#if defined(MK_PROBE_DUP)
    { static const int kDup[NPH] = MK_PROBE_DUP;
      for (int li = 0; li < NPH; ++li) for (int rep = 0; rep < kDup[li]; ++rep) { a.ph_lo = li; a.ph_hi = li + 1; a.li = li; hipLaunchKernelGGL(mk_fwd, dim3(grid), dim3(NWAVES * 64), LDS_BYTES, stream, a); } }
#elif MK_N_LAUNCHES == 1
    a.ph_lo = 0; a.ph_hi = NPH; a.li = 0;
    hipLaunchKernelGGL(mk_fwd, dim3(grid), dim3(NWAVES * 64), LDS_BYTES, stream, a);
#else
    for (int li = 0; li < NPH; ++li) { a.ph_lo = li; a.ph_hi = li + 1; a.li = li; hipLaunchKernelGGL(mk_fwd, dim3(grid), dim3(NWAVES * 64), LDS_BYTES, stream, a); }
#endif
}
```
